# Optimizing an MI355X kernel written in HIP

```python
import jax, jax.numpy as jnp
from jax import lax
import numpy as np

D_MODEL = 2048
BATCH = 4
SEQ = 4096
DEPTH = 1

CHUNK = 64
N_MEM = 256
GLA_HEADS = 4
GLA_VW = D_MODEL // 2
GLA_KW = D_MODEL // 4
GLA_DK = GLA_KW // GLA_HEADS
GLA_DV = GLA_VW // GLA_HEADS
GLA_LOWRANK = 16
GLA_TAU = 16.0
FOX_HEADS = 4
FOX_W = D_MODEL // 4
FOX_DH = FOX_W // FOX_HEADS
FOX_QBLOCK = 128
MEM_HEADS = 4
MEM_W = D_MODEL // 4
MEM_DH = MEM_W // MEM_HEADS
D_MIX = GLA_VW + FOX_W + MEM_W
N_EXPERTS = 32
TOP_K = 4
D_FF = D_MODEL
SWIGLU_LIMIT = 7.0
SWIGLU_ALPHA = 1.702
MOE_BLOCK = 256
EPS = 1e-5

IN_SPLITS = (GLA_KW, GLA_KW, GLA_VW, GLA_VW, GLA_LOWRANK,
             FOX_W, FOX_W, FOX_W, FOX_HEADS,
             MEM_W)
D_IN = sum(IN_SPLITS)

kernel_name = 'hybrid_gla_fox_mem_moe_block'


def rms_norm(x, g):
    xf = x.astype(jnp.float32)
    y = xf * lax.rsqrt(jnp.mean(xf * xf, axis=-1, keepdims=True) + EPS)
    return (y * g.astype(jnp.float32)).astype(x.dtype)


def gla_mixer(q, k, v, a_low, w_a2, b_a):
    B, S = q.shape[:2]
    nc = S // CHUNK
    log_alpha = jax.nn.log_sigmoid((a_low @ w_a2 + b_a).astype(jnp.float32)) / GLA_TAU
    shp_k = (B, nc, CHUNK, GLA_HEADS, GLA_DK)
    qc = q.astype(jnp.float32).reshape(shp_k) * (GLA_DK ** -0.5)
    kc = k.astype(jnp.float32).reshape(shp_k)
    vc = v.astype(jnp.float32).reshape(B, nc, CHUNK, GLA_HEADS, GLA_DV)
    b = jnp.cumsum(log_alpha.reshape(shp_k), axis=2)
    b_end = b[:, :, -1:]
    k_dec = kc * jnp.exp(b_end - b)
    chunk_kv = jnp.einsum('bnchk,bnchv->nbhkv', k_dec, vc)
    chunk_decay = jnp.exp(b_end[:, :, 0]).transpose(1, 0, 2, 3)

    def step(state, inp):
        d, kv = inp
        state = d[..., None] * state + kv
        return state, state

    init = jnp.zeros((B, GLA_HEADS, GLA_DK, GLA_DV), jnp.float32)
    _, states = lax.scan(step, init, (chunk_decay, chunk_kv))
    o = jnp.einsum('bnchk,nbhkv->bnchv', qc, states)
    return o.reshape(B, S, GLA_HEADS, GLA_DV)


def fox_mixer(q, k, v, f_logit, b_f):
    B, S = q.shape[:2]
    qh = q.reshape(B, S, FOX_HEADS, FOX_DH).transpose(0, 2, 1, 3)
    kh = k.reshape(B, S, FOX_HEADS, FOX_DH).transpose(0, 2, 1, 3)
    vh = v.reshape(B, S, FOX_HEADS, FOX_DH).transpose(0, 2, 1, 3)
    log_f = jax.nn.log_sigmoid(f_logit.astype(jnp.float32) + b_f.astype(jnp.float32))
    F = jnp.cumsum(log_f, axis=1).transpose(0, 2, 1)
    scale = FOX_DH ** -0.5
    outs = []
    for i in range(S // FOX_QBLOCK):
        q0, q1 = i * FOX_QBLOCK, (i + 1) * FOX_QBLOCK
        s = jnp.einsum('bhqd,bhkd->bhqk', qh[:, :, q0:q1], kh[:, :, :q1]).astype(jnp.float32) * scale
        s = s + F[:, :, q0:q1, None] - F[:, :, None, :q1]
        mask = jnp.arange(q1)[None, :] <= jnp.arange(q0, q1)[:, None]
        p = jax.nn.softmax(jnp.where(mask, s, -jnp.inf), axis=-1)
        outs.append(jnp.einsum('bhqk,bhkd->bhqd', p.astype(vh.dtype), vh[:, :, :q1]))
    return jnp.concatenate(outs, axis=2).transpose(0, 2, 1, 3)


def mem_mixer(qm, mem_n, w_mem_kv):
    B, S = qm.shape[:2]
    kv = mem_n @ w_mem_kv
    km = kv[..., :MEM_W].reshape(B, -1, MEM_HEADS, MEM_DH)
    vm = kv[..., MEM_W:].reshape(B, -1, MEM_HEADS, MEM_DH)
    qh = qm.reshape(B, S, MEM_HEADS, MEM_DH)
    s = jnp.einsum('bshd,bmhd->bhsm', qh, km).astype(jnp.float32) * (MEM_DH ** -0.5)
    p = jax.nn.softmax(s, axis=-1)
    return jnp.einsum('bhsm,bmhd->bshd', p.astype(vm.dtype), vm)


def moe(xn, w_router, b_router, w_up, b_up, w_down, b_down):
    B, S, D = xn.shape
    N = B * S
    xf = xn.reshape(N, D)
    logits = (xf @ w_router).astype(jnp.float32) + b_router.astype(jnp.float32)
    top_vals, top_idx = lax.top_k(logits, TOP_K)
    gates = jax.nn.softmax(top_vals, axis=-1).astype(xn.dtype)
    A = N * TOP_K
    e_flat = top_idx.reshape(A).astype(jnp.int32)
    g_flat = gates.reshape(A)
    tok_flat = jnp.arange(A, dtype=jnp.int32) // TOP_K
    order = jnp.argsort(e_flat)
    e_sorted = e_flat[order]
    counts = jnp.zeros((N_EXPERTS,), jnp.int32).at[e_flat].add(1)
    padded = (counts + MOE_BLOCK - 1) // MOE_BLOCK * MOE_BLOCK
    pad_end = jnp.cumsum(padded)
    pad_start = pad_end - padded
    start = jnp.cumsum(counts) - counts
    dest = pad_start[e_sorted] + (jnp.arange(A, dtype=jnp.int32) - start[e_sorted])
    n_rows = -(-(A + N_EXPERTS * (MOE_BLOCK - 1)) // MOE_BLOCK) * MOE_BLOCK
    nb = n_rows // MOE_BLOCK
    row_tok = jnp.zeros((n_rows,), jnp.int32).at[dest].set(tok_flat[order])
    row_gate = jnp.zeros((n_rows,), xn.dtype).at[dest].set(g_flat[order])
    block_e = jnp.minimum(jnp.searchsorted(pad_end, jnp.arange(nb, dtype=jnp.int32) * MOE_BLOCK,
                                           side='right'), N_EXPERTS - 1).astype(jnp.int32)

    def expert_block(args):
        toks, e = args
        h = xf[toks] @ w_up[e] + b_up[e]
        gate = jnp.minimum(h[:, :D_FF], SWIGLU_LIMIT)
        up = jnp.clip(h[:, D_FF:], -SWIGLU_LIMIT, SWIGLU_LIMIT)
        act = gate * jax.nn.sigmoid(SWIGLU_ALPHA * gate) * (up + 1.0)
        return act @ w_down[e] + b_down[e]

    y_rows = lax.map(expert_block, (row_tok.reshape(nb, MOE_BLOCK), block_e))
    y_rows = y_rows.reshape(n_rows, D) * row_gate[:, None]
    y = jnp.zeros((N, D), y_rows.dtype).at[row_tok].add(y_rows)
    return y.reshape(B, S, D).astype(xn.dtype)


def setup_inputs(seed: int = 0) -> dict:
    key = jax.random.key(seed)
    ks = jax.random.split(key, 24)
    nrm = jax.random.normal
    L = DEPTH

    def gain(k, *shape):
        return 1.0 + 0.02 * nrm(k, (L,) + shape, jnp.float32)

    return {
        'x': nrm(ks[0], (BATCH, SEQ, D_MODEL), jnp.float32),
        'mem': nrm(ks[1], (BATCH, N_MEM, D_MODEL), jnp.float32),
        'g_attn_norm': gain(ks[2], D_MODEL),
        'g_mem_norm': gain(ks[3], D_MODEL),
        'w_in': nrm(ks[4], (L, D_MODEL, D_IN), jnp.float32) * D_MODEL ** -0.5,
        'w_gla_a2': nrm(ks[5], (L, GLA_LOWRANK, GLA_KW), jnp.float32) * GLA_LOWRANK ** -0.5,
        'b_gla_a': 0.1 * nrm(ks[6], (L, GLA_KW), jnp.float32),
        'g_gla_out': gain(ks[7], GLA_VW),
        'b_fox_f': jax.random.uniform(ks[8], (L, FOX_HEADS), jnp.float32, 1.0, 4.0),
        'g_fox_out': gain(ks[9], FOX_W),
        'w_mem_kv': nrm(ks[10], (L, D_MODEL, 2 * MEM_W), jnp.float32) * D_MODEL ** -0.5,
        'g_mem_out': gain(ks[11], MEM_W),
        'w_out': nrm(ks[12], (L, D_MIX, D_MODEL), jnp.float32) * D_MIX ** -0.5,
        'g_ffn_norm': gain(ks[13], D_MODEL),
        'w_router': nrm(ks[14], (L, D_MODEL, N_EXPERTS), jnp.float32) * D_MODEL ** -0.5,
        'b_router': 0.01 * nrm(ks[15], (L, N_EXPERTS), jnp.float32),
        'w_moe_up': nrm(ks[16], (L, N_EXPERTS, D_MODEL, 2 * D_FF), jnp.float32) * D_MODEL ** -0.5,
        'b_moe_up': 0.01 * nrm(ks[17], (L, N_EXPERTS, 2 * D_FF), jnp.float32),
        'w_moe_down': nrm(ks[18], (L, N_EXPERTS, D_FF, D_MODEL), jnp.float32) * D_FF ** -0.5,
        'b_moe_down': 0.01 * nrm(ks[19], (L, N_EXPERTS, D_MODEL), jnp.float32),
        'g_final': 1.0 + 0.02 * nrm(ks[20], (D_MODEL,), jnp.float32),
    }


def reference(x, mem, g_attn_norm, g_mem_norm, w_in, w_gla_a2, b_gla_a, g_gla_out, b_fox_f,
              g_fox_out, w_mem_kv, g_mem_out, w_out, g_ffn_norm, w_router, b_router,
              w_moe_up, b_moe_up, w_moe_down, b_moe_down, g_final):
    B, S, _ = x.shape
    split_idx = [int(i) for i in np.cumsum(IN_SPLITS)[:-1]]
    for l in range(DEPTH):
        h = rms_norm(x, g_attn_norm[l])
        proj = h @ w_in[l]
        q_g, k_g, v_g, gate_g, a_low, q_f, k_f, v_f, f_f, q_m = jnp.split(proj, split_idx, axis=-1)

        gla = gla_mixer(q_g, k_g, v_g, a_low, w_gla_a2[l], b_gla_a[l])
        gla = rms_norm(gla, g_gla_out[l].reshape(GLA_HEADS, GLA_DV)).reshape(B, S, GLA_VW)
        gla = gla.astype(x.dtype) * jax.nn.silu(gate_g)

        fox = fox_mixer(q_f, k_f, v_f, f_f, b_fox_f[l])
        fox = rms_norm(fox, g_fox_out[l].reshape(FOX_HEADS, FOX_DH)).reshape(B, S, FOX_W)

        memo = mem_mixer(q_m, rms_norm(mem, g_mem_norm[l]), w_mem_kv[l])
        memo = rms_norm(memo, g_mem_out[l].reshape(MEM_HEADS, MEM_DH)).reshape(B, S, MEM_W)

        mix = jnp.concatenate([gla.astype(x.dtype), fox.astype(x.dtype), memo.astype(x.dtype)], axis=-1)
        x = x + mix @ w_out[l]

        x = x + moe(rms_norm(x, g_ffn_norm[l]), w_router[l], b_router[l],
                    w_moe_up[l], b_moe_up[l], w_moe_down[l], b_moe_down[l])
    return rms_norm(x, g_final)
```

```cpp
#include <hip/hip_runtime.h>
#include <cstdio>
#include <cstdint>

#define GAS __attribute__((address_space(1)))
#define LAS __attribute__((address_space(3)))
typedef unsigned short bf16_t;
typedef short bf16x8 __attribute__((ext_vector_type(8)));
typedef short s16x4 __attribute__((ext_vector_type(4)));
typedef float f32x2 __attribute__((ext_vector_type(2)));
typedef float f32x4 __attribute__((ext_vector_type(4)));
typedef float f32x16 __attribute__((ext_vector_type(16)));
typedef unsigned u32x2 __attribute__((ext_vector_type(2)));
typedef unsigned u32x4 __attribute__((ext_vector_type(4)));
typedef GAS unsigned gu32;
#define RLX_AGENT __ATOMIC_RELAXED, __HIP_MEMORY_SCOPE_AGENT
#define LDS_WAIT() asm volatile("s_waitcnt lgkmcnt(0)" ::: "memory")
#define VM_WAIT() asm volatile("s_waitcnt vmcnt(0)" ::: "memory")
#define SBAR() __builtin_amdgcn_sched_barrier(0)

#ifndef Y_FP8
#define Y_FP8 1
#endif
#ifndef MOE_FP8
#define MOE_FP8 1
#endif
constexpr int DM = 2048, NB = 4, SEQ = 4096, NTOK = NB * SEQ, NMEM = 256;
constexpr int NPROJ = 5120;
constexpr int C_QG = 0, C_KG = 512, C_VG = 1024, C_GG = 2048, C_QF = 3072, C_KF = 3584, C_VF = 4096, C_QM = 4608;
constexpr int NEXP = 32, TOPK = 4, DFF = 2048, NASSIGN = NTOK * TOPK, MAXTILES = NASSIGN / 256 + NEXP;
constexpr float EPS = 1e-5f;

typedef __bf16 bf16v2_t __attribute__((ext_vector_type(2)));
__device__ __forceinline__ unsigned cvt_pk_bf16(float lo, float hi) { const f32x2 v = {lo, hi}; return __builtin_bit_cast(unsigned, __builtin_convertvector(v, bf16v2_t)); }
__device__ __forceinline__ unsigned pk_fp8x4(float a, float b, float c, float d) { int w = 0; w = __builtin_amdgcn_cvt_pk_fp8_f32(a, b, w, false); w = __builtin_amdgcn_cvt_pk_fp8_f32(c, d, w, true); return (unsigned)w; }
__device__ __forceinline__ float bf2f(unsigned short b) { return __uint_as_float(((unsigned)b) << 16); }
__device__ __forceinline__ bf16x8 pack8(f32x4 a, f32x4 b) { u32x4 w = {cvt_pk_bf16(a[0], a[1]), cvt_pk_bf16(a[2], a[3]), cvt_pk_bf16(b[0], b[1]), cvt_pk_bf16(b[2], b[3])}; return __builtin_bit_cast(bf16x8, w); }
__device__ __forceinline__ unsigned cvt_pk_bf16_raw(float lo, float hi) { unsigned r; asm volatile("v_cvt_pk_bf16_f32 %0, %1, %2" : "=v"(r) : "v"(lo), "v"(hi)); return r; }
__device__ __forceinline__ bf16x8 pack8_raw(f32x4 a, f32x4 b) { u32x4 w = {cvt_pk_bf16_raw(a[0], a[1]), cvt_pk_bf16_raw(a[2], a[3]), cvt_pk_bf16_raw(b[0], b[1]), cvt_pk_bf16_raw(b[2], b[3])}; return __builtin_bit_cast(bf16x8, w); }
__device__ __forceinline__ float wave_sum(float v) {
#pragma unroll
    for (int o = 1; o < 64; o <<= 1) v += __shfl_xor(v, o);
    return v;
}
__device__ __forceinline__ float log_sigmoid(float z) { return fminf(z, 0.f) - log1pf(__expf(-fabsf(z))); }

namespace pg8 {
constexpr int META_OFF = 148480, META_BYTES = 4096;
constexpr int GSLOT_OFF = 131072 + 8192;
constexpr int BM = 256, BK = 64, HALF = 128, HTB = HALF * BK * 2, STAGE_BYTES = 8 * HTB, NXCD = 8, WGM = 8;
__host__ __device__ __forceinline__ int lds_byte(int r, int c) { const int st = (r >> 4) * 2 + (c >> 5), rr = r & 15, cc = c & 31, ob = rr * 64 + cc * 2; return st * 1024 + (ob ^ (((ob >> 9) & 1) << 5)); }
__host__ __device__ __forceinline__ void stage_rc(int b, int& R, int& C) { const int st = b / 1024, sb = b % 1024, swz = sb ^ (((sb >> 9) & 1) << 5); R = (st >> 1) * 16 + swz / 64; C = (st & 1) * 32 + (swz % 64) / 2; }
__host__ __device__ __forceinline__ int perm32(int rho) { const int n = rho >> 4, i = rho & 15; return 8 * (i >> 2) + 4 * n + (i & 3); }

struct Unit { const char* A; const char* B; const int* rowidx; const int* gidx; int pm, pn, e, rows, grows; };

struct StaticOrder {
    const char* A; const char* B; int K; int nM, nN, nwg, G, c;
    __device__ void init(const void* A_, const void* B_, int M, int N, int K_, int G_, int c_) { A = (const char*)A_; B = (const char*)B_; K = K_; nM = M / BM; nN = N / BM; nwg = nM * nN; G = G_; c = c_; }
    __device__ __forceinline__ bool next(int i, Unit& u) const {
        const long L = (long)i * G + c; if (L >= nwg) return false;
        int wgid = (int)L; { const int q = nwg / NXCD, r = nwg % NXCD, xcd = wgid % NXCD, off = wgid / NXCD; wgid = (xcd < r ? xcd * (q + 1) : r * (q + 1) + (xcd - r) * q) + off; }
        const int nig = WGM * nN, gid = wgid / nig, fm = gid * WGM, gsz = (nM - fm) < WGM ? (nM - fm) : WGM;
        u.pm = fm + ((wgid % nig) % gsz); u.pn = (wgid % nig) / gsz; u.e = 0; u.rows = BM; u.rowidx = nullptr; u.gidx = nullptr; u.grows = BM;
        u.A = A + (size_t)u.pm * BM * K * 2; u.B = B + (size_t)u.pn * BM * K * 2; return true;
    }
};

typedef int v4i_t __attribute__((ext_vector_type(4)));
typedef int v8i_t __attribute__((ext_vector_type(8)));
template <class Epi, class Sched, bool GATHER, bool FP8 = false, int SCA = 127, int SCB = 127>
__device__ __forceinline__ void gemm_phase(LAS unsigned char* lds, const int K, const Sched& S, const Epi& E) {
    const int tid = threadIdx.x, wid = __builtin_amdgcn_readfirstlane(tid >> 6), lane = tid & 63, wr = wid >> 2, wc = wid & 3, fr = lane & 15, fq = lane >> 4;
    const int nt = K / BK;
    unsigned voffA[2], voffB[2]; int RA[2], CA[2];
#pragma unroll
    for (int i = 0; i < 2; ++i) { int R, C; stage_rc(tid * 16 + i * 8192, R, C); const int Rb = Epi::PERM ? ((R & ~31) + perm32(R & 31)) : R;
        RA[i] = R; CA[i] = C; voffA[i] = (unsigned)(R * K + C) * 2u; voffB[i] = (unsigned)(Rb * K + C) * 2u; }
    const size_t kstep = (size_t)(BK * 2);
    const size_t hstep = (size_t)HALF * K * 2;
    const unsigned ldsw = (unsigned)wid * 1024u;
    const int aoff = lds_byte(wr * 64 + fr, fq * 8), boff = lds_byte(wc * 32 + fr, fq * 8);
    unsigned gcur[2][2];
#define PG8_SA(b, h) (((b) * 2 + (h)) * HTB)
#define PG8_SB(b, h) ((4 + (b) * 2 + (h)) * HTB)
#define PG8_STAGE(bufoff, gbase, voff) do { _Pragma("unroll") for (int _i = 0; _i < 2; ++_i) \
        __builtin_amdgcn_global_load_lds((const unsigned*)((const char*)(gbase) + (voff)[_i]), (LAS unsigned*)(lds + (bufoff) + ldsw + _i * 8192), 16, 0, 0); } while (0)
#define PG8_STAGE_A(bufoff, base, kb, h, NX) do { if constexpr (GATHER) { PG8_STAGE(bufoff, (base) + (kb), gcur[h]); } \
        else PG8_STAGE(bufoff, (base) + (kb) + (h) * hstep, voffA); } while (0)
#define PG8_LDA(dst, b, h) do { _Pragma("unroll") for (int m = 0; m < 4; ++m) { dst[m].lo = *(const LAS v4i_t*)(lds + PG8_SA(b, h) + aoff + m * 2048); dst[m].hi = *(const LAS v4i_t*)(lds + PG8_SA(b, h) + aoff + m * 2048 + 1024); } } while (0)
#define PG8_LDB(dst, b, h) do { _Pragma("unroll") for (int n = 0; n < 2; ++n) { dst[n].lo = *(const LAS v4i_t*)(lds + PG8_SB(b, h) + boff + n * 2048); dst[n].hi = *(const LAS v4i_t*)(lds + PG8_SB(b, h) + boff + n * 2048 + 1024); } } while (0)
#define PG8_BF(x) __builtin_bit_cast(bf16x8, (v4i_t)(x))
#define PG8_MMA(ai, bj, At, Bt) do { __builtin_amdgcn_s_setprio(1); _Pragma("unroll") for (int m = 0; m < 4; ++m) _Pragma("unroll") for (int n = 0; n < 2; ++n) { \
        if constexpr (FP8) acc[ai][bj][m][n] = __builtin_amdgcn_mfma_scale_f32_16x16x128_f8f6f4(Bt[n], At[m], acc[ai][bj][m][n], 0, 0, 0, SCB * 0x01010101, 0, SCA * 0x01010101); \
        else { acc[ai][bj][m][n] = __builtin_amdgcn_mfma_f32_16x16x32_bf16(PG8_BF(Bt[n].lo), PG8_BF(At[m].lo), acc[ai][bj][m][n], 0, 0, 0); \
               acc[ai][bj][m][n] = __builtin_amdgcn_mfma_f32_16x16x32_bf16(PG8_BF(Bt[n].hi), PG8_BF(At[m].hi), acc[ai][bj][m][n], 0, 0, 0); } } \
        __builtin_amdgcn_s_setprio(0); } while (0)
#define PG8_WAIT_V(n) asm volatile("s_waitcnt vmcnt(" #n ")" ::: "memory")
#define PG8_WAIT_L(n) asm volatile("s_waitcnt lgkmcnt(" #n ")" ::: "memory")
#define PG8_BAR __builtin_amdgcn_s_barrier()
#define PG8_SCHED __builtin_amdgcn_sched_barrier(0)
#define PG8_GIDX(dst, u) do { _Pragma("unroll") for (int _h = 0; _h < 2; ++_h) _Pragma("unroll") for (int _i = 0; _i < 2; ++_i) { \
        const int _r = _h * HALF + RA[_i]; const int _t = (u).gidx[_r < (u).grows ? _r : 0] >> 2; dst[_h][_i] = (unsigned)(_t * K + CA[_i]) * 2u; } } while (0)
#define PG8_GPOST(u) do { _Pragma("unroll") for (int _h = 0; _h < 2; ++_h) _Pragma("unroll") for (int _i = 0; _i < 2; ++_i) { const int _r = _h * HALF + RA[_i]; \
        __builtin_amdgcn_global_load_lds((const unsigned*)((u).gidx + (_r < (u).grows ? _r : 0)), (LAS unsigned*)(lds + GSLOT_OFF + (_h * 2 + _i) * 2048 + wid * 256), 4, 0, 0); } } while (0)
#define PG8_GTAKE() do { _Pragma("unroll") for (int _h = 0; _h < 2; ++_h) _Pragma("unroll") for (int _i = 0; _i < 2; ++_i) { \
        const int _t = *(const LAS int*)(lds + GSLOT_OFF + (_h * 2 + _i) * 2048 + wid * 256 + lane * 4) >> 2; gcur[_h][_i] = (unsigned)(_t * K + CA[_i]) * 2u; } } while (0)
    Unit cur, nxt; int ui = 0;
    if (!S.next(0, cur)) return;
    f32x4 acc[2][2][4][2];
#pragma unroll
    for (int a = 0; a < 2; ++a)
#pragma unroll
        for (int b = 0; b < 2; ++b)
#pragma unroll
            for (int m = 0; m < 4; ++m)
#pragma unroll
                for (int n = 0; n < 2; ++n) acc[a][b][m][n] = (f32x4){0.f, 0.f, 0.f, 0.f};
    v8i_t At[4], B0[2], B1[2];
    const char* cA = cur.A; const char* cB = cur.B;
    if constexpr (GATHER) { PG8_GIDX(gcur, cur); }
    PG8_STAGE(PG8_SB(0, 0), cB, voffB); PG8_STAGE(PG8_SB(0, 1), cB + hstep, voffB); PG8_STAGE_A(PG8_SA(0, 0), cA, 0, 0, false); PG8_STAGE_A(PG8_SA(0, 1), cA, 0, 1, false);
    if (wr == 1) PG8_BAR;
    PG8_WAIT_V(2); PG8_BAR;
    PG8_STAGE(PG8_SB(1, 0), cB + kstep, voffB); PG8_STAGE_A(PG8_SA(1, 0), cA, kstep, 0, false); PG8_STAGE(PG8_SB(1, 1), cB + hstep + kstep, voffB);
    PG8_WAIT_V(6); PG8_BAR;
    for (;;) {
        const bool has_next = S.next(ui + 1, nxt);
        const char* nA = has_next ? nxt.A : cA; const char* nB = has_next ? nxt.B : cB;
        if constexpr (GATHER) { if (has_next) { PG8_GPOST(nxt); } else { PG8_GPOST(cur); } }
        if constexpr (Epi::META) E.post(cur, lds + META_OFF + (ui & 1) * META_BYTES, wid, lane);
        for (int t = 0; t < nt; t += 2) {
            const bool last = (t == nt - 2);
            const size_t k1 = (size_t)(t + 1) * kstep;
            const char* a2 = last ? nA : cA; const char* b2 = last ? nB : cB + (size_t)(t + 2) * kstep;
            const size_t ka2 = last ? 0 : (size_t)(t + 2) * kstep, ka3 = ka2 + kstep; const char* b3 = b2 + kstep;
            PG8_LDB(B0, 0, 0); PG8_LDB(B1, 0, 1); PG8_SCHED; PG8_LDA(At, 0, 0); PG8_STAGE_A(PG8_SA(1, 1), cA, k1, 1, false);
            if constexpr (GATHER) { if (last) { PG8_GTAKE(); } }
            PG8_WAIT_V(8); PG8_WAIT_L(0); PG8_BAR; PG8_MMA(0, 0, At, B0); PG8_MMA(0, 1, At, B1); PG8_BAR; PG8_SCHED;
            PG8_LDA(At, 0, 1); PG8_STAGE(PG8_SB(0, 0), b2, voffB); PG8_STAGE(PG8_SB(0, 1), b2 + hstep, voffB); PG8_STAGE_A(PG8_SA(0, 0), a2, ka2, 0, last);
            PG8_WAIT_V(8); PG8_WAIT_L(0); PG8_BAR; PG8_MMA(1, 0, At, B0); PG8_MMA(1, 1, At, B1); PG8_BAR; PG8_SCHED;
            PG8_LDB(B0, 1, 0); PG8_LDB(B1, 1, 1); PG8_SCHED; PG8_LDA(At, 1, 0); PG8_STAGE_A(PG8_SA(0, 1), a2, ka2, 1, last);
            PG8_WAIT_V(8); PG8_WAIT_L(0); PG8_BAR; PG8_MMA(0, 0, At, B0); PG8_MMA(0, 1, At, B1); PG8_BAR; PG8_SCHED;
            PG8_LDA(At, 1, 1); PG8_STAGE(PG8_SB(1, 0), b3, voffB); PG8_STAGE(PG8_SB(1, 1), b3 + hstep, voffB); PG8_STAGE_A(PG8_SA(1, 0), a2, ka3, 0, last);
            PG8_WAIT_V(8); PG8_WAIT_L(0); PG8_BAR; PG8_MMA(1, 0, At, B0); PG8_MMA(1, 1, At, B1); PG8_BAR; PG8_SCHED;
        }
        if (wr == 0) PG8_BAR;
        if constexpr (Epi::META) E(acc, cur, wr, wc, fr, fq, lds + META_OFF + (ui & 1) * META_BYTES); else E(acc, cur, wr, wc, fr, fq);
        if (!has_next) break;
#pragma unroll
        for (int a = 0; a < 2; ++a)
#pragma unroll
            for (int b = 0; b < 2; ++b)
#pragma unroll
                for (int m = 0; m < 4; ++m)
#pragma unroll
                    for (int n = 0; n < 2; ++n) acc[a][b][m][n] = (f32x4){0.f, 0.f, 0.f, 0.f};
        cur = nxt; cA = nA; cB = nB; ++ui;
        if (wr == 1) PG8_BAR;
    }
    PG8_WAIT_V(0);
    PG8_BAR;
#undef PG8_SA
#undef PG8_SB
#undef PG8_STAGE
#undef PG8_STAGE_A
#undef PG8_LDA
#undef PG8_LDB
#undef PG8_MMA
#undef PG8_BF
#undef PG8_WAIT_V
#undef PG8_WAIT_L
#undef PG8_BAR
#undef PG8_SCHED
#undef PG8_GIDX
#undef PG8_GPOST
#undef PG8_GTAKE
}
}

namespace fox {
constexpr int D = 128, NW = 8, QBLK = 32, KVBLK = 64, QB = NW * QBLK;
constexpr int SHM_V = KVBLK * D * 2, SHM_K = KVBLK * D * 2;
constexpr int LDS_WS = 2 * SHM_V + 2 * SHM_K, LDS_FB = LDS_WS + NW * 64 * 4, LDS_BYTES = LDS_FB + 4096 * 4 + 64;
constexpr float SCALE = 0.08838834764831845f;
constexpr float THR = 8.f;
constexpr int LDQ = NPROJ;
#define KSWZ(row, colB) ((row) * 256 + ((colB) ^ (((row) & 7) << 4)))
__device__ __forceinline__ int v_st(int k, int c) { const int kk = (k & ~0xC) | ((k & 4) << 1) | ((k & 8) >> 1); return ((kk >> 3) * 4 + (c >> 5)) * 512 + ((kk & 7) * 32 + (c & 31)) * 2; }
__device__ __forceinline__ int v_rd_base(int lane) { return ((lane & 3) << 3) | (((lane >> 2) & 3) << 6) | (((lane >> 4) & 1) << 5) | (((lane >> 5) & 1) << 8); }
constexpr int v_rd_off(int d0, int ks, int half) { return d0 * 512 + ks * 4096 + half * 2048; }
__device__ __forceinline__ int crow(int r, int hi) { return (r & 3) + 8 * (r >> 2) + 4 * hi; }
__device__ __forceinline__ unsigned cvtpk(float lo, float hi) { return cvt_pk_bf16(lo, hi); }
__device__ __forceinline__ bf16x8 load8(const bf16_t* p) { return *reinterpret_cast<const bf16x8*>(p); }
__device__ __forceinline__ void mask_tile(f32x16& p0, f32x16& p1, int dq) {
    const float NEG = -__builtin_inff();
#pragma unroll
    for (int r = 0; r < 16; ++r) {
        const int c = (r & 3) + 8 * (r >> 2);
        if (dq - c < 0) p0[r] = NEG;
        if (dq - c - 32 < 0) p1[r] = NEG;
    }
}
__device__ __forceinline__ void partialSM(f32x16& p0, f32x16& p1, float& m_reg, float& mn, float& alpha) {
    float pmax = p0[0]; for (int r = 1; r < 16; ++r) pmax = fmaxf(pmax, p0[r]); for (int r = 0; r < 16; ++r) pmax = fmaxf(pmax, p1[r]);
    { auto rr = __builtin_amdgcn_permlane32_swap(__float_as_uint(pmax), __float_as_uint(pmax), false, false);
      pmax = fmaxf(__uint_as_float(rr[0]), __uint_as_float(rr[1])); }
    constexpr float C2 = 1.4426950408889634f * SCALE;
    if (__builtin_expect(__all((pmax - m_reg) * SCALE <= THR), 1)) { mn = m_reg; alpha = 1.f; }
    else { mn = fmaxf(m_reg, pmax); alpha = __builtin_amdgcn_exp2f((m_reg - mn) * C2); m_reg = mn; }
    const float mnL = -mn * C2;
    for (int r = 0; r < 16; ++r) p0[r] = fmaf(p0[r], C2, mnL); for (int r = 0; r < 16; ++r) p1[r] = fmaf(p1[r], C2, mnL);
    for (int r = 0; r < 16; ++r) p0[r] = __builtin_amdgcn_exp2f(p0[r]);
}
__device__ __forceinline__ void finishSM(f32x16& p0, f32x16& p1, float alpha, float& l_reg, bf16x8& pa0, bf16x8& pa1, bf16x8& pa2, bf16x8& pa3) {
    for (int r = 0; r < 16; ++r) p1[r] = __builtin_amdgcn_exp2f(p1[r]);
    float ps = 0; for (int r = 0; r < 16; ++r) ps += p0[r]; for (int r = 0; r < 16; ++r) ps += p1[r];
    { auto rr = __builtin_amdgcn_permlane32_swap(__float_as_uint(ps), __float_as_uint(ps), false, false);
      ps = __uint_as_float(rr[0]) + __uint_as_float(rr[1]); }
    l_reg = l_reg * alpha + ps;
#define PK4(P, B_, OUT) do { unsigned a0 = cvtpk(P[B_+0], P[B_+1]), a1 = cvtpk(P[B_+2], P[B_+3]);                          \
        unsigned b0 = cvtpk(P[B_+4], P[B_+5]), b1 = cvtpk(P[B_+6], P[B_+7]);                                             \
        auto r0 = __builtin_amdgcn_permlane32_swap(a0, b0, false, false); auto r1 = __builtin_amdgcn_permlane32_swap(a1, b1, false, false); \
        u32x4 w = {r0[0], r1[0], r0[1], r1[1]}; OUT = *reinterpret_cast<bf16x8*>(&w); } while (0)
    PK4(p0, 0, pa0); PK4(p0, 8, pa1); PK4(p1, 0, pa2); PK4(p1, 8, pa3);
#undef PK4
}
template <int KB>
__device__ __forceinline__ void qkt(f32x16& p0, f32x16& p1, const char* K_lds, const float* fb, int r32, int hi, const bf16x8* qr) {
#pragma unroll
    for (int g = 0; g < 4; ++g) { const f32x4 a = *(const f32x4*)(fb + 8 * g), b = *(const f32x4*)(fb + 32 + 8 * g);
        p0[4 * g] = a[0]; p0[4 * g + 1] = a[1]; p0[4 * g + 2] = a[2]; p0[4 * g + 3] = a[3];
        p1[4 * g] = b[0]; p1[4 * g + 1] = b[1]; p1[4 * g + 2] = b[2]; p1[4 * g + 3] = b[3]; }
    const char* kb[4];
#pragma unroll
    for (int dd = 0; dd < 4; ++dd) kb[dd] = K_lds + KB * SHM_K + KSWZ(r32, (dd * 16 + hi * 8) * 2);
#pragma unroll
    for (int d0 = 0; d0 < 8; ++d0) { const char* a = kb[d0 & 3] + (d0 >> 2) * 128;
        bf16x8 b0 = *reinterpret_cast<const bf16x8*>(a);
        bf16x8 b1 = *reinterpret_cast<const bf16x8*>(a + 32 * 256);
        p0 = __builtin_amdgcn_mfma_f32_32x32x16_bf16(b0, qr[d0], p0, 0, 0, 0);
        p1 = __builtin_amdgcn_mfma_f32_32x32x16_bf16(b1, qr[d0], p1, 0, 0, 0); }
}
template <int VB>
__device__ __forceinline__ void pv_tile(f32x16* o, int vb0, bf16x8 pa0, bf16x8 pa1, bf16x8 pa2, bf16x8 pa3) {
#define TRRD(dst, off) asm volatile("ds_read_b64_tr_b16 %0, %1 offset:%2" : "=&v"(dst) : "v"(vb0), "i"(off) : "memory")
#define PV_D0(d0) do { s16x4 l0, l1, l2, l3, h0, h1, h2, h3; constexpr int b_ = VB * SHM_V + v_rd_off(d0, 0, 0); \
        TRRD(l0, b_); TRRD(h0, b_ + 2048); TRRD(l1, b_ + 4096); TRRD(h1, b_ + 6144); TRRD(l2, b_ + 8192); TRRD(h2, b_ + 10240); TRRD(l3, b_ + 12288); TRRD(h3, b_ + 14336); \
        asm volatile("s_waitcnt lgkmcnt(0)" ::: "memory"); SBAR();   \
        o[d0] = __builtin_amdgcn_mfma_f32_32x32x16_bf16(pa0, (bf16x8){l0[0], l0[1], l0[2], l0[3], h0[0], h0[1], h0[2], h0[3]}, o[d0], 0, 0, 0);   \
        o[d0] = __builtin_amdgcn_mfma_f32_32x32x16_bf16(pa1, (bf16x8){l1[0], l1[1], l1[2], l1[3], h1[0], h1[1], h1[2], h1[3]}, o[d0], 0, 0, 0);   \
        o[d0] = __builtin_amdgcn_mfma_f32_32x32x16_bf16(pa2, (bf16x8){l2[0], l2[1], l2[2], l2[3], h2[0], h2[1], h2[2], h2[3]}, o[d0], 0, 0, 0);   \
        o[d0] = __builtin_amdgcn_mfma_f32_32x32x16_bf16(pa3, (bf16x8){l3[0], l3[1], l3[2], l3[3], h3[0], h3[1], h3[2], h3[3]}, o[d0], 0, 0, 0); } while (0)
    PV_D0(0); PV_D0(1); PV_D0(2); PV_D0(3);
#undef PV_D0
#undef TRRD
}
struct BlockRef { const bf16_t* Q; const bf16_t* K; const bf16_t* V; int P0, j_lo, j_hi; };
struct Seam { bf16x8 qr[8]; bf16x8 st_v0, st_v1, st_k0, st_k1; };
#define ROW(p, k0, rr) ((p) + (size_t)((k0) + (rr)) * LDQ + sc)
#define VMWN(n) asm volatile("s_waitcnt vmcnt(%0)" :: "i"(n) : "memory")
#define SLOAD_H(Kp, Vp, k0) do { S.st_v0 = load8(ROW(Vp, k0, sr)); S.st_v1 = load8(ROW(Vp, k0, 32 + sr)); S.st_k0 = load8(ROW(Kp, k0, sr)); S.st_k1 = load8(ROW(Kp, k0, 32 + sr)); } while (0)
#define SWRITE_HK(bf) do { *(bf16x8*)(K_lds + (bf) * SHM_K + kws) = S.st_k0; *(bf16x8*)(K_lds + (bf) * SHM_K + kws + 32 * 256) = S.st_k1; } while (0)
#define SWRITE_HV(bf) do { *(bf16x8*)(V_lds + (bf) * SHM_V + vst0) = S.st_v0; *(bf16x8*)(V_lds + (bf) * SHM_V + vst1) = S.st_v1; } while (0)
#define SWRITE_H(bf) do { SWRITE_HV(bf); SWRITE_HK(bf); } while (0)
__device__ __forceinline__ void prime(const BlockRef& cur, char* lds, Seam& S) {
    const int tid = threadIdx.x, wid = __builtin_amdgcn_readfirstlane(tid >> 6), lane = tid & 63, r32 = lane & 31, hi = lane >> 5;
    const int sr = tid >> 4, sc = (tid & 15) * 8, kws = KSWZ(sr, sc * 2); char* K_lds = lds + 2 * SHM_V;
    const int kb0 = cur.j_lo * KVBLK;
    for (int d0 = 0; d0 < 8; ++d0) S.qr[d0] = load8(cur.Q + (size_t)(wid * QBLK + r32) * LDQ + d0 * 16 + hi * 8);
    SLOAD_H(cur.K, cur.V, kb0); VM_WAIT(); SWRITE_HK(0);
    __syncthreads();
}
template <class Epi>
__device__ __forceinline__ void block(const BlockRef& cur, const BlockRef& nxt, char* lds, Seam& S, const Epi& E) {
    const int tid = threadIdx.x, wid = __builtin_amdgcn_readfirstlane(tid >> 6), lane = tid & 63, r32 = lane & 31, hi = lane >> 5;
    const int j_lo = cur.j_lo, j_hi = cur.j_hi;
    const int NT = j_hi - j_lo;
    const int kbn = nxt.j_lo * KVBLK;
    const int qlo = cur.P0 + wid * QBLK, qm = qlo + r32 - 4 * hi;
    char* V_lds = lds; char* K_lds = lds + 2 * SHM_V;
    float* ws = (float*)(lds + LDS_WS) + wid * 64; float* li_l = ws, * al_l = ws + 32;
    const float* FB = (const float*)(lds + LDS_FB) + 4 * hi;
    float m_reg = -1e30f, l_reg = 0; f32x16 o[4] = {};
    const int sr = tid >> 4, sc = (tid & 15) * 8, vst0 = v_st(sr, sc), vst1 = v_st(32 + sr, sc), kws = KSWZ(sr, sc * 2);
    const int vb0 = (int)(uintptr_t)V_lds + v_rd_base(lane);
    const bf16_t* Kh = cur.K; const bf16_t* Vh = cur.V;
#define RESC(a) do { if (__any((a) < 1.f)) { if (hi == 0) al_l[r32] = (a); asm volatile("s_waitcnt lgkmcnt(0)" ::: "memory");              \
                     for (int d_ = 0; d_ < 4; ++d_) for (int r = 0; r < 16; ++r) o[d_][r] *= al_l[crow(r, hi)]; } } while (0)
#define KBASE(t) ((j_lo + (t)) * KVBLK)
#define MASKT(P0_, P1_, t) do { const int kb_ = KBASE(t); if (kb_ + KVBLK - 1 > qlo) mask_tile(P0_, P1_, qm - kb_); } while (0)
    constexpr int NQL = 8;
#define SEAM_K0() do { VMWN(NQL); SWRITE_HK(0); SBAR(); } while (0)
    f32x16 pA0, pA1, pB0, pB1; float mnA, mnB, alA, alB; bf16x8 pa0, pa1, pa2, pa3;
    SWRITE_HV(0); SBAR();
    if (NT > 1) { SLOAD_H(Kh, Vh, KBASE(1)); }
    SBAR(); qkt<0>(pA0, pA1, K_lds, FB + KBASE(0), r32, hi, S.qr);
    MASKT(pA0, pA1, 0); partialSM(pA0, pA1, m_reg, mnA, alA);
    if (NT > 1) { VM_WAIT(); SWRITE_H(1); }
    __syncthreads();
#define HALF_STEP(PX0, PX1, mnX, alX, PY0, PY1, alY, t, KB, VB, SB) do {                                                      \
        SBAR(); qkt<KB>(PX0, PX1, K_lds, FB + KBASE(t), r32, hi, S.qr);                                                      \
        finishSM(PY0, PY1, alY, l_reg, pa0, pa1, pa2, pa3); SBAR();                                                           \
        if ((t) + 1 < NT) { SLOAD_H(Kh, Vh, KBASE((t) + 1)); SBAR(); }                                                       \
        pv_tile<VB>(o, vb0, pa0, pa1, pa2, pa3); MASKT(PX0, PX1, (t)); partialSM(PX0, PX1, m_reg, mnX, alX);                  \
        __syncthreads();                                                                                                      \
        if ((t) + 1 < NT) { VM_WAIT(); SWRITE_H(SB); }                                                                        \
        RESC(alX); __syncthreads(); } while (0)
    for (int t = 1; t + 1 < NT; t += 2) {
        HALF_STEP(pB0, pB1, mnB, alB, pA0, pA1, alA, t, 1, 0, 0);
        HALF_STEP(pA0, pA1, mnA, alA, pB0, pB1, alB, t + 1, 0, 1, 1);
    }
    const bool even = (NT & 1) == 0;
    if (even) { SBAR(); qkt<1>(pB0, pB1, K_lds, FB + KBASE(NT - 1), r32, hi, S.qr); SBAR(); }
    SLOAD_H(nxt.K, nxt.V, kbn); SBAR();
#pragma unroll
    for (int d0 = 0; d0 < 8; ++d0) S.qr[d0] = load8(nxt.Q + (size_t)(wid * QBLK + r32) * LDQ + d0 * 16 + hi * 8);
    SBAR();
    finishSM(pA0, pA1, alA, l_reg, pa0, pa1, pa2, pa3); SBAR();
    pv_tile<0>(o, vb0, pa0, pa1, pa2, pa3);
    if (even) { MASKT(pB0, pB1, NT - 1); partialSM(pB0, pB1, m_reg, mnB, alB); __syncthreads(); RESC(alB);
        finishSM(pB0, pB1, alB, l_reg, pa0, pa1, pa2, pa3); SBAR(); pv_tile<1>(o, vb0, pa0, pa1, pa2, pa3); }
    SBAR(); SEAM_K0();
    if (hi == 0) li_l[r32] = l_reg; asm volatile("s_waitcnt lgkmcnt(0)" ::: "memory");
    E(o, li_l, m_reg, cur.P0 + wid * QBLK, r32, hi);
    __syncthreads();
#undef RESC
#undef KBASE
#undef MASKT
#undef SEAM_K0
#undef HALF_STEP
}
#undef ROW
#undef VMWN
#undef SLOAD_H
#undef SWRITE_HK
#undef SWRITE_HV
#undef SWRITE_H
struct EpiNormBf16 {
    bf16_t* out; int ldo; const float* gain;
    __device__ __forceinline__ void operator()(const f32x16* o, const float* li_l, float  , int row0, int r32, int hi) const {
        const float g0 = gain[r32], g1 = gain[32 + r32], g2 = gain[64 + r32], g3 = gain[96 + r32];
#pragma unroll
        for (int r = 0; r < 16; ++r) { const int orow = crow(r, hi); const float rl = __builtin_amdgcn_rcpf(li_l[orow]);
            const float v0 = o[0][r] * rl, v1 = o[1][r] * rl, v2 = o[2][r] * rl, v3 = o[3][r] * rl;
            float ss = (v0 * v0 + v1 * v1) + (v2 * v2 + v3 * v3);
            ss += __shfl_xor(ss, 1); ss += __shfl_xor(ss, 2); ss += __shfl_xor(ss, 4); ss += __shfl_xor(ss, 8); ss += __shfl_xor(ss, 16);
            const float rs = 1.0f / sqrtf(ss * (1.0f / 128.0f) + EPS);
            u32x2 w; w.x = cvtpk(v0 * rs * g0, v1 * rs * g1); w.y = cvtpk(v2 * rs * g2, v3 * rs * g3);
            *(u32x2*)(out + (size_t)(row0 + orow) * ldo + r32 * 4) = w; }
    }
};
struct EpiPartial {
    float* O; float* ML;
    __device__ __forceinline__ void operator()(const f32x16* o, const float* li_l, float m, int row0, int r32, int hi) const {
#pragma unroll
        for (int r = 0; r < 16; ++r) { const int orow = crow(r, hi); u32x2 w; w.x = cvtpk(o[0][r], o[1][r]); w.y = cvtpk(o[2][r], o[3][r]); *(u32x2*)((bf16_t*)O + (size_t)(row0 + orow) * 512 + r32 * 4) = w; }
        if (hi == 0) *(f32x2*)(ML + (size_t)(row0 + r32) * 8) = (f32x2){m, li_l[r32]};
    }
};
}

constexpr size_t MiB = 1u << 20;
constexpr size_t WS_CTL = 0, CTL_ZERO_BYTES = 65536;
constexpr size_t WS_WSM = 1 * MiB;
constexpr size_t WS_RSTD = 2 * MiB;
constexpr size_t WS_SMALL = 3 * MiB;
constexpr size_t WS_GATE = 5 * MiB;
constexpr size_t WS_ROWLIST = 6 * MiB;
constexpr size_t WS_WMKV = 8 * MiB, WS_WOUT = 12 * MiB, WS_WIN = 20 * MiB;
constexpr size_t WS_MEMB = 40 * MiB;
constexpr size_t WS_KVM = 44 * MiB;
constexpr size_t WS_GLAD = 46 * MiB;
constexpr size_t WS_XB = 48 * MiB;
constexpr size_t WS_PROJ = 112 * MiB;
constexpr size_t WS_MIX = 272 * MiB;
constexpr size_t WS_X1 = 336 * MiB;
constexpr size_t WS_X1B = 464 * MiB;
constexpr size_t WS_GLAKV = 528 * MiB;
constexpr size_t WS_GLAO = 656 * MiB;
constexpr size_t WS_WUP = 720 * MiB;
constexpr size_t WS_WDOWN = 1232 * MiB;
constexpr size_t WS_ACT = 1488 * MiB;
constexpr size_t WS_Y = 1776 * MiB;
constexpr size_t WS_IDENT = 5 * MiB + 512 * 1024;
constexpr size_t WS_LA = 2032 * MiB;
constexpr size_t WS_FOXO = 2064 * MiB;
constexpr size_t WS_FOXML = 2192 * MiB;
constexpr size_t WS_ROWGATE = 2194 * MiB, WS_ROWRSTD = 2196 * MiB;
constexpr size_t WS_END = 2198 * MiB;
constexpr int CW_BAR = 4096;
constexpr int CW_CNT = 8192;

constexpr int RING_BYTES = 131072;
constexpr int TAB_OFF = RING_BYTES;
constexpr int MISC_OFF = 147456;
constexpr int LDS_BYTES = 147456 + 1024 + 8192;

#define XB_TMO      128
#define XB_XCNT(j)  (256  + 64 * (j))
#define XB_XSUB(j)  (1280 + 64 * (j))
#define XB_XGEN(j)  (2304 + 64 * (j))
#define XB_TOP      3328
#define XB_TOPGEN   3392
#define XCD_BAR_WORDS 3456
#define XB_SPIN_CAP (1u << 18)
__device__ __forceinline__ unsigned xb_ld(unsigned* p)              { return __hip_atomic_load(p, __ATOMIC_RELAXED, __HIP_MEMORY_SCOPE_AGENT); }
__device__ __forceinline__ unsigned xb_add(unsigned* p, unsigned v) { return __hip_atomic_fetch_add(p, v, __ATOMIC_RELAXED, __HIP_MEMORY_SCOPE_AGENT); }
__device__ __forceinline__ unsigned xb_xcc_id() { return (unsigned)__builtin_amdgcn_s_getreg((3 << 11) | 20) & 0xFu; }
#define XB_SPIN(cond, bar) do { unsigned _sp = 0; while (cond) { __builtin_amdgcn_s_sleep(1); \
    if ((++_sp & 255u) == 0u) { if (xb_ld(&(bar)[XB_TMO])) break; if (_sp > XB_SPIN_CAP) { atomicAdd(&(bar)[XB_TMO], 1u); break; } } } } while (0)
struct XcdBarrier { unsigned* bar; unsigned x; volatile LAS unsigned* st; };
__device__ __forceinline__ XcdBarrier xcd_barrier_post(unsigned* bar, volatile LAS unsigned* st) {
    XcdBarrier b; b.bar = bar; b.x = xb_xcc_id(); b.st = st;
    if (threadIdx.x == 0) (void)xb_add(&bar[XB_XCNT(b.x)], 1u);
    return b;
}
__device__ __forceinline__ void xcd_barrier_complete(unsigned* bar, unsigned x, unsigned& nloc, unsigned& nx) {
    const unsigned G = gridDim.x * gridDim.y * gridDim.z;
    unsigned sum, cnt, mine, sp = 0u;
    for (;;) {
        sum = 0u; cnt = 0u; mine = 0u;
#pragma unroll
        for (unsigned j = 0; j < 16; ++j) { const unsigned c = xb_ld(&bar[XB_XCNT(j)]); sum += c; cnt += (c > 0u) ? 1u : 0u; mine = (j == x) ? c : mine; }
        if (sum == G) break;
        __builtin_amdgcn_s_sleep(1);
        if ((++sp & 255u) == 0u) { if (xb_ld(&bar[XB_TMO])) break; if (sp > XB_SPIN_CAP) { atomicAdd(&bar[XB_TMO], 1u); break; } }
    }
    nloc = mine > 0u ? mine : 1u; nx = cnt > 0u ? cnt : 1u;
}
__device__ __forceinline__ void xcd_barrier(const XcdBarrier& b) {
    asm volatile("s_waitcnt vmcnt(0)" ::: "memory");
    __syncthreads();
    if (threadIdx.x == 0) {
        unsigned* bar = b.bar;
        __builtin_amdgcn_s_waitcnt(0);
        unsigned nloc = b.st[0], nx = b.st[1];
        if (nloc == 0u) { xcd_barrier_complete(bar, b.x, nloc, nx); b.st[0] = nloc; b.st[1] = nx; }
        const unsigned old = xb_add(&bar[XB_XSUB(b.x)], 1u);
        const unsigned gen = old / nloc;
        if (old + 1u == (gen + 1u) * nloc) {
            __builtin_amdgcn_fence(__ATOMIC_RELEASE, "agent");
            asm volatile("s_waitcnt vmcnt(0)" ::: "memory");
            const unsigned og = xb_add(&bar[XB_TOP], 1u);
            const unsigned tg = og / nx;
            if (og + 1u == (tg + 1u) * nx) xb_add(&bar[XB_TOPGEN], 1u);
            else XB_SPIN(xb_ld(&bar[XB_TOPGEN]) == tg, bar);
            __builtin_amdgcn_fence(__ATOMIC_ACQUIRE, "agent");
            xb_add(&bar[XB_XGEN(b.x)], 1u);
            asm volatile("s_waitcnt vmcnt(0)" ::: "memory");
        } else {
            XB_SPIN(xb_ld(&bar[XB_XGEN(b.x)]) == gen, bar);
            __builtin_amdgcn_fence(__ATOMIC_ACQUIRE, "agent");
            asm volatile("s_waitcnt vmcnt(0)" ::: "memory");
        }
    }
    __syncthreads();
}

__device__ __forceinline__ unsigned f2bf(float f) { unsigned u = __builtin_bit_cast(unsigned, f); return (u + 0x7fffu + ((u >> 16) & 1u)) >> 16; }
__device__ __forceinline__ unsigned pk2(float lo, float hi) { return f2bf(lo) | (f2bf(hi) << 16); }
__device__ __forceinline__ int head_perm(int x) { return (x & 3) * 32 + (x >> 2); }
template <bool KPERM>
__device__ __forceinline__ void transpose_item(const float* W, size_t ldw, int k0, int scol0, bf16_t* WT, int K, const float* g, float cs, LAS float* scr, int lane) {
#pragma unroll 16
    for (int i = 0; i < 32; ++i) { const int kk = 2 * i + (lane >> 5); int sk = k0 + kk; if (KPERM) sk = (sk & ~127) + head_perm(sk & 127);
        float v = W[(size_t)sk * ldw + scol0 + (lane & 31)]; if (g) v *= g[sk]; scr[kk * 33 + (lane & 31)] = v * cs; }
    LDS_WAIT(); asm volatile("" ::: "memory");
    const int c = lane & 7;
#pragma unroll
    for (int j = 0; j < 4; ++j) { const int n = (lane >> 3) + 8 * j; const LAS float* s = scr + (8 * c) * 33 + n;
        u32x4 o; o.x = pk2(s[0 * 33], s[1 * 33]); o.y = pk2(s[2 * 33], s[3 * 33]); o.z = pk2(s[4 * 33], s[5 * 33]); o.w = pk2(s[6 * 33], s[7 * 33]);
        *(GAS u32x4*)(WT + (size_t)n * K + k0 + 8 * c) = o; }
    LDS_WAIT(); asm volatile("" ::: "memory");
}
template <bool KPERM>
__device__ __forceinline__ void tr_item(const float* W, size_t ldw, int k0, int scol0, bf16_t* WT, int K, const float* g, float cs, LAS unsigned char* scr, int lane) {
    const int kr = lane >> 5, c4 = lane & 31;
    f32x4 a[16], b[16]; float ga[16], gb[16];
#pragma unroll
    for (int i = 0; i < 16; ++i) { int sa = k0 + 4 * i + 2 * kr, sb = sa + 1; if (KPERM) { sa = (sa & ~127) + head_perm(sa & 127); sb = (sb & ~127) + head_perm(sb & 127); }
        a[i] = *(const f32x4*)(W + (size_t)sa * ldw + scol0 + c4 * 4); b[i] = *(const f32x4*)(W + (size_t)sb * ldw + scol0 + c4 * 4);
        ga[i] = g ? g[sa] * cs : cs; gb[i] = g ? g[sb] * cs : cs; }
#pragma unroll
    for (int i = 0; i < 16; ++i) {
#pragma unroll
        for (int j = 0; j < 4; ++j) *(LAS unsigned*)(scr + (4 * c4 + j) * 144 + (2 * i + kr) * 4) = cvt_pk_bf16(a[i][j] * ga[i], b[i][j] * gb[i]); }
    LDS_WAIT(); asm volatile("" ::: "memory");
    const int q = lane & 7;
#pragma unroll
    for (int t = 0; t < 16; ++t) { const int n = 8 * t + (lane >> 3); const u32x4 v = *(const LAS u32x4*)(scr + n * 144 + q * 16);
        *(GAS u32x4*)(WT + (size_t)n * K + k0 + 8 * q) = v; }
    LDS_WAIT(); asm volatile("" ::: "memory");
}
__device__ __forceinline__ void tr_item_fp8(const float* W, size_t ldw, int k0, int scol0, unsigned char* WT, int K, const float* g, float cs, LAS unsigned char* scr, int lane) {
    const int kr = lane >> 4, c4 = lane & 15;
    const float* wl = W + (size_t)(4 * kr) * ldw + scol0 + c4 * 4;
    f32x4 a[8][4]; f32x4 gs[8];
#pragma unroll
    for (int i = 0; i < 8; ++i) {
#pragma unroll
        for (int t = 0; t < 4; ++t) a[i][t] = __builtin_nontemporal_load((const f32x4*)(wl + (size_t)(k0 + 16 * i + t) * ldw));
        gs[i] = g ? *(const f32x4*)(g + k0 + 16 * i + 4 * kr) * cs : (f32x4){cs, cs, cs, cs}; }
#pragma unroll
    for (int i = 0; i < 8; ++i)
#pragma unroll
        for (int j = 0; j < 4; ++j) *(LAS unsigned*)(scr + (4 * c4 + j) * 144 + (4 * i + kr) * 4) = pk_fp8x4(a[i][0][j] * gs[i][0], a[i][1][j] * gs[i][1], a[i][2][j] * gs[i][2], a[i][3][j] * gs[i][3]);
    LDS_WAIT(); asm volatile("" ::: "memory");
    const int q = lane & 7;
#pragma unroll
    for (int t = 0; t < 8; ++t) { const int n = 8 * t + (lane >> 3); const u32x4 v = *(const LAS u32x4*)(scr + n * 144 + q * 16);
        __builtin_nontemporal_store(v, (u32x4*)(WT + (size_t)n * K + k0 + 16 * q)); }
    LDS_WAIT(); asm volatile("" ::: "memory");
}
__device__ __forceinline__ void thin_item(int which, const float* W, const float* g, int k0, bf16_t* hi, bf16_t* lo, LAS float* scr, int lane) {
#pragma unroll 8
    for (int i = 0; i < 32; ++i) { const int kk = 2 * i + (lane >> 5), n = lane & 31, sk = k0 + kk; float v = 0.f;
        if (which == 0) { if (n < 16) v = W[(size_t)sk * 5140 + 3072 + n]; else if (n < 20) v = W[(size_t)sk * 5140 + 4624 + (n - 16)]; }
        else v = W[(size_t)sk * 32 + n];
        scr[kk * 33 + n] = v * g[sk]; }
    LDS_WAIT(); asm volatile("" ::: "memory");
    const int c = lane & 7;
#pragma unroll
    for (int j = 0; j < 4; ++j) { const int n = (lane >> 3) + 8 * j; const LAS float* s = scr + (8 * c) * 33 + n; float v[8], l[8];
#pragma unroll
        for (int t = 0; t < 8; ++t) { v[t] = s[t * 33]; l[t] = v[t] - __uint_as_float(f2bf(v[t]) << 16); }
        u32x4 o; o.x = pk2(v[0], v[1]); o.y = pk2(v[2], v[3]); o.z = pk2(v[4], v[5]); o.w = pk2(v[6], v[7]);
        *(GAS u32x4*)(hi + (size_t)n * 2048 + k0 + 8 * c) = o;
        o.x = pk2(l[0], l[1]); o.y = pk2(l[2], l[3]); o.z = pk2(l[4], l[5]); o.w = pk2(l[6], l[7]);
        *(GAS u32x4*)(lo + (size_t)n * 2048 + k0 + 8 * c) = o; }
    LDS_WAIT(); asm volatile("" ::: "memory");
}
__device__ __forceinline__ f32x4 bf_up4(bf16x8 h, int half) {
    f32x4 r;
#pragma unroll
    for (int j = 0; j < 4; ++j) r[j] = __uint_as_float(((unsigned)(unsigned short)h[4 * half + j]) << 16);
    return r;
}
template <int NT, bool Q8 = false>
__device__ __forceinline__ void rowpass16(const float* X, int row0, bf16_t* XB, const bf16_t* WT_hi, const bf16_t* WT_lo, f32x4 (&acc)[2], float& rstd_r, int lane) {
    const int r = lane & 15, q = lane >> 4;
    const float* xp = X + (size_t)(row0 + r) * DM + q * 16;
    bf16_t* xo = XB + (size_t)(row0 + r) * DM + q * 16;
    float ss = 0.f; acc[0] = (f32x4){0.f, 0.f, 0.f, 0.f}; acc[1] = acc[0];
#pragma unroll 2
    for (int kb = 0; kb < 32; ++kb) {
        const f32x4 v0 = *(const f32x4*)(xp + kb * 64), v1 = *(const f32x4*)(xp + kb * 64 + 4), v2 = *(const f32x4*)(xp + kb * 64 + 8), v3 = *(const f32x4*)(xp + kb * 64 + 12);
        ss += (v0[0] * v0[0] + v0[1] * v0[1]) + (v0[2] * v0[2] + v0[3] * v0[3]) + (v1[0] * v1[0] + v1[1] * v1[1]) + (v1[2] * v1[2] + v1[3] * v1[3]);
        ss += (v2[0] * v2[0] + v2[1] * v2[1]) + (v2[2] * v2[2] + v2[3] * v2[3]) + (v3[0] * v3[0] + v3[1] * v3[1]) + (v3[2] * v3[2] + v3[3] * v3[3]);
        const bf16x8 h0 = pack8(v0, v1), h1 = pack8(v2, v3);
        if constexpr (Q8) { u32x4 w8 = {pk_fp8x4(v0[0], v0[1], v0[2], v0[3]), pk_fp8x4(v1[0], v1[1], v1[2], v1[3]), pk_fp8x4(v2[0], v2[1], v2[2], v2[3]), pk_fp8x4(v3[0], v3[1], v3[2], v3[3])};
            *(u32x4*)((unsigned char*)XB + (size_t)(row0 + r) * DM + q * 16 + kb * 64) = w8; }
        else { *(bf16x8*)(xo + kb * 64) = h0; *(bf16x8*)(xo + kb * 64 + 8) = h1; }
        if constexpr (NT > 0) {
            const bf16x8 l0 = pack8(v0 - bf_up4(h0, 0), v1 - bf_up4(h0, 1)), l1 = pack8(v2 - bf_up4(h1, 0), v3 - bf_up4(h1, 1));
#pragma unroll
            for (int nt = 0; nt < NT; ++nt) {
                const bf16_t* wh = WT_hi + (size_t)(nt * 16 + r) * DM + kb * 64 + q * 16; const bf16_t* wl = WT_lo + (size_t)(nt * 16 + r) * DM + kb * 64 + q * 16;
                const bf16x8 bh0 = *(const bf16x8*)wh, bh1 = *(const bf16x8*)(wh + 8), bl0 = *(const bf16x8*)wl, bl1 = *(const bf16x8*)(wl + 8);
                acc[nt] = __builtin_amdgcn_mfma_f32_16x16x32_bf16(h0, bh0, acc[nt], 0, 0, 0); acc[nt] = __builtin_amdgcn_mfma_f32_16x16x32_bf16(l0, bh0, acc[nt], 0, 0, 0);
                acc[nt] = __builtin_amdgcn_mfma_f32_16x16x32_bf16(h0, bl0, acc[nt], 0, 0, 0);
                acc[nt] = __builtin_amdgcn_mfma_f32_16x16x32_bf16(h1, bh1, acc[nt], 0, 0, 0); acc[nt] = __builtin_amdgcn_mfma_f32_16x16x32_bf16(l1, bh1, acc[nt], 0, 0, 0);
                acc[nt] = __builtin_amdgcn_mfma_f32_16x16x32_bf16(h1, bl1, acc[nt], 0, 0, 0);
            }
        }
    }
    ss += __shfl_xor(ss, 16); ss += __shfl_xor(ss, 32);
    rstd_r = 1.0f / sqrtf(ss * (1.0f / DM) + EPS);
}

template <bool Q8>
__device__ __forceinline__ void rowpass_wg(const float* X, int row0, bf16_t* XB, const bf16_t* WT_hi, const bf16_t* WT_lo, f32x4 (&acc)[2], float& rstd_r, LAS unsigned char* wlds) {
    const int tid = threadIdx.x, lane = tid & 63, wave = __builtin_amdgcn_readfirstlane(tid >> 6), r = lane & 15, q = lane >> 4;
    const int rw = row0 + 16 * wave;
    const float* xp = X + (size_t)(rw + r) * DM + q * 16;
    bf16_t* xo = XB + (size_t)(rw + r) * DM + q * 16;
    float ss = 0.f; acc[0] = (f32x4){0.f, 0.f, 0.f, 0.f}; acc[1] = acc[0];
    f32x4 xa[4][4], xbuf[4][4]; u32x4 wst[4];
#define RW_LOADX(dst, c) do { _Pragma("unroll") for (int k4 = 0; k4 < 4; ++k4) _Pragma("unroll") for (int j = 0; j < 4; ++j) dst[k4][j] = *(const f32x4*)(xp + ((c) * 4 + k4) * 64 + 4 * j); } while (0)
#define RW_LOADW(c) do { _Pragma("unroll") for (int i = 0; i < 4; ++i) { const int p = tid + 512 * i, pp = p & 1023; const bf16_t* src = ((p >> 10) ? WT_lo : WT_hi) + (size_t)(pp >> 5) * DM + (c) * 256 + (pp & 31) * 8; \
        wst[i] = *(const u32x4*)src; } } while (0)
#define RW_STOREW() do { _Pragma("unroll") for (int i = 0; i < 4; ++i) { const int p = tid + 512 * i, pp = p & 1023; *(LAS u32x4*)(wlds + (p >> 10) * 16896 + (pp >> 5) * 528 + (pp & 31) * 16) = wst[i]; } } while (0)
#define RW_USE(src, c) do { _Pragma("unroll") for (int k4 = 0; k4 < 4; ++k4) { asm volatile("" ::: "memory"); const int kb = (c) * 4 + k4; const f32x4 v0 = src[k4][0], v1 = src[k4][1], v2 = src[k4][2], v3 = src[k4][3]; \
        ss += (v0[0] * v0[0] + v0[1] * v0[1]) + (v0[2] * v0[2] + v0[3] * v0[3]) + (v1[0] * v1[0] + v1[1] * v1[1]) + (v1[2] * v1[2] + v1[3] * v1[3]); \
        ss += (v2[0] * v2[0] + v2[1] * v2[1]) + (v2[2] * v2[2] + v2[3] * v2[3]) + (v3[0] * v3[0] + v3[1] * v3[1]) + (v3[2] * v3[2] + v3[3] * v3[3]); \
        const bf16x8 h0 = pack8_raw(v0, v1), h1 = pack8_raw(v2, v3); \
        if constexpr (Q8) { u32x4 w8 = {pk_fp8x4(v0[0], v0[1], v0[2], v0[3]), pk_fp8x4(v1[0], v1[1], v1[2], v1[3]), pk_fp8x4(v2[0], v2[1], v2[2], v2[3]), pk_fp8x4(v3[0], v3[1], v3[2], v3[3])}; \
            *(u32x4*)((unsigned char*)XB + (size_t)(rw + r) * DM + q * 16 + kb * 64) = w8; } \
        else { *(bf16x8*)(xo + kb * 64) = h0; *(bf16x8*)(xo + kb * 64 + 8) = h1; } \
        const bf16x8 l0 = pack8_raw(v0 - bf_up4(h0, 0), v1 - bf_up4(h0, 1)), l1 = pack8_raw(v2 - bf_up4(h1, 0), v3 - bf_up4(h1, 1)); \
        _Pragma("unroll") for (int nt = 0; nt < 2; ++nt) { const LAS unsigned char* wp = wlds + (nt * 16 + r) * 528 + (k4 * 64 + q * 16) * 2; \
            const bf16x8 bh0 = *(const LAS bf16x8*)wp, bh1 = *(const LAS bf16x8*)(wp + 16), bl0 = *(const LAS bf16x8*)(wp + 16896), bl1 = *(const LAS bf16x8*)(wp + 16896 + 16); \
            acc[nt] = __builtin_amdgcn_mfma_f32_16x16x32_bf16(h0, bh0, acc[nt], 0, 0, 0); acc[nt] = __builtin_amdgcn_mfma_f32_16x16x32_bf16(l0, bh0, acc[nt], 0, 0, 0); \
            acc[nt] = __builtin_amdgcn_mfma_f32_16x16x32_bf16(h0, bl0, acc[nt], 0, 0, 0); \
            acc[nt] = __builtin_amdgcn_mfma_f32_16x16x32_bf16(h1, bh1, acc[nt], 0, 0, 0); acc[nt] = __builtin_amdgcn_mfma_f32_16x16x32_bf16(l1, bh1, acc[nt], 0, 0, 0); \
            acc[nt] = __builtin_amdgcn_mfma_f32_16x16x32_bf16(h1, bl1, acc[nt], 0, 0, 0); } } } while (0)
    RW_LOADX(xa, 0);
#pragma unroll 1
    for (int c = 0; c < 8; c += 2) {
        RW_LOADW(c); RW_LOADX(xbuf, c + 1);
        __syncthreads(); RW_STOREW(); LDS_WAIT(); __syncthreads();
        RW_USE(xa, c);
        RW_LOADW(c + 1); if (c + 2 < 8) RW_LOADX(xa, c + 2);
        __syncthreads(); RW_STOREW(); LDS_WAIT(); __syncthreads();
        RW_USE(xbuf, c + 1);
    }
#undef RW_LOADX
#undef RW_LOADW
#undef RW_STOREW
#undef RW_USE
    ss += __shfl_xor(ss, 16); ss += __shfl_xor(ss, 32);
    rstd_r = 1.0f / sqrtf(ss * (1.0f / DM) + EPS);
    __syncthreads();
}

namespace pg8 {
struct EpiRowScaleBf16 {
    static constexpr bool PERM = true, META = false;
    bf16_t* O; int ldc; const float* rowscale;
    __device__ __forceinline__ void operator()(const f32x4 (&acc)[2][2][4][2], const Unit& u, int wr, int wc, int fr, int fq) const {
        const int row0 = u.pm * BM + wr * 64 + fr, col0 = u.pn * BM + wc * 32 + 8 * fq;
        float sc[2][4];
#pragma unroll
        for (int ai = 0; ai < 2; ++ai)
#pragma unroll
            for (int m = 0; m < 4; ++m) sc[ai][m] = rowscale[row0 + ai * HALF + m * 16];
        asm volatile("" : "+v"(sc[0][0]), "+v"(sc[0][1]), "+v"(sc[0][2]), "+v"(sc[0][3]), "+v"(sc[1][0]), "+v"(sc[1][1]), "+v"(sc[1][2]), "+v"(sc[1][3]));
#pragma unroll
        for (int ai = 0; ai < 2; ++ai)
#pragma unroll
            for (int m = 0; m < 4; ++m) { const int row = row0 + ai * HALF + m * 16; const float s = sc[ai][m]; bf16_t* rowp = O + (size_t)row * ldc + col0;
#pragma unroll
                for (int bj = 0; bj < 2; ++bj) { const f32x4 v0 = acc[ai][bj][m][0] * s, v1 = acc[ai][bj][m][1] * s;
                    u32x4 w; w.x = cvt_pk_bf16(v0[0], v0[1]); w.y = cvt_pk_bf16(v0[2], v0[3]); w.z = cvt_pk_bf16(v1[0], v1[1]); w.w = cvt_pk_bf16(v1[2], v1[3]);
                    *(u32x4*)(rowp + bj * HALF) = w; } }
    }
};
struct EpiResF32 {
    static constexpr bool PERM = false, META = false;
    const float* base; float* C; int ldc;
    __device__ __forceinline__ void operator()(const f32x4 (&acc)[2][2][4][2], const Unit& u, int wr, int wc, int fr, int fq) const {
        const int row0 = u.pm * BM + wr * 64 + fr, col0 = u.pn * BM + wc * 32 + 4 * fq;
#pragma unroll
        for (int ai = 0; ai < 2; ++ai) { f32x4 bs[4][2][2];
#pragma unroll
            for (int m = 0; m < 4; ++m)
#pragma unroll
                for (int bj = 0; bj < 2; ++bj)
#pragma unroll
                    for (int n = 0; n < 2; ++n) bs[m][bj][n] = *(const f32x4*)(base + (size_t)(row0 + ai * HALF + m * 16) * ldc + col0 + bj * HALF + n * 16);
#pragma unroll
            for (int m = 0; m < 4; ++m) asm volatile("" : "+v"(bs[m][0][0]), "+v"(bs[m][0][1]), "+v"(bs[m][1][0]), "+v"(bs[m][1][1]));
#pragma unroll
            for (int m = 0; m < 4; ++m)
#pragma unroll
                for (int bj = 0; bj < 2; ++bj)
#pragma unroll
                    for (int n = 0; n < 2; ++n) *(f32x4*)(C + (size_t)(row0 + ai * HALF + m * 16) * ldc + col0 + bj * HALF + n * 16) = bs[m][bj][n] + acc[ai][bj][m][n]; }
    }
};
struct EpiMoeUp {
    static constexpr bool PERM = true, META = false;
    bf16_t* ACT; const float* rstd; const float* bias;
    __device__ __forceinline__ void operator()(const f32x4 (&acc)[2][2][4][2], const Unit& u, int wr, int wc, int fr, int fq) const {
        asm volatile("" : "+v"(fr), "+v"(fq));
        const int j0 = u.pn * HALF + wc * 32 + 8 * fq; const float* bg = bias + (size_t)u.e * 4096 + j0; const float* bu = bg + 2048;
        int tk[2][4];
#pragma unroll
        for (int ai = 0; ai < 2; ++ai)
#pragma unroll
            for (int m = 0; m < 4; ++m) { const int r = ai * HALF + wr * 64 + m * 16 + fr; tk[ai][m] = u.rowidx[r < u.rows ? r : 0]; }
        f32x4 bg0 = *(const f32x4*)bg, bg1 = *(const f32x4*)(bg + 4), bu0 = *(const f32x4*)bu, bu1 = *(const f32x4*)(bu + 4);
        asm volatile("" : "+v"(tk[0][0]), "+v"(tk[0][1]), "+v"(tk[0][2]), "+v"(tk[0][3]), "+v"(tk[1][0]), "+v"(tk[1][1]), "+v"(tk[1][2]), "+v"(tk[1][3]), "+v"(bg0), "+v"(bg1), "+v"(bu0), "+v"(bu1));
        float sc[2][4];
#pragma unroll
        for (int ai = 0; ai < 2; ++ai)
#pragma unroll
            for (int m = 0; m < 4; ++m) sc[ai][m] = rstd[tk[ai][m] >> 2];
        asm volatile("" : "+v"(sc[0][0]), "+v"(sc[0][1]), "+v"(sc[0][2]), "+v"(sc[0][3]), "+v"(sc[1][0]), "+v"(sc[1][1]), "+v"(sc[1][2]), "+v"(sc[1][3]));
#pragma unroll
        for (int ai = 0; ai < 2; ++ai)
#pragma unroll
            for (int m = 0; m < 4; ++m) { const int r = ai * HALF + wr * 64 + m * 16 + fr; const float s = sc[ai][m];
                f32x4 o[2];
#pragma unroll
                for (int n = 0; n < 2; ++n) { const f32x4 g = acc[ai][0][m][n] * s + (n ? bg1 : bg0), up = acc[ai][1][m][n] * s + (n ? bu1 : bu0);
#pragma unroll
                    for (int i = 0; i < 4; ++i) { const float gg = fminf(g[i], 7.0f), uu = fminf(fmaxf(up[i], -7.0f), 7.0f);
                        const float sg = __builtin_amdgcn_rcpf(1.0f + __builtin_amdgcn_exp2f(-1.702f * 1.4426950408889634f * gg)); o[n][i] = gg * sg * (uu + 1.0f); } }
                u32x4 w; w.x = cvt_pk_bf16(o[0][0], o[0][1]); w.y = cvt_pk_bf16(o[0][2], o[0][3]); w.z = cvt_pk_bf16(o[1][0], o[1][1]); w.w = cvt_pk_bf16(o[1][2], o[1][3]);
                *(u32x4*)(ACT + ((size_t)u.pm * BM + r) * DFF + j0) = w; }
    }
};
struct EpiMoeDown {
    static constexpr bool PERM = true, META = true;
    bf16_t* Y; const float* gate; const float* bias;
    __device__ __forceinline__ void post(const Unit& u, LAS unsigned char* mb, int wid, int lane) const {
        const int r = (wid & 3) * 64 + lane, rc = r < u.rows ? r : 0;
        if (wid < 4) { __builtin_amdgcn_global_load_lds((const unsigned*)(u.rowidx + rc), (LAS unsigned*)(mb + wid * 256), 4, 0, 0);
                       __builtin_amdgcn_global_load_lds((const unsigned*)((const char*)(u.rowidx + rc) + (WS_ROWGATE - WS_ROWLIST)), (LAS unsigned*)(mb + 1024 + wid * 256), 4, 0, 0); }
        else __builtin_amdgcn_global_load_lds((const unsigned*)(bias + (size_t)u.e * DM + u.pn * BM + (wid - 4) * 64 + lane), (LAS unsigned*)(mb + 2048 + (wid - 4) * 256), 4, 0, 0);
    }
    __device__ __forceinline__ void operator()(const f32x4 (&acc)[2][2][4][2], const Unit& u, int wr, int wc, int fr, int fq, const LAS unsigned char* mb) const {
        asm volatile("" : "+v"(fr), "+v"(fq));
        const int col0 = u.pn * BM + wc * 32 + 8 * fq;
        f32x4 bv[2][2];
#pragma unroll
        for (int bj = 0; bj < 2; ++bj)
#pragma unroll
            for (int n = 0; n < 2; ++n) bv[bj][n] = *(const LAS f32x4*)(mb + 2048 + (bj * HALF + wc * 32 + 8 * fq + 4 * n) * 4);
#pragma unroll
        for (int ai = 0; ai < 2; ++ai)
#pragma unroll
            for (int m = 0; m < 4; ++m) { const int r = ai * HALF + wr * 64 + m * 16 + fr;
                const int a = (r < u.rows) ? *(const LAS int*)(mb + r * 4) : NASSIGN;
                const float g = *(const LAS float*)(mb + 1024 + r * 4);
#if Y_FP8
                unsigned char* rowp = (unsigned char*)Y + (size_t)a * DM + col0; const float g16 = g * 16.0f;
#pragma unroll
                for (int bj = 0; bj < 2; ++bj) { const f32x4 v0 = (acc[ai][bj][m][0] + bv[bj][0]) * g16, v1 = (acc[ai][bj][m][1] + bv[bj][1]) * g16;
                    u32x2 w; w.x = pk_fp8x4(v0[0], v0[1], v0[2], v0[3]); w.y = pk_fp8x4(v1[0], v1[1], v1[2], v1[3]);
                    *(u32x2*)(rowp + bj * HALF) = w; } }
#else
                bf16_t* rowp = Y + (size_t)a * DM + col0;
#pragma unroll
                for (int bj = 0; bj < 2; ++bj) { const f32x4 v0 = (acc[ai][bj][m][0] + bv[bj][0]) * g, v1 = (acc[ai][bj][m][1] + bv[bj][1]) * g;
                    u32x4 w; w.x = cvt_pk_bf16(v0[0], v0[1]); w.y = cvt_pk_bf16(v0[2], v0[3]); w.z = cvt_pk_bf16(v1[0], v1[1]); w.w = cvt_pk_bf16(v1[2], v1[3]);
                    *(u32x4*)(rowp + bj * HALF) = w; } }
#endif
    }
};
struct EpiMoeUpQ {
    static constexpr bool PERM = true, META = true;
    unsigned char* ACT; const float* rstd; const float* bias;
    __device__ __forceinline__ void post(const Unit& u, LAS unsigned char* mb, int wid, int lane) const {
        const int r = (wid & 3) * 64 + lane, rc = r < u.rows ? r : 0;
        if (wid < 4) __builtin_amdgcn_global_load_lds((const unsigned*)((const char*)(u.rowidx + rc) + (WS_ROWRSTD - WS_ROWLIST)), (LAS unsigned*)(mb + wid * 256), 4, 0, 0);
        else __builtin_amdgcn_global_load_lds((const unsigned*)(bias + (size_t)u.e * 4096 + ((wid - 4) >> 1) * 2048 + u.pn * HALF + ((wid - 4) & 1) * 64 + lane), (LAS unsigned*)(mb + 1024 + (wid - 4) * 256), 4, 0, 0);
    }
    __device__ __forceinline__ void operator()(const f32x4 (&acc)[2][2][4][2], const Unit& u, int wr, int wc, int fr, int fq, const LAS unsigned char* mb) const {
        asm volatile("" : "+v"(fr), "+v"(fq));
        const int j0 = u.pn * HALF + wc * 32 + 8 * fq, jl = wc * 32 + 8 * fq;
        const f32x4 bg0 = *(const LAS f32x4*)(mb + 1024 + jl * 4), bg1 = *(const LAS f32x4*)(mb + 1024 + jl * 4 + 16), bu0 = *(const LAS f32x4*)(mb + 1536 + jl * 4), bu1 = *(const LAS f32x4*)(mb + 1536 + jl * 4 + 16);
#pragma unroll
        for (int ai = 0; ai < 2; ++ai)
#pragma unroll
            for (int m = 0; m < 4; ++m) { const int r = ai * HALF + wr * 64 + m * 16 + fr; const float s = *(const LAS float*)(mb + r * 4);
                f32x4 o[2];
#pragma unroll
                for (int n = 0; n < 2; ++n) { const f32x4 g4 = acc[ai][0][m][n] * s + (n ? bg1 : bg0), u4 = acc[ai][1][m][n] * s + (n ? bu1 : bu0);
#pragma unroll
                    for (int hh = 0; hh < 2; ++hh) { f32x2 g = {g4[2 * hh], g4[2 * hh + 1]}, up = {u4[2 * hh], u4[2 * hh + 1]};
                        g = __builtin_elementwise_min(g, (f32x2){7.0f, 7.0f}); up = __builtin_elementwise_min(__builtin_elementwise_max(up, (f32x2){-7.0f, -7.0f}), (f32x2){7.0f, 7.0f});
                        const f32x2 ea = g * (-1.702f * 1.4426950408889634f); f32x2 e; e.x = __builtin_amdgcn_exp2f(ea.x); e.y = __builtin_amdgcn_exp2f(ea.y);
                        const f32x2 d = e + 1.0f; f32x2 sg; sg.x = __builtin_amdgcn_rcpf(d.x); sg.y = __builtin_amdgcn_rcpf(d.y);
                        const f32x2 t = g * 4.0f, r2 = (t * up + t) * sg; o[n][2 * hh] = r2.x; o[n][2 * hh + 1] = r2.y; } }
                u32x2 w; w.x = pk_fp8x4(o[0][0], o[0][1], o[0][2], o[0][3]); w.y = pk_fp8x4(o[1][0], o[1][1], o[1][2], o[1][3]);
                *(u32x2*)(ACT + ((size_t)u.pm * BM + r) * DFF + j0) = w; }
    }
};
struct MoeOrder {
    const char* A; const char* B; const int* rowlist; const int* ident; const LAS int* tab; int NT, K; size_t bexp; int G, c;
    __device__ __forceinline__ bool next(int i, Unit& u) const {
        if (i >= 32) return false;
        const LAS int* en = tab + 1024 + 8 * i;
        const int valid = __builtin_amdgcn_readfirstlane(en[0]); if (!valid) return false;
        const int e = __builtin_amdgcn_readfirstlane(en[1]), ntile = __builtin_amdgcn_readfirstlane(en[2]), pm = __builtin_amdgcn_readfirstlane(en[3]), rows = __builtin_amdgcn_readfirstlane(en[4]),
                  mrow = __builtin_amdgcn_readfirstlane(en[5]);
        u.e = e; u.pn = ntile; u.pm = pm; u.rows = rows;
        u.rowidx = rowlist + (size_t)e * NTOK + (size_t)mrow * BM;
        u.B = B + (size_t)e * bexp + (size_t)ntile * BM * K * 2;
        u.A = A;
        if (ident) { u.gidx = ident + (size_t)u.pm * BM; u.grows = BM; } else { u.gidx = u.rowidx; u.grows = u.rows; }
        return true;
    }
};
}
__device__ __forceinline__ void moe_build_table(LAS int* tab, const unsigned* cnt, int NT) {
    if (threadIdx.x == 0) { int ng = 0, start = 0, slot = 0;
        for (int e = 0; e < NEXP; ++e) { const int c = (int)cnt[e]; const int tiles = (c + 255) >> 8;
            for (int mt0 = 0; mt0 < tiles; mt0 += 8) { const int gsz = (tiles - mt0) < 8 ? (tiles - mt0) : 8; LAS int* en = tab + 8 + 8 * ng;
                en[0] = start; en[1] = e; en[2] = mt0; en[3] = gsz; en[4] = slot + mt0; en[5] = c - mt0 * 256; ++ng; start += gsz * NT; }
            slot += tiles; }
        tab[0] = ng; tab[1] = start; }
    __syncthreads();
    if (threadIdx.x < 32) { const int i = threadIdx.x, G = gridDim.x, c = blockIdx.x; const int total = tab[1], ng = tab[0]; LAS int* en = tab + 1024 + 8 * i;
        const long L = (long)i * G + c;
        if (L >= total) { en[0] = 0; }
        else { int p = (int)L; { const int q = total / pg8::NXCD, r = total % pg8::NXCD, xcd = p % pg8::NXCD, off = p / pg8::NXCD; p = (xcd < r ? xcd * (q + 1) : r * (q + 1) + (xcd - r) * q) + off; }
            int g = 0; while (g + 1 < ng && tab[8 + 8 * (g + 1)] <= p) ++g;
            const LAS int* ge = tab + 8 + 8 * g; const int qn = p - ge[0], gsz = ge[3], ntile = qn / gsz, mi = qn - ntile * gsz, rl = ge[5] - mi * 256;
            en[0] = 1; en[1] = ge[1]; en[2] = ntile; en[3] = ge[4] + mi; en[4] = rl < 256 ? rl : 256; en[5] = ge[2] + mi; } }
    __syncthreads();
}
__device__ __forceinline__ void gla_chunk_kv(int unit, const bf16_t* proj, const float* la, float* KV, float* Dc, char* lds) {
    const int tid = threadIdx.x, wid = __builtin_amdgcn_readfirstlane(tid >> 6), lane = tid & 63, r32 = lane & 31, hi = lane >> 5;
    const int b = unit >> 8, h = (unit >> 6) & 3, c = unit & 63; const size_t tok0 = (size_t)b * SEQ + (size_t)c * 64;
    char* V_lds = lds;
    const int dk = 32 * (wid & 3) + r32, hd = h * 128 + dk;
    float lav[64];
#pragma unroll
    for (int s = 0; s < 64; ++s) lav[s] = la[(tok0 + s) * 512 + hd];
    float kv[4][8];
#pragma unroll
    for (int ks = 0; ks < 4; ++ks)
#pragma unroll
        for (int j = 0; j < 8; ++j) kv[ks][j] = bf2f(proj[(tok0 + 16 * ks + 8 * hi + j) * NPROJ + C_KG + hd]);
    { const int sr = tid >> 4, sc = (tid & 15) * 8;
#pragma unroll
      for (int hf = 0; hf < 2; ++hf) { const bf16_t* vp = proj + (tok0 + sr) * NPROJ + C_VG + h * 256 + hf * 128 + sc;
          const bf16x8 a = *(const bf16x8*)vp, bb = *(const bf16x8*)(vp + (size_t)32 * NPROJ);
          *(bf16x8*)(V_lds + hf * fox::SHM_V + fox::v_st(sr, sc)) = a; *(bf16x8*)(V_lds + hf * fox::SHM_V + fox::v_st(32 + sr, sc)) = bb; } }
    float rsum = 0.f; float fr[4][8];
#pragma unroll
    for (int ks = 3; ks >= 0; --ks)
#pragma unroll
        for (int h2 = 1; h2 >= 0; --h2)
#pragma unroll
            for (int j = 7; j >= 0; --j) { const int s = 16 * ks + 8 * h2 + j;
                const float dec = __builtin_amdgcn_exp2f(rsum * 1.4426950408889634f);
                if (h2 == hi) fr[ks][j] = kv[ks][j] * dec;
                rsum += lav[s]; }
    bf16x8 pa[4];
#pragma unroll
    for (int ks = 0; ks < 4; ++ks) pa[ks] = pack8((f32x4){fr[ks][0], fr[ks][1], fr[ks][2], fr[ks][3]}, (f32x4){fr[ks][4], fr[ks][5], fr[ks][6], fr[ks][7]});
    __syncthreads();
    f32x16 o[4] = {};
    const int vb0 = (int)(uintptr_t)V_lds + fox::v_rd_base(lane);
    if ((wid >> 2) == 0) fox::pv_tile<0>(o, vb0, pa[0], pa[1], pa[2], pa[3]); else fox::pv_tile<1>(o, vb0, pa[0], pa[1], pa[2], pa[3]);
    bf16_t* kvo = (bf16_t*)KV + (size_t)unit * (128 * 256) + (size_t)((wid >> 2) * 128 + r32) * 128 + 32 * (wid & 3) + 4 * hi;
#pragma unroll
    for (int d0 = 0; d0 < 4; ++d0)
#pragma unroll
        for (int g = 0; g < 4; ++g) { u32x2 w; w.x = cvt_pk_bf16(o[d0][4 * g], o[d0][4 * g + 1]); w.y = cvt_pk_bf16(o[d0][4 * g + 2], o[d0][4 * g + 3]); *(u32x2*)(kvo + (size_t)d0 * 32 * 128 + 8 * g) = w; }
    if (hi == 0 && (wid >> 2) == 0) Dc[(size_t)unit * 128 + dk] = __builtin_amdgcn_exp2f(rsum * 1.4426950408889634f);
    __syncthreads();
}
struct GlaSet { bf16x8 kv[4]; bf16x8 qf[4]; };
__device__ __forceinline__ void gla_ld(GlaSet& R, int c, int b, int h, int sl, int mt, const bf16_t* proj, const bf16_t* KV, int r, int q) {
    const bf16_t* kvp = KV + (size_t)((b * 4 + h) * 64 + c) * (128 * 256) + (size_t)(sl * 16 + r) * 128 + 8 * q;
    const bf16_t* qp = proj + ((size_t)b * SEQ + (size_t)c * 64 + 16 * mt + r) * NPROJ + C_QG + h * 128 + 8 * q;
#pragma unroll
    for (int ks = 0; ks < 4; ++ks) { R.qf[ks] = *(const bf16x8*)(qp + 32 * ks); R.kv[ks] = *(const bf16x8*)(kvp + 32 * ks); }
}
__device__ __forceinline__ void gla_step(const GlaSet& R, f32x4 (&S)[4][2], const LAS float* dl, int c, int b, int h, int sl, int mt, float* GO, int r, int q) {
    f32x4 o = {0.f, 0.f, 0.f, 0.f};
#pragma unroll
    for (int ks = 0; ks < 4; ++ks) { const f32x4 d0 = *(const LAS f32x4*)(dl + c * 128 + 32 * ks + 8 * q), d1 = *(const LAS f32x4*)(dl + c * 128 + 32 * ks + 8 * q + 4);
        S[ks][0] = d0 * S[ks][0] + bf_up4(R.kv[ks], 0); S[ks][1] = d1 * S[ks][1] + bf_up4(R.kv[ks], 1);
        o = __builtin_amdgcn_mfma_f32_16x16x32_bf16(pack8(S[ks][0], S[ks][1]), R.qf[ks], o, 0, 0, 0); }
    u32x2 w; w.x = cvt_pk_bf16(o[0], o[1]); w.y = cvt_pk_bf16(o[2], o[3]);
    *(u32x2*)((bf16_t*)GO + ((size_t)b * SEQ + (size_t)c * 64 + 16 * mt + r) * 1024 + h * 256 + sl * 16 + 4 * q) = w;
}
__device__ __forceinline__ void gla_scan(int unit, const bf16_t* proj, const float* KVf, float* GO, const LAS float* dl, int lane) {
    const bf16_t* KV = (const bf16_t*)KVf;
    const int mt = unit & 3, u2 = unit >> 2, b = u2 >> 6, h = (u2 >> 4) & 3, sl = u2 & 15, r = lane & 15, q = lane >> 4;
    f32x4 S[4][2];
#pragma unroll
    for (int ks = 0; ks < 4; ++ks) { S[ks][0] = (f32x4){0.f, 0.f, 0.f, 0.f}; S[ks][1] = S[ks][0]; }
    GlaSet R0, R1, R2, R3;
    gla_ld(R0, 0, b, h, sl, mt, proj, KV, r, q); gla_ld(R1, 1, b, h, sl, mt, proj, KV, r, q); gla_ld(R2, 2, b, h, sl, mt, proj, KV, r, q);
#pragma unroll 1
    for (int c = 0; c < 64; c += 4) {
        gla_ld(R3, c + 3, b, h, sl, mt, proj, KV, r, q);
        gla_step(R0, S, dl, c, b, h, sl, mt, GO, r, q);
        if (c + 4 < 64) gla_ld(R0, c + 4, b, h, sl, mt, proj, KV, r, q);
        gla_step(R1, S, dl, c + 1, b, h, sl, mt, GO, r, q);
        if (c + 4 < 64) gla_ld(R1, c + 5, b, h, sl, mt, proj, KV, r, q);
        gla_step(R2, S, dl, c + 2, b, h, sl, mt, GO, r, q);
        if (c + 4 < 64) gla_ld(R2, c + 6, b, h, sl, mt, proj, KV, r, q);
        gla_step(R3, S, dl, c + 3, b, h, sl, mt, GO, r, q);
    }
    LDS_WAIT(); asm volatile("" ::: "memory");
}
__device__ __forceinline__ void gla_finish8(int th0, const float* GO, const bf16_t* proj, const float* gain, bf16_t* mix, int lane) {
    f32x4 v[8]; u32x2 gw[8];
#pragma unroll
    for (int i = 0; i < 8; ++i) { const int th = th0 + i, tok = th >> 2, h = th & 3;
        { const u32x2 w = *(const u32x2*)((const bf16_t*)GO + (size_t)tok * 1024 + h * 256 + lane * 4); v[i] = (f32x4){__uint_as_float(w.x << 16), __uint_as_float(w.x & 0xffff0000u), __uint_as_float(w.y << 16), __uint_as_float(w.y & 0xffff0000u)}; } gw[i] = *(const u32x2*)(proj + (size_t)tok * NPROJ + C_GG + h * 256 + lane * 4); }
#pragma unroll
    for (int i = 0; i < 8; ++i) { const int th = th0 + i, tok = th >> 2, h = th & 3;
        const float ss = wave_sum((v[i][0] * v[i][0] + v[i][1] * v[i][1]) + (v[i][2] * v[i][2] + v[i][3] * v[i][3]));
        const float rs = 1.0f / sqrtf(ss * (1.0f / 256.0f) + EPS);
        const f32x4 g = *(const f32x4*)(gain + h * 256 + lane * 4);
        const float g0 = __uint_as_float(gw[i].x << 16), g1 = __uint_as_float(gw[i].x & 0xffff0000u), g2 = __uint_as_float(gw[i].y << 16), g3 = __uint_as_float(gw[i].y & 0xffff0000u);
        auto silu = [](float x) { return x * __builtin_amdgcn_rcpf(1.0f + __expf(-x)); };
        u32x2 w; w.x = cvt_pk_bf16(v[i][0] * rs * g[0] * silu(g0), v[i][1] * rs * g[1] * silu(g1)); w.y = cvt_pk_bf16(v[i][2] * rs * g[2] * silu(g2), v[i][3] * rs * g[3] * silu(g3));
        *(u32x2*)(mix + (size_t)tok * DM + h * 256 + lane * 4) = w; }
}

__device__ __forceinline__ void fox_combine8(int th0, const float* PO, const float* ML, const float* gain, bf16_t* mix, int lane) {
    const int l32 = lane & 31, sub = lane >> 5; constexpr float C2 = 1.4426950408889634f * 0.08838834764831845f;
    f32x4 o0[4], o1[4]; f32x2 ml0[4], ml1[4];
#pragma unroll
    for (int i = 0; i < 4; ++i) { const size_t th = (size_t)(th0 + 2 * i + sub);
        { const u32x2 w0 = *(const u32x2*)((const bf16_t*)PO + th * 128 + l32 * 4), w1 = *(const u32x2*)((const bf16_t*)PO + (size_t)NTOK * 512 + th * 128 + l32 * 4);
          o0[i] = (f32x4){__uint_as_float(w0.x << 16), __uint_as_float(w0.x & 0xffff0000u), __uint_as_float(w0.y << 16), __uint_as_float(w0.y & 0xffff0000u)};
          o1[i] = (f32x4){__uint_as_float(w1.x << 16), __uint_as_float(w1.x & 0xffff0000u), __uint_as_float(w1.y << 16), __uint_as_float(w1.y & 0xffff0000u)}; }
        ml0[i] = *(const f32x2*)(ML + th * 2); ml1[i] = *(const f32x2*)(ML + (size_t)NTOK * 8 + th * 2); }
#pragma unroll
    for (int i = 0; i < 4; ++i) { const int th = th0 + 2 * i + sub, tok = th >> 2, h = th & 3;
        const float m = fmaxf(ml0[i][0], ml1[i][0]), a0 = __builtin_amdgcn_exp2f((ml0[i][0] - m) * C2), a1 = __builtin_amdgcn_exp2f((ml1[i][0] - m) * C2);
        const float inv = 1.0f / (ml0[i][1] * a0 + ml1[i][1] * a1);
        const f32x4 v = (o0[i] * a0 + o1[i] * a1) * inv;
        float ss = (v[0] * v[0] + v[1] * v[1]) + (v[2] * v[2] + v[3] * v[3]);
        ss += __shfl_xor(ss, 1); ss += __shfl_xor(ss, 2); ss += __shfl_xor(ss, 4); ss += __shfl_xor(ss, 8); ss += __shfl_xor(ss, 16);
        const float rs = 1.0f / sqrtf(ss * (1.0f / 128.0f) + EPS);
        const float* g = gain + h * 128 + l32;
        u32x2 w; w.x = cvt_pk_bf16(v[0] * rs * g[0], v[1] * rs * g[32]); w.y = cvt_pk_bf16(v[2] * rs * g[64], v[3] * rs * g[96]);
        *(u32x2*)(mix + (size_t)tok * DM + 1024 + h * 128 + l32 * 4) = w; }
}

__device__ __forceinline__ void memkv_tile(int t, const bf16_t* memb, const bf16_t* WT, const float* rstd, bf16_t* KM, bf16_t* VT, int lane) {
    const int rt = t >> 5, ct = t & 31, r = lane & 15, q = lane >> 4;
    const bf16_t* ap = memb + (size_t)(rt * 32 + r) * DM + q * 16; const bf16_t* bp = WT + (size_t)(ct * 32 + r) * DM + q * 16;
    f32x4 acc[2][2] = {};
#pragma unroll 4
    for (int kb = 0; kb < 32; ++kb) {
        bf16x8 a[2][2], bb[2][2];
#pragma unroll
        for (int i = 0; i < 2; ++i)
#pragma unroll
            for (int s = 0; s < 2; ++s) { a[i][s] = *(const bf16x8*)(ap + (size_t)i * 16 * DM + kb * 64 + s * 8); bb[i][s] = *(const bf16x8*)(bp + (size_t)i * 16 * DM + kb * 64 + s * 8); }
#pragma unroll
        for (int i = 0; i < 2; ++i)
#pragma unroll
            for (int j = 0; j < 2; ++j)
#pragma unroll
                for (int s = 0; s < 2; ++s) acc[i][j] = __builtin_amdgcn_mfma_f32_16x16x32_bf16(a[i][s], bb[j][s], acc[i][j], 0, 0, 0);
    }
#pragma unroll
    for (int i = 0; i < 2; ++i) { const int row = rt * 32 + 16 * i + 4 * q;
        const f32x4 rs = *(const f32x4*)(rstd + row);
#pragma unroll
        for (int j = 0; j < 2; ++j) { const int col = ct * 32 + 16 * j + r; const f32x4 v = acc[i][j] * rs;
            if (col < 512) {
#pragma unroll
                for (int tt = 0; tt < 4; ++tt) KM[(size_t)(row + tt) * 512 + col] = (bf16_t)(cvt_pk_bf16(v[tt], 0.f) & 0xffffu); }
            else { const int hd = col - 512, bb2 = row >> 8, key = row & 255; u32x2 w; w.x = cvt_pk_bf16(v[0], v[1]); w.y = cvt_pk_bf16(v[2], v[3]);
                *(u32x2*)(VT + ((size_t)(bb2 * 4 + (hd >> 7)) * 128 + (hd & 127)) * 256 + key) = w; } } }
}
__device__ __forceinline__ void memattn_unit(int bh, int qt, const bf16_t* proj, const LAS unsigned char* kl, const bf16_t* VT, const float* gain, bf16_t* mix, int lane) {
    const int b = bh >> 2, h = bh & 3, r32 = lane & 31, hi = lane >> 5;
    const size_t tok0 = (size_t)b * SEQ + (size_t)qt * 32;
    bf16x8 qr[8];
#pragma unroll
    for (int d0 = 0; d0 < 8; ++d0) qr[d0] = *(const bf16x8*)(proj + (tok0 + r32) * NPROJ + C_QM + h * 128 + d0 * 16 + hi * 8);
    const LAS unsigned char* kp0 = kl + r32 * 272 + hi * 16;
    float mx = -3.0e38f;
#pragma unroll 1
    for (int j = 0; j < 8; ++j) { f32x16 p = {}; const LAS unsigned char* kp = kp0 + j * 32 * 272;
#pragma unroll
        for (int d0 = 0; d0 < 8; ++d0) p = __builtin_amdgcn_mfma_f32_32x32x16_bf16(*(const LAS bf16x8*)(kp + d0 * 32), qr[d0], p, 0, 0, 0);
#pragma unroll
        for (int r = 0; r < 16; ++r) mx = fmaxf(mx, p[r]); }
    { auto rr = __builtin_amdgcn_permlane32_swap(__float_as_uint(mx), __float_as_uint(mx), false, false); mx = fmaxf(__uint_as_float(rr[0]), __uint_as_float(rr[1])); }
    constexpr float C2 = 1.4426950408889634f * 0.08838834764831845f; const float mL = -mx * C2;
    float ps = 0.f;
    f32x16 o[4] = {};
    const bf16_t* vp0 = VT + ((size_t)(b * 4 + h) * 128 + r32) * 256 + 8 * hi;
#define PK4(P, B_, OUT) do { unsigned a0 = cvt_pk_bf16(P[B_+0], P[B_+1]), a1 = cvt_pk_bf16(P[B_+2], P[B_+3]), b0 = cvt_pk_bf16(P[B_+4], P[B_+5]), b1 = cvt_pk_bf16(P[B_+6], P[B_+7]); \
        auto r0 = __builtin_amdgcn_permlane32_swap(a0, b0, false, false); auto r1 = __builtin_amdgcn_permlane32_swap(a1, b1, false, false); \
        u32x4 w = {r0[0], r1[0], r0[1], r1[1]}; OUT = __builtin_bit_cast(bf16x8, w); } while (0)
#pragma unroll 1
    for (int jj = 0; jj < 4; ++jj) { f32x16 p0 = {}, p1 = {}; const LAS unsigned char* kp = kp0 + jj * 64 * 272;
#pragma unroll
        for (int d0 = 0; d0 < 8; ++d0) { p0 = __builtin_amdgcn_mfma_f32_32x32x16_bf16(*(const LAS bf16x8*)(kp + d0 * 32), qr[d0], p0, 0, 0, 0);
                                         p1 = __builtin_amdgcn_mfma_f32_32x32x16_bf16(*(const LAS bf16x8*)(kp + 32 * 272 + d0 * 32), qr[d0], p1, 0, 0, 0); }
#pragma unroll
        for (int r = 0; r < 16; ++r) { p0[r] = __builtin_amdgcn_exp2f(fmaf(p0[r], C2, mL)); p1[r] = __builtin_amdgcn_exp2f(fmaf(p1[r], C2, mL)); ps += p0[r] + p1[r]; }
        bf16x8 pa[4];
        PK4(p0, 0, pa[0]); PK4(p0, 8, pa[1]); PK4(p1, 0, pa[2]); PK4(p1, 8, pa[3]);
        const bf16_t* vp = vp0 + jj * 64;
#pragma unroll
        for (int ks = 0; ks < 4; ++ks)
#pragma unroll
            for (int d0 = 0; d0 < 4; ++d0) o[d0] = __builtin_amdgcn_mfma_f32_32x32x16_bf16(pa[ks], *(const bf16x8*)(vp + (size_t)d0 * 32 * 256 + 16 * ks), o[d0], 0, 0, 0); }
#undef PK4
    { auto rr = __builtin_amdgcn_permlane32_swap(__float_as_uint(ps), __float_as_uint(ps), false, false); ps = __uint_as_float(rr[0]) + __uint_as_float(rr[1]); }
    const float rl = __builtin_amdgcn_rcpf(ps);
    const float g0 = gain[h * 128 + r32], g1 = gain[h * 128 + 32 + r32], g2 = gain[h * 128 + 64 + r32], g3 = gain[h * 128 + 96 + r32];
    bf16_t* out = mix + tok0 * DM + 1536 + h * 128;
#pragma unroll
    for (int r = 0; r < 16; ++r) { const int orow = fox::crow(r, hi); const float rlr = __shfl(rl, orow);
        const float v0 = o[0][r] * rlr, v1 = o[1][r] * rlr, v2 = o[2][r] * rlr, v3 = o[3][r] * rlr;
        float ss = (v0 * v0 + v1 * v1) + (v2 * v2 + v3 * v3);
        ss += __shfl_xor(ss, 1); ss += __shfl_xor(ss, 2); ss += __shfl_xor(ss, 4); ss += __shfl_xor(ss, 8); ss += __shfl_xor(ss, 16);
        const float rs = 1.0f / sqrtf(ss * (1.0f / 128.0f) + EPS);
        u32x2 w; w.x = cvt_pk_bf16(v0 * rs * g0, v1 * rs * g1); w.y = cvt_pk_bf16(v2 * rs * g2, v3 * rs * g3);
        *(u32x2*)(out + (size_t)orow * DM + r32 * 4) = w; }
}

constexpr int NWAVES = 8;
constexpr int CONV_ALL = 49152, CONV_P1 = 3072, CONV_P7 = 3072, CONV_P2 = CONV_ALL - CONV_P1 - CONV_P7;
#ifndef MK_N_LAUNCHES
#define MK_N_LAUNCHES 1
#endif
#ifndef REP_PHASE
#define REP_PHASE -1
#endif
#ifndef REP_EXTRA
#define REP_EXTRA 1
#endif
#define REP_SUB 0
constexpr int PER_PHASE = 11;
constexpr int N_LAUNCHES = MK_N_LAUNCHES;
struct Args {
    const float *x, *mem, *g_attn, *g_mem, *w_in, *w_a2, *b_a, *g_gla, *b_fox, *g_fox, *w_mkv, *g_memo, *w_out, *g_ffn, *w_router, *b_router, *w_up, *b_up, *w_down, *b_down, *g_final;
    float* out; unsigned char* ws; int ph_lo, ph_hi;
};
typedef const __attribute__((address_space(4))) Args* KArgs;
__device__ __forceinline__ KArgs kargs() { KArgs p = (KArgs)__builtin_amdgcn_kernarg_segment_ptr(); asm volatile("" : "+s"(p)); return p; }
__global__ void __launch_bounds__(NWAVES * 64, 2) fwd(Args a_unused) {
    extern __shared__ __attribute__((aligned(16))) unsigned char lds_raw[];
    LAS unsigned char* lds = (LAS unsigned char*)lds_raw;
    const int tid = threadIdx.x, lane = tid & 63, wave = __builtin_amdgcn_readfirstlane(tid >> 6);
    const int G = gridDim.x, bx = blockIdx.x;
    const int vcu = (G % 8 == 0) ? (bx % 8) * (G / 8) + bx / 8 : bx;
    const int gw = vcu * NWAVES + wave, NGW = G * NWAVES;
    unsigned char* ws = kargs()->ws;
    unsigned* ctl = (unsigned*)(ws + WS_CTL);
    volatile LAS unsigned* MISC = (volatile LAS unsigned*)(lds + MISC_OFF);
    for (int u = tid; u < (LDS_BYTES - MISC_OFF) / 4; u += NWAVES * 64) ((LAS unsigned*)(lds + MISC_OFF))[u] = 0u;
    __syncthreads();
    XcdBarrier bar; bar.bar = ctl + CW_BAR; bar.x = 0; bar.st = nullptr;
    if (N_LAUNCHES == 1) bar = xcd_barrier_post(ctl + CW_BAR, MISC + 8);
#define GRID_BAR() do { if (N_LAUNCHES == 1) xcd_barrier(bar); } while (0)
    const int lo = kargs()->ph_lo, hi_ph = kargs()->ph_hi & 0xff, sub = kargs()->ph_hi >> 8;
#define PART(i) (sub == 0 || ((sub >> (i)) & 1))
#ifndef PH_MASK
#define PH_MASK 0xFFFF
#endif
#define IN(k) (((PH_MASK >> (k)) & 1) && lo <= (k) && (k) < hi_ph)
#define BOTH(k) (IN(k) && IN((k) + 1))
    bf16_t* WsmT = (bf16_t*)(ws + WS_WSM); bf16_t* WrT = (bf16_t*)(ws + WS_WSM + 256 * 1024);
    float* rstd1 = (float*)(ws + WS_RSTD); float* rstdm = rstd1 + 16384; float* rstd2 = rstd1 + 32768;
    float* small = (float*)(ws + WS_SMALL); float* gate_a = (float*)(ws + WS_GATE); int* rowlist = (int*)(ws + WS_ROWLIST);
    bf16_t* WmkvT = (bf16_t*)(ws + WS_WMKV); bf16_t* WoutT = (bf16_t*)(ws + WS_WOUT); bf16_t* WinT = (bf16_t*)(ws + WS_WIN);
    bf16_t* memb = (bf16_t*)(ws + WS_MEMB); bf16_t* KM = (bf16_t*)(ws + WS_KVM); bf16_t* VT = (bf16_t*)(ws + WS_KVM + MiB);
    float* glaD = (float*)(ws + WS_GLAD); bf16_t* xb = (bf16_t*)(ws + WS_XB); bf16_t* proj = (bf16_t*)(ws + WS_PROJ); bf16_t* mix = (bf16_t*)(ws + WS_MIX);
    float* x1 = (float*)(ws + WS_X1); bf16_t* x1b = (bf16_t*)(ws + WS_X1B); float* glaKV = (float*)(ws + WS_GLAKV); float* glaO = (float*)(ws + WS_GLAO);
    bf16_t* WupT = (bf16_t*)(ws + WS_WUP); bf16_t* WdownT = (bf16_t*)(ws + WS_WDOWN); bf16_t* act = (bf16_t*)(ws + WS_ACT); bf16_t* ybuf = (bf16_t*)(ws + WS_Y);
    unsigned* cnt = ctl + CW_CNT; float* la = (float*)(ws + WS_LA); int* ident = (int*)(ws + WS_IDENT); float* rowgate = (float*)(ws + WS_ROWGATE); float* rowrstd = (float*)(ws + WS_ROWRSTD);

#if MOE_FP8
#define MOE_CONV_ITEM(r_) do { const int r = (int)(r_); KArgs kq = kargs(); LAS unsigned char* scr = lds + wave * 18432; \
        if (r < 32768) { const int e = r >> 10, q = r & 1023, kb = q >> 6, nb = q & 63, nt = nb >> 2, bj = (nb >> 1) & 1, j64 = nb & 1; \
            tr_item_fp8(kq->w_up + (size_t)e * DM * 4096, 4096, kb * 128, bj * 2048 + nt * 128 + j64 * 64, (unsigned char*)WupT + ((size_t)e * 4096 + nb * 64) * DM, DM, kq->g_ffn, 32.0f, scr, lane); } \
        else { const int r2 = r - 32768, e = r2 >> 9, q = r2 & 511, kb = q >> 5, nb = q & 31; \
            tr_item_fp8(kq->w_down + (size_t)e * DFF * DM, DM, kb * 128, nb * 64, (unsigned char*)WdownT + ((size_t)e * DM + nb * 64) * DFF, DFF, nullptr, 32.0f, scr, lane); } } while (0)
#else
#define MOE_CONV_ITEM(r_) do { const int r = (int)(r_); KArgs kq = kargs(); LAS unsigned char* scr = lds + wave * 18432; \
        if (r < 32768) { const int e = r >> 10, q = r & 1023, kb = q >> 5, nb = q & 31, nt = nb >> 1, bj = nb & 1; \
            tr_item<false>(kq->w_up + (size_t)e * DM * 4096, 4096, kb * 64, bj * 2048 + nt * 128, WupT + ((size_t)e * 4096 + nb * 128) * DM, DM, kq->g_ffn, 1.0f, scr, lane); } \
        else { const int r2 = r - 32768, e = r2 >> 9, q = r2 & 511, kb = q >> 4, nb = q & 15; \
            tr_item<false>(kq->w_down + (size_t)e * DFF * DM, DM, kb * 64, nb * 128, WdownT + ((size_t)e * DM + nb * 128) * DFF, DFF, nullptr, 1.0f, scr, lane); } } while (0)
#endif
    if (IN(0)) {
        KArgs ka = kargs();
        LAS unsigned char* scr = lds + wave * 18432; LAS float* scrf = (LAS float*)scr;
        constexpr int I_IN = 32 * 40, I_OUT = 32 * 16, I_MKV = 32 * 8, I_TH = 32;
        constexpr int NITEMS = I_IN + I_OUT + I_MKV + 2 * I_TH;
        for (int it = gw; it < NITEMS; it += NGW) {
            int r = it;
            if (r < I_IN) { const int kb = r / 40, nb = r % 40, n0 = nb * 128; const int sc0 = n0 < 3072 ? n0 : (n0 < 4608 ? n0 + 16 : n0 + 20);
                tr_item<false>(ka->w_in, 5140, kb * 64, sc0, WinT + (size_t)n0 * DM, DM, ka->g_attn, n0 < 512 ? 0.08838834764831845f : 1.0f, scr, lane); continue; } r -= I_IN;
            if (r < I_OUT) { const int kb = r >> 4, nb = r & 15;
                if (kb < 16) tr_item<false>(ka->w_out, DM, kb * 64, nb * 128, WoutT + (size_t)nb * 128 * DM, DM, nullptr, 1.0f, scr, lane);
                else tr_item<true>(ka->w_out, DM, kb * 64, nb * 128, WoutT + (size_t)nb * 128 * DM, DM, nullptr, 1.0f, scr, lane);
                continue; } r -= I_OUT;
            if (r < I_MKV) { const int kb = r >> 3, nb = r & 7;
                tr_item<false>(ka->w_mkv, 1024, kb * 64, nb * 128, WmkvT + (size_t)nb * 128 * DM, DM, ka->g_mem, 1.0f, scr, lane); continue; } r -= I_MKV;
            if (r < I_TH) { thin_item(0, ka->w_in, ka->g_attn, r * 64, WsmT, WsmT + 32 * 2048, scrf, lane); continue; } r -= I_TH;
            thin_item(1, ka->w_router, ka->g_ffn, r * 64, WrT, WrT + 32 * 2048, scrf, lane);
        }
        for (int i = gw * 64 + lane; i < MAXTILES * 256; i += NGW * 64) ident[i] = i << 2;
        for (int row = gw; row < NB * NMEM; row += NGW) {
            const float* xr = ka->mem + (size_t)row * DM + lane * 4; f32x4 v[8]; float ss = 0.f;
#pragma unroll
            for (int j = 0; j < 8; ++j) v[j] = *(const f32x4*)(xr + j * 256);
#pragma unroll
            for (int j = 0; j < 8; ++j) { ss += (v[j][0] * v[j][0] + v[j][1] * v[j][1]) + (v[j][2] * v[j][2] + v[j][3] * v[j][3]);
                u32x2 w; w.x = cvt_pk_bf16(v[j][0], v[j][1]); w.y = cvt_pk_bf16(v[j][2], v[j][3]); *(u32x2*)(memb + (size_t)row * DM + j * 256 + lane * 4) = w; }
            ss = wave_sum(ss); if (lane == 0) rstdm[row] = 1.0f / sqrtf(ss * (1.0f / DM) + EPS); }
        if (BOTH(0)) GRID_BAR();
    }
    if (IN(1)) {
        KArgs ka = kargs();
        LAS float* alw = (LAS float*)(lds + wave * 1024);
        LAS unsigned char* wl = lds + 8192;
        for (int gq8 = vcu; gq8 < NTOK / 128; gq8 += G) { const int gq = gq8 * 8 + wave; f32x4 acc2[2]; float rs;
            rowpass_wg<false>(ka->x, gq8 * 128, xb, WsmT, WsmT + 32 * 2048, acc2, rs, wl);
            int lane = tid & 63; asm volatile("" : "+v"(lane));
            if (lane < 16) rstd1[gq * 16 + lane] = rs;
            const int r = lane & 15, q = lane >> 4;
#pragma unroll
            for (int i = 0; i < 4; ++i) { const float rr = __shfl(rs, 4 * q + i);
                alw[(4 * q + i) * 16 + r] = acc2[0][i] * rr; small[(size_t)(gq * 16 + 4 * q + i) * 32 + 16 + r] = acc2[1][i] * rr; }
            LDS_WAIT(); asm volatile("" ::: "memory");
#pragma unroll 1
            for (int hb = 0; hb < 8; ++hb) { const int hd = hb * 64 + lane; float w[16];
#pragma unroll
                for (int k2 = 0; k2 < 16; ++k2) w[k2] = ka->w_a2[k2 * 512 + hd];
                const float ba = ka->b_a[hd];
#pragma unroll 4
                for (int rw = 0; rw < 16; ++rw) { const f32x4 a0 = *(const LAS f32x4*)(alw + rw * 16), a1 = *(const LAS f32x4*)(alw + rw * 16 + 4), a2 = *(const LAS f32x4*)(alw + rw * 16 + 8), a3 = *(const LAS f32x4*)(alw + rw * 16 + 12);
                    float z = ba;
                    z += a0[0] * w[0] + a0[1] * w[1] + a0[2] * w[2] + a0[3] * w[3]; z += a1[0] * w[4] + a1[1] * w[5] + a1[2] * w[6] + a1[3] * w[7];
                    z += a2[0] * w[8] + a2[1] * w[9] + a2[2] * w[10] + a2[3] * w[11]; z += a3[0] * w[12] + a3[1] * w[13] + a3[2] * w[14] + a3[3] * w[15];
                    const float ls = fminf(z, 0.f) - __logf(1.0f + __expf(-fabsf(z)));
                    la[(size_t)(gq * 16 + rw) * 512 + hd] = ls * (1.0f / 16.0f); } }
            LDS_WAIT(); asm volatile("" ::: "memory"); }
        for (int t = gw - NTOK / 16; t < 1024; t += NGW) if (t >= 0) memkv_tile(t, memb, WmkvT, rstdm, KM, VT, lane);
        if (NGW == 2048 && gw >= 1024) { for (int it = CONV_P2 + (gw - 1024); it < CONV_P2 + CONV_P1; it += 1024) MOE_CONV_ITEM(it); }
        else if (NGW != 2048) { for (int it = CONV_P2 + gw; it < CONV_P2 + CONV_P1; it += NGW) MOE_CONV_ITEM(it); }
        if (BOTH(1)) GRID_BAR();
    }
    if (IN(2)) {
        KArgs ka = kargs();
        pg8::StaticOrder S; S.init(xb, WinT, NTOK, NPROJ, DM, G, bx);
        pg8::EpiRowScaleBf16 E{proj, NPROJ, rstd1};
        const bool conv_first = (bx & 7) < 4;
        if (conv_first) { for (int it = gw; it < CONV_P2; it += NGW) MOE_CONV_ITEM(it); __syncthreads(); }
        pg8::gemm_phase<pg8::EpiRowScaleBf16, pg8::StaticOrder, false>(lds, DM, S, E);
        if (!conv_first) { __syncthreads(); for (int it = gw; it < CONV_P2; it += NGW) MOE_CONV_ITEM(it); }
        if (BOTH(2)) GRID_BAR();
    }
    if (IN(3)) {
        KArgs ka = kargs();
        if (G == 256) {
            const int j = bx >> 3, bh = 2 * (bx & 7) + (j >> 4), x = j & 7, sh = (j >> 3) & 1, b = bh >> 2, h = bh & 3;
            char* l = (char*)lds_raw; float* Fb = (float*)(l + fox::LDS_FB); float* wsum = (float*)(l + fox::LDS_WS);
            bf16_t* PO = (bf16_t*)(ws + WS_FOXO) + (size_t)sh * NTOK * 512; float* PML = (float*)(ws + WS_FOXML) + (size_t)sh * NTOK * 8;
            {
                const float bf = ka->b_fox[h]; float v[8]; float run = 0.f;
#pragma unroll
                for (int i = 0; i < 8; ++i) { const int k = tid * 8 + i; const float lf = log_sigmoid(small[((size_t)b * SEQ + k) * 32 + 16 + h] + bf); run += lf; v[i] = run; }
                float inc = run;
#pragma unroll
                for (int o = 1; o < 64; o <<= 1) { const float t2 = __shfl_up(inc, o); if (lane >= o) inc += t2; }
                if (lane == 63) wsum[wave] = inc;
                __syncthreads();
                float woff = 0.f; for (int w2 = 0; w2 < wave; ++w2) woff += wsum[w2];
                const float base = woff + inc - run;
#pragma unroll
                for (int i = 0; i < 8; ++i) Fb[tid * 8 + i] = -(base + v[i]) * (1.0f / fox::SCALE);
                __syncthreads(); }
#pragma unroll 1
            for (int pass = 0; pass < 2; ++pass) { const int qb = pass ? 15 - x : x, n = 4 * (qb + 1);
                fox::BlockRef cur; cur.Q = proj + (size_t)(b * SEQ + qb * 256) * NPROJ + C_QF + h * 128; cur.K = proj + (size_t)b * SEQ * NPROJ + C_KF + h * 128; cur.V = proj + (size_t)b * SEQ * NPROJ + C_VF + h * 128;
                cur.P0 = qb * 256; cur.j_lo = sh ? n / 2 : 0; cur.j_hi = sh ? n : n / 2;
                fox::Seam Sm; fox::prime(cur, l, Sm);
                fox::EpiPartial E{(float*)(PO + ((size_t)b * SEQ * 4 + h) * 128), PML + ((size_t)b * SEQ * 4 + h) * 2};
                fox::block<fox::EpiPartial>(cur, cur, l, Sm, E); }
        }
        for (int u = bx; u < 1024; u += G) gla_chunk_kv(u, proj, la, glaKV, glaD, (char*)lds_raw);
        if (BOTH(3)) GRID_BAR();
    }
    if (IN(4)) {
        KArgs ka = kargs();
#pragma unroll 1
        for (int g = vcu; g < 256; g += G) {
            const int bh = g >> 4; int tl = tid, ll = lane; asm volatile("" : "+v"(tl), "+v"(ll));
            { const float* dsrc = glaD + (size_t)bh * 8192; const bf16_t* ksrc = KM + (size_t)((bh >> 2) * 256) * 512 + (bh & 3) * 128;
              f32x4 t[4]; bf16x8 kk[8];
#pragma unroll
              for (int i = 0; i < 4; ++i) t[i] = *(const f32x4*)(dsrc + (i * 512 + tl) * 4);
#pragma unroll
              for (int i = 0; i < 8; ++i) { const int idx = i * 512 + tl; kk[i] = *(const bf16x8*)(ksrc + (size_t)(idx >> 4) * 512 + (idx & 15) * 8); }
#pragma unroll
              for (int i = 0; i < 4; ++i) *(LAS f32x4*)(lds + (i * 512 + tl) * 16) = t[i];
#pragma unroll
              for (int i = 0; i < 8; ++i) { const int idx = i * 512 + tl; *(LAS bf16x8*)(lds + 32768 + (idx >> 4) * 272 + (idx & 15) * 16) = kk[i]; }
              __syncthreads(); }
            if (wave < 4) { if (PART(0)) gla_scan(g * 4 + wave, proj, glaKV, glaO, (const LAS float*)lds, ll); }
            else if (PART(1)) { for (int i = 0; i < 2; ++i) memattn_unit(bh, (g & 15) * 8 + i * 4 + (wave - 4), proj, lds + 32768, VT, ka->g_memo, mix, ll); }
            __syncthreads();
        }
        if (BOTH(4)) GRID_BAR();
    }
    if (IN(5)) {
        KArgs ka = kargs();
        for (int th = gw * 8; th < NTOK * 4; th += NGW * 8) gla_finish8(th, glaO, proj, ka->g_gla, mix, lane);
        for (int th = gw * 8; th < NTOK * 4; th += NGW * 8) fox_combine8(th, (const float*)(ws + WS_FOXO), (const float*)(ws + WS_FOXML), ka->g_fox, mix, lane);
        if (BOTH(5)) GRID_BAR();
    }
    if (IN(6)) {
        KArgs ka = kargs();
        pg8::StaticOrder S; S.init(mix, WoutT, NTOK, DM, DM, G, bx);
        pg8::EpiResF32 E{ka->x, x1, DM};
        pg8::gemm_phase<pg8::EpiResF32, pg8::StaticOrder, false>(lds, DM, S, E);
        if (BOTH(6)) GRID_BAR();
    }
    if (IN(7)) {
        KArgs ka = kargs();
        LAS float* lg = (LAS float*)(lds + wave * 2048);
        LAS unsigned char* wl = lds + 16384;
        for (int gq8 = vcu; gq8 < NTOK / 128; gq8 += G) { const int gq = gq8 * 8 + wave; f32x4 acc2[2]; float rs;
            rowpass_wg<MOE_FP8 != 0>(x1, gq8 * 128, x1b, WrT, WrT + 32 * 2048, acc2, rs, wl);
            int lane = tid & 63; asm volatile("" : "+v"(lane));
            if (lane < 16) rstd2[gq * 16 + lane] = rs;
            const int r = lane & 15, q = lane >> 4;
#pragma unroll
            for (int i = 0; i < 4; ++i) { const float rr = __shfl(rs, 4 * q + i);
                lg[(4 * q + i) * 32 + r] = acc2[0][i] * rr + ka->b_router[r]; lg[(4 * q + i) * 32 + 16 + r] = acc2[1][i] * rr + ka->b_router[16 + r]; }
            LDS_WAIT(); asm volatile("" ::: "memory");
            if (lane < 16) { const int tok = gq * 16 + lane; const float rsrow = rs; float v[32];
#pragma unroll
                for (int e = 0; e < 32; ++e) v[e] = lg[lane * 32 + e];
                int idx[4]; float val[4];
#pragma unroll
                for (int k = 0; k < 4; ++k) { float best = -3.0e38f; int bi = 0;
#pragma unroll
                    for (int e = 0; e < 32; ++e) { const bool better = v[e] > best; best = better ? v[e] : best; bi = better ? e : bi; }
                    idx[k] = bi; val[k] = best;
#pragma unroll
                    for (int e = 0; e < 32; ++e) v[e] = (e == bi) ? -3.0e38f : v[e]; }
                const float e0 = 1.0f, e1 = __expf(val[1] - val[0]), e2 = __expf(val[2] - val[0]), e3 = __expf(val[3] - val[0]); const float inv = 1.0f / (e0 + e1 + e2 + e3);
                const float gt[4] = {e0 * inv, e1 * inv, e2 * inv, e3 * inv};
#pragma unroll
                for (int k = 0; k < 4; ++k) { const int asg = tok * 4 + k; const unsigned pos = atomicAdd(&cnt[idx[k]], 1u); const size_t rp = (size_t)idx[k] * NTOK + pos; rowlist[rp] = asg; rowgate[rp] = gt[k]; rowrstd[rp] = rsrow; } }
            LDS_WAIT(); asm volatile("" ::: "memory");
        }
        if (NGW == 2048 && gw >= 1024) { for (int it = CONV_P2 + CONV_P1 + (gw - 1024); it < CONV_ALL; it += 1024) MOE_CONV_ITEM(it); }
        else if (NGW != 2048) { for (int it = CONV_P2 + CONV_P1 + gw; it < CONV_ALL; it += NGW) MOE_CONV_ITEM(it); }
        if (BOTH(7)) GRID_BAR();
    }
    if (IN(8)) {
        KArgs ka = kargs();
        LAS int* tab = (LAS int*)(lds + TAB_OFF);
        moe_build_table(tab, cnt, 16);
#if MOE_FP8
        pg8::MoeOrder S{(const char*)x1b, (const char*)WupT, rowlist, nullptr, tab, 16, DM / 2, (size_t)4096 * DM, G, bx};
        pg8::EpiMoeUpQ E{(unsigned char*)act, rstd2, ka->b_up};
        pg8::gemm_phase<pg8::EpiMoeUpQ, pg8::MoeOrder, true, true, 127, 122>(lds, DM / 2, S, E);
#else
        pg8::MoeOrder S{(const char*)x1b, (const char*)WupT, rowlist, nullptr, tab, 16, DM, (size_t)4096 * DM * 2, G, bx};
        pg8::EpiMoeUp E{act, rstd2, ka->b_up};
        pg8::gemm_phase<pg8::EpiMoeUp, pg8::MoeOrder, true>(lds, DM, S, E);
#endif
        if (BOTH(8)) GRID_BAR();
    }
    if (IN(9)) {
        KArgs ka = kargs();
        LAS int* tab = (LAS int*)(lds + TAB_OFF);
        __syncthreads();
        moe_build_table(tab, cnt, 8);
#if MOE_FP8
        pg8::MoeOrder S{(const char*)act, (const char*)WdownT, rowlist, ident, tab, 8, DFF / 2, (size_t)DM * DFF, G, bx};
        pg8::EpiMoeDown E{ybuf, gate_a, ka->b_down};
        pg8::gemm_phase<pg8::EpiMoeDown, pg8::MoeOrder, true, true, 125, 122>(lds, DFF / 2, S, E);
#else
        pg8::MoeOrder S{(const char*)act, (const char*)WdownT, rowlist, ident, tab, 8, DFF, (size_t)DM * DFF * 2, G, bx};
        pg8::EpiMoeDown E{ybuf, gate_a, ka->b_down};
        pg8::gemm_phase<pg8::EpiMoeDown, pg8::MoeOrder, true>(lds, DFF, S, E);
#endif
        if (BOTH(9)) GRID_BAR();
    }
    if (IN(10)) {
        KArgs ka = kargs();
        const int lane = (int)__builtin_amdgcn_mbcnt_hi(~0u, __builtin_amdgcn_mbcnt_lo(~0u, 0u));
        for (int tok = gw; tok < NTOK; tok += NGW) {
            f32x4 v[8]; float ss = 0.f;
#if Y_FP8
            unsigned yw[4][8];
#pragma unroll
            for (int j = 0; j < 8; ++j) { v[j] = __builtin_nontemporal_load((const f32x4*)(x1 + (size_t)tok * DM + j * 256 + lane * 4));
#pragma unroll
                for (int k = 0; k < 4; ++k) yw[k][j] = __builtin_nontemporal_load((const unsigned*)((const unsigned char*)ybuf + ((size_t)tok * 4 + k) * DM + j * 256 + lane * 4)); }
#pragma unroll
            for (int j = 0; j < 8; ++j) {
#pragma unroll
                for (int k = 0; k < 4; ++k) { const f32x2 lo = __builtin_amdgcn_cvt_pk_f32_fp8((int)yw[k][j], false), hi2 = __builtin_amdgcn_cvt_pk_f32_fp8((int)yw[k][j], true);
                    v[j][0] += lo[0] * 0.0625f; v[j][1] += lo[1] * 0.0625f; v[j][2] += hi2[0] * 0.0625f; v[j][3] += hi2[1] * 0.0625f; }
#else
            u32x2 yw[4][8];
#pragma unroll
            for (int j = 0; j < 8; ++j) { v[j] = __builtin_nontemporal_load((const f32x4*)(x1 + (size_t)tok * DM + j * 256 + lane * 4));
#pragma unroll
                for (int k = 0; k < 4; ++k) yw[k][j] = __builtin_nontemporal_load((const u32x2*)(ybuf + ((size_t)tok * 4 + k) * DM + j * 256 + lane * 4)); }
#pragma unroll
            for (int j = 0; j < 8; ++j) {
#pragma unroll
                for (int k = 0; k < 4; ++k) { const u32x2 w = yw[k][j];
                    v[j][0] += __uint_as_float(w.x << 16); v[j][1] += __uint_as_float(w.x & 0xffff0000u); v[j][2] += __uint_as_float(w.y << 16); v[j][3] += __uint_as_float(w.y & 0xffff0000u); }
#endif
                ss += (v[j][0] * v[j][0] + v[j][1] * v[j][1]) + (v[j][2] * v[j][2] + v[j][3] * v[j][3]); }
            const float rs = 1.0f / sqrtf(wave_sum(ss) * (1.0f / DM) + EPS);
#pragma unroll
            for (int j = 0; j < 8; ++j) { const f32x4 g = *(const f32x4*)(ka->g_final + j * 256 + lane * 4); __builtin_nontemporal_store(v[j] * rs * g, (f32x4*)(ka->out + (size_t)tok * DM + j * 256 + lane * 4)); }
        }
    }
#undef IN
#undef BOTH
#undef GRID_BAR
}

extern "C" void kernel_launch(void* const* d_in, const int* in_sizes, int n_in, void* d_out, int out_size, void* d_ws, size_t ws_size, hipStream_t stream) {
    static int grid = 0;
    if (grid == 0) {
        if (n_in != 21 || in_sizes[0] != NTOK * DM || out_size != NTOK * DM || ws_size < WS_END) { fprintf(stderr, "kernel_launch: unexpected shapes (n_in %d, in0 %d, out %d, ws %zu)\n", n_in, n_in > 0 ? in_sizes[0] : -1, out_size, ws_size); grid = -1; return; }
        int dev = 0, cus = 0;
        if (hipGetDevice(&dev) != hipSuccess || hipDeviceGetAttribute(&cus, hipDeviceAttributeMultiprocessorCount, dev) != hipSuccess) { grid = -1; return; }
        if (hipFuncSetAttribute((const void*)fwd, hipFuncAttributeMaxDynamicSharedMemorySize, LDS_BYTES) != hipSuccess) { fprintf(stderr, "kernel_launch: hipFuncSetAttribute failed\n"); grid = -1; return; }
        int per_cu = 0; (void)hipOccupancyMaxActiveBlocksPerMultiprocessor(&per_cu, (const void*)fwd, NWAVES * 64, LDS_BYTES); (void)hipGetLastError();
        if (per_cu < 1) fprintf(stderr, "kernel_launch: occupancy query says %d\n", per_cu);
        grid = cus;
    }
    if (grid < 0) return;
    (void)hipMemsetAsync((char*)d_ws + WS_CTL, 0, CTL_ZERO_BYTES, stream);
    Args a{};
    const float** fp = (const float**)&a.x;
    for (int i = 0; i < 21; ++i) fp[i] = (const float*)d_in[i];
    a.out = (float*)d_out; a.ws = (unsigned char*)d_ws;
    if (N_LAUNCHES == 1) { a.ph_lo = 0; a.ph_hi = PER_PHASE; hipLaunchKernelGGL(fwd, dim3(grid), dim3(NWAVES * 64), LDS_BYTES, stream, a); }
    else for (int p = 0; p < PER_PHASE; ++p) { a.ph_lo = p; a.ph_hi = p + 1;
        for (int rep = 0; rep < ((p == REP_PHASE) ? 1 + REP_EXTRA : 1); ++rep) { a.ph_hi = (p + 1) | ((rep > 0 ? REP_SUB : 0) << 8); hipLaunchKernelGGL(fwd, dim3(grid), dim3(NWAVES * 64), LDS_BYTES, stream, a); } }
}
```

```cpp
#include <hip/hip_runtime.h>
#include <cstdio>
#include <cstdint>

#define GAS __attribute__((address_space(1)))
#define LAS __attribute__((address_space(3)))
typedef unsigned short bf16_t;
typedef short bf16x8 __attribute__((ext_vector_type(8)));
typedef short s16x4 __attribute__((ext_vector_type(4)));
typedef float f32x2 __attribute__((ext_vector_type(2)));
typedef float f32x4 __attribute__((ext_vector_type(4)));
typedef float f32x16 __attribute__((ext_vector_type(16)));
typedef unsigned u32x2 __attribute__((ext_vector_type(2)));
typedef unsigned u32x4 __attribute__((ext_vector_type(4)));
typedef GAS unsigned gu32;
#define RLX_AGENT __ATOMIC_RELAXED, __HIP_MEMORY_SCOPE_AGENT
#define LDS_WAIT() asm volatile("s_waitcnt lgkmcnt(0)" ::: "memory")
#define VM_WAIT() asm volatile("s_waitcnt vmcnt(0)" ::: "memory")
#define SBAR() __builtin_amdgcn_sched_barrier(0)

#ifndef Y_FP8
#define Y_FP8 1
#endif
#ifndef MOE_FP8
#define MOE_FP8 1
#endif
constexpr int DM = 2048, NB = 4, SEQ = 4096, NTOK = NB * SEQ, NMEM = 256;
constexpr int NPROJ = 5120;
constexpr int C_QG = 0, C_KG = 512, C_VG = 1024, C_GG = 2048, C_QF = 3072, C_KF = 3584, C_VF = 4096, C_QM = 4608;
constexpr int NEXP = 32, TOPK = 4, DFF = 2048, NASSIGN = NTOK * TOPK, MAXTILES = NASSIGN / 256 + NEXP;
constexpr float EPS = 1e-5f;

typedef __bf16 bf16v2_t __attribute__((ext_vector_type(2)));
__device__ __forceinline__ unsigned cvt_pk_bf16(float lo, float hi) { const f32x2 v = {lo, hi}; return __builtin_bit_cast(unsigned, __builtin_convertvector(v, bf16v2_t)); }
__device__ __forceinline__ unsigned pk_fp8x4(float a, float b, float c, float d) { int w = 0; w = __builtin_amdgcn_cvt_pk_fp8_f32(a, b, w, false); w = __builtin_amdgcn_cvt_pk_fp8_f32(c, d, w, true); return (unsigned)w; }
__device__ __forceinline__ float bf2f(unsigned short b) { return __uint_as_float(((unsigned)b) << 16); }
__device__ __forceinline__ bf16x8 pack8(f32x4 a, f32x4 b) { u32x4 w = {cvt_pk_bf16(a[0], a[1]), cvt_pk_bf16(a[2], a[3]), cvt_pk_bf16(b[0], b[1]), cvt_pk_bf16(b[2], b[3])}; return __builtin_bit_cast(bf16x8, w); }
__device__ __forceinline__ unsigned cvt_pk_bf16_raw(float lo, float hi) { unsigned r; asm volatile("v_cvt_pk_bf16_f32 %0, %1, %2" : "=v"(r) : "v"(lo), "v"(hi)); return r; }
__device__ __forceinline__ bf16x8 pack8_raw(f32x4 a, f32x4 b) { u32x4 w = {cvt_pk_bf16_raw(a[0], a[1]), cvt_pk_bf16_raw(a[2], a[3]), cvt_pk_bf16_raw(b[0], b[1]), cvt_pk_bf16_raw(b[2], b[3])}; return __builtin_bit_cast(bf16x8, w); }
__device__ __forceinline__ float wave_sum(float v) {
#pragma unroll
    for (int o = 1; o < 64; o <<= 1) v += __shfl_xor(v, o);
    return v;
}
__device__ __forceinline__ float log_sigmoid(float z) { return fminf(z, 0.f) - log1pf(__expf(-fabsf(z))); }

namespace pg8 {
constexpr int META_OFF = 148480, META_BYTES = 4096;
constexpr int GSLOT_OFF = 131072 + 8192;
constexpr int BM = 256, BK = 64, HALF = 128, HTB = HALF * BK * 2, STAGE_BYTES = 8 * HTB, NXCD = 8, WGM = 8;
__host__ __device__ __forceinline__ int lds_byte(int r, int c) { const int st = (r >> 4) * 2 + (c >> 5), rr = r & 15, cc = c & 31, ob = rr * 64 + cc * 2; return st * 1024 + (ob ^ (((ob >> 9) & 1) << 5)); }
__host__ __device__ __forceinline__ void stage_rc(int b, int& R, int& C) { const int st = b / 1024, sb = b % 1024, swz = sb ^ (((sb >> 9) & 1) << 5); R = (st >> 1) * 16 + swz / 64; C = (st & 1) * 32 + (swz % 64) / 2; }
__host__ __device__ __forceinline__ int perm32(int rho) { const int n = rho >> 4, i = rho & 15; return 8 * (i >> 2) + 4 * n + (i & 3); }

struct Unit { const char* A; const char* B; const int* rowidx; const int* gidx; int pm, pn, e, rows, grows; };

struct StaticOrder {
    const char* A; const char* B; int K; int nM, nN, nwg, G, c;
    __device__ void init(const void* A_, const void* B_, int M, int N, int K_, int G_, int c_) { A = (const char*)A_; B = (const char*)B_; K = K_; nM = M / BM; nN = N / BM; nwg = nM * nN; G = G_; c = c_; }
    __device__ __forceinline__ bool next(int i, Unit& u) const {
        const long L = (long)i * G + c; if (L >= nwg) return false;
        int wgid = (int)L; { const int q = nwg / NXCD, r = nwg % NXCD, xcd = wgid % NXCD, off = wgid / NXCD; wgid = (xcd < r ? xcd * (q + 1) : r * (q + 1) + (xcd - r) * q) + off; }
        const int nig = WGM * nN, gid = wgid / nig, fm = gid * WGM, gsz = (nM - fm) < WGM ? (nM - fm) : WGM;
        u.pm = fm + ((wgid % nig) % gsz); u.pn = (wgid % nig) / gsz; u.e = 0; u.rows = BM; u.rowidx = nullptr; u.gidx = nullptr; u.grows = BM;
        u.A = A + (size_t)u.pm * BM * K * 2; u.B = B + (size_t)u.pn * BM * K * 2; return true;
    }
};

typedef int v4i_t __attribute__((ext_vector_type(4)));
typedef int v8i_t __attribute__((ext_vector_type(8)));
template <class Epi, class Sched, bool GATHER, bool FP8 = false, int SCA = 127, int SCB = 127>
__device__ __forceinline__ void gemm_phase(LAS unsigned char* lds, const int K, const Sched& S, const Epi& E) {
    const int tid = threadIdx.x, wid = __builtin_amdgcn_readfirstlane(tid >> 6), lane = tid & 63, wr = wid >> 2, wc = wid & 3, fr = lane & 15, fq = lane >> 4;
    const int nt = K / BK;
    unsigned voffA[2], voffB[2]; int RA[2], CA[2];
#pragma unroll
    for (int i = 0; i < 2; ++i) { int R, C; stage_rc(tid * 16 + i * 8192, R, C); const int Rb = Epi::PERM ? ((R & ~31) + perm32(R & 31)) : R;
        RA[i] = R; CA[i] = C; voffA[i] = (unsigned)(R * K + C) * 2u; voffB[i] = (unsigned)(Rb * K + C) * 2u; }
    const size_t kstep = (size_t)(BK * 2);
    const size_t hstep = (size_t)HALF * K * 2;
    const unsigned ldsw = (unsigned)wid * 1024u;
    const int aoff = lds_byte(wr * 64 + fr, fq * 8), boff = lds_byte(wc * 32 + fr, fq * 8);
    unsigned gcur[2][2];
#define PG8_SA(b, h) (((b) * 2 + (h)) * HTB)
#define PG8_SB(b, h) ((4 + (b) * 2 + (h)) * HTB)
#define PG8_STAGE(bufoff, gbase, voff) do { _Pragma("unroll") for (int _i = 0; _i < 2; ++_i) \
        __builtin_amdgcn_global_load_lds((const unsigned*)((const char*)(gbase) + (voff)[_i]), (LAS unsigned*)(lds + (bufoff) + ldsw + _i * 8192), 16, 0, 0); } while (0)
#define PG8_STAGE_A(bufoff, base, kb, h, NX) do { if constexpr (GATHER) { PG8_STAGE(bufoff, (base) + (kb), gcur[h]); } \
        else PG8_STAGE(bufoff, (base) + (kb) + (h) * hstep, voffA); } while (0)
#define PG8_LDA(dst, b, h) do { _Pragma("unroll") for (int m = 0; m < 4; ++m) { dst[m].lo = *(const LAS v4i_t*)(lds + PG8_SA(b, h) + aoff + m * 2048); dst[m].hi = *(const LAS v4i_t*)(lds + PG8_SA(b, h) + aoff + m * 2048 + 1024); } } while (0)
#define PG8_LDB(dst, b, h) do { _Pragma("unroll") for (int n = 0; n < 2; ++n) { dst[n].lo = *(const LAS v4i_t*)(lds + PG8_SB(b, h) + boff + n * 2048); dst[n].hi = *(const LAS v4i_t*)(lds + PG8_SB(b, h) + boff + n * 2048 + 1024); } } while (0)
#define PG8_BF(x) __builtin_bit_cast(bf16x8, (v4i_t)(x))
#define PG8_MMA(ai, bj, At, Bt) do { __builtin_amdgcn_s_setprio(1); _Pragma("unroll") for (int m = 0; m < 4; ++m) _Pragma("unroll") for (int n = 0; n < 2; ++n) { \
        if constexpr (FP8) acc[ai][bj][m][n] = __builtin_amdgcn_mfma_scale_f32_16x16x128_f8f6f4(Bt[n], At[m], acc[ai][bj][m][n], 0, 0, 0, SCB * 0x01010101, 0, SCA * 0x01010101); \
        else { acc[ai][bj][m][n] = __builtin_amdgcn_mfma_f32_16x16x32_bf16(PG8_BF(Bt[n].lo), PG8_BF(At[m].lo), acc[ai][bj][m][n], 0, 0, 0); \
               acc[ai][bj][m][n] = __builtin_amdgcn_mfma_f32_16x16x32_bf16(PG8_BF(Bt[n].hi), PG8_BF(At[m].hi), acc[ai][bj][m][n], 0, 0, 0); } } \
        __builtin_amdgcn_s_setprio(0); } while (0)
#define PG8_WAIT_V(n) asm volatile("s_waitcnt vmcnt(" #n ")" ::: "memory")
#define PG8_WAIT_L(n) asm volatile("s_waitcnt lgkmcnt(" #n ")" ::: "memory")
#define PG8_BAR __builtin_amdgcn_s_barrier()
#define PG8_SCHED __builtin_amdgcn_sched_barrier(0)
#define PG8_GIDX(dst, u) do { _Pragma("unroll") for (int _h = 0; _h < 2; ++_h) _Pragma("unroll") for (int _i = 0; _i < 2; ++_i) { \
        const int _r = _h * HALF + RA[_i]; const int _t = (u).gidx[_r < (u).grows ? _r : 0] >> 2; dst[_h][_i] = (unsigned)(_t * K + CA[_i]) * 2u; } } while (0)
#define PG8_GPOST(u) do { _Pragma("unroll") for (int _h = 0; _h < 2; ++_h) _Pragma("unroll") for (int _i = 0; _i < 2; ++_i) { const int _r = _h * HALF + RA[_i]; \
        __builtin_amdgcn_global_load_lds((const unsigned*)((u).gidx + (_r < (u).grows ? _r : 0)), (LAS unsigned*)(lds + GSLOT_OFF + (_h * 2 + _i) * 2048 + wid * 256), 4, 0, 0); } } while (0)
#define PG8_GTAKE() do { _Pragma("unroll") for (int _h = 0; _h < 2; ++_h) _Pragma("unroll") for (int _i = 0; _i < 2; ++_i) { \
        const int _t = *(const LAS int*)(lds + GSLOT_OFF + (_h * 2 + _i) * 2048 + wid * 256 + lane * 4) >> 2; gcur[_h][_i] = (unsigned)(_t * K + CA[_i]) * 2u; } } while (0)
    Unit cur, nxt; int ui = 0;
    if (!S.next(0, cur)) return;
    f32x4 acc[2][2][4][2];
#pragma unroll
    for (int a = 0; a < 2; ++a)
#pragma unroll
        for (int b = 0; b < 2; ++b)
#pragma unroll
            for (int m = 0; m < 4; ++m)
#pragma unroll
                for (int n = 0; n < 2; ++n) acc[a][b][m][n] = (f32x4){0.f, 0.f, 0.f, 0.f};
    v8i_t At[4], B0[2], B1[2];
    const char* cA = cur.A; const char* cB = cur.B;
    if constexpr (GATHER) { PG8_GIDX(gcur, cur); }
    PG8_STAGE(PG8_SB(0, 0), cB, voffB); PG8_STAGE(PG8_SB(0, 1), cB + hstep, voffB); PG8_STAGE_A(PG8_SA(0, 0), cA, 0, 0, false); PG8_STAGE_A(PG8_SA(0, 1), cA, 0, 1, false);
    if (wr == 1) PG8_BAR;
    PG8_WAIT_V(2); PG8_BAR;
    PG8_STAGE(PG8_SB(1, 0), cB + kstep, voffB); PG8_STAGE_A(PG8_SA(1, 0), cA, kstep, 0, false); PG8_STAGE(PG8_SB(1, 1), cB + hstep + kstep, voffB);
    PG8_WAIT_V(6); PG8_BAR;
    for (;;) {
        const bool has_next = S.next(ui + 1, nxt);
        const char* nA = has_next ? nxt.A : cA; const char* nB = has_next ? nxt.B : cB;
        if constexpr (GATHER) { if (has_next) { PG8_GPOST(nxt); } else { PG8_GPOST(cur); } }
        if constexpr (Epi::META) E.post(cur, lds + META_OFF + (ui & 1) * META_BYTES, wid, lane);
        for (int t = 0; t < nt; t += 2) {
            const bool last = (t == nt - 2);
            const size_t k1 = (size_t)(t + 1) * kstep;
            const char* a2 = last ? nA : cA; const char* b2 = last ? nB : cB + (size_t)(t + 2) * kstep;
            const size_t ka2 = last ? 0 : (size_t)(t + 2) * kstep, ka3 = ka2 + kstep; const char* b3 = b2 + kstep;
            PG8_LDB(B0, 0, 0); PG8_LDB(B1, 0, 1); PG8_SCHED; PG8_LDA(At, 0, 0); PG8_STAGE_A(PG8_SA(1, 1), cA, k1, 1, false);
            if constexpr (GATHER) { if (last) { PG8_GTAKE(); } }
            PG8_WAIT_V(8); PG8_WAIT_L(0); PG8_BAR; PG8_MMA(0, 0, At, B0); PG8_MMA(0, 1, At, B1); PG8_BAR; PG8_SCHED;
            PG8_LDA(At, 0, 1); PG8_STAGE(PG8_SB(0, 0), b2, voffB); PG8_STAGE(PG8_SB(0, 1), b2 + hstep, voffB); PG8_STAGE_A(PG8_SA(0, 0), a2, ka2, 0, last);
            PG8_WAIT_V(8); PG8_WAIT_L(0); PG8_BAR; PG8_MMA(1, 0, At, B0); PG8_MMA(1, 1, At, B1); PG8_BAR; PG8_SCHED;
            PG8_LDB(B0, 1, 0); PG8_LDB(B1, 1, 1); PG8_SCHED; PG8_LDA(At, 1, 0); PG8_STAGE_A(PG8_SA(0, 1), a2, ka2, 1, last);
            PG8_WAIT_V(8); PG8_WAIT_L(0); PG8_BAR; PG8_MMA(0, 0, At, B0); PG8_MMA(0, 1, At, B1); PG8_BAR; PG8_SCHED;
            PG8_LDA(At, 1, 1); PG8_STAGE(PG8_SB(1, 0), b3, voffB); PG8_STAGE(PG8_SB(1, 1), b3 + hstep, voffB); PG8_STAGE_A(PG8_SA(1, 0), a2, ka3, 0, last);
            PG8_WAIT_V(8); PG8_WAIT_L(0); PG8_BAR; PG8_MMA(1, 0, At, B0); PG8_MMA(1, 1, At, B1); PG8_BAR; PG8_SCHED;
        }
        if (wr == 0) PG8_BAR;
        if constexpr (Epi::META) E(acc, cur, wr, wc, fr, fq, lds + META_OFF + (ui & 1) * META_BYTES); else E(acc, cur, wr, wc, fr, fq);
        if (!has_next) break;
#pragma unroll
        for (int a = 0; a < 2; ++a)
#pragma unroll
            for (int b = 0; b < 2; ++b)
#pragma unroll
                for (int m = 0; m < 4; ++m)
#pragma unroll
                    for (int n = 0; n < 2; ++n) acc[a][b][m][n] = (f32x4){0.f, 0.f, 0.f, 0.f};
        cur = nxt; cA = nA; cB = nB; ++ui;
        if (wr == 1) PG8_BAR;
    }
    PG8_WAIT_V(0);
    PG8_BAR;
#undef PG8_SA
#undef PG8_SB
#undef PG8_STAGE
#undef PG8_STAGE_A
#undef PG8_LDA
#undef PG8_LDB
#undef PG8_MMA
#undef PG8_BF
#undef PG8_WAIT_V
#undef PG8_WAIT_L
#undef PG8_BAR
#undef PG8_SCHED
#undef PG8_GIDX
#undef PG8_GPOST
#undef PG8_GTAKE
}
}

namespace fox {
constexpr int D = 128, NW = 8, QBLK = 32, KVBLK = 64, QB = NW * QBLK;
constexpr int SHM_V = KVBLK * D * 2, SHM_K = KVBLK * D * 2;
constexpr int LDS_WS = 2 * SHM_V + 2 * SHM_K, LDS_FB = LDS_WS + NW * 64 * 4, LDS_BYTES = LDS_FB + 4096 * 4 + 64;
constexpr float SCALE = 0.08838834764831845f;
constexpr float THR = 8.f;
constexpr int LDQ = NPROJ;
#define KSWZ(row, colB) ((row) * 256 + ((colB) ^ (((row) & 7) << 4)))
__device__ __forceinline__ int v_st(int k, int c) { const int kk = (k & ~0xC) | ((k & 4) << 1) | ((k & 8) >> 1); return ((kk >> 3) * 4 + (c >> 5)) * 512 + ((kk & 7) * 32 + (c & 31)) * 2; }
__device__ __forceinline__ int v_rd_base(int lane) { return ((lane & 3) << 3) | (((lane >> 2) & 3) << 6) | (((lane >> 4) & 1) << 5) | (((lane >> 5) & 1) << 8); }
constexpr int v_rd_off(int d0, int ks, int half) { return d0 * 512 + ks * 4096 + half * 2048; }
__device__ __forceinline__ int crow(int r, int hi) { return (r & 3) + 8 * (r >> 2) + 4 * hi; }
__device__ __forceinline__ unsigned cvtpk(float lo, float hi) { return cvt_pk_bf16(lo, hi); }
__device__ __forceinline__ bf16x8 load8(const bf16_t* p) { return *reinterpret_cast<const bf16x8*>(p); }
__device__ __forceinline__ void mask_tile(f32x16& p0, f32x16& p1, int dq) {
    const float NEG = -__builtin_inff();
#pragma unroll
    for (int r = 0; r < 16; ++r) {
        const int c = (r & 3) + 8 * (r >> 2);
        if (dq - c < 0) p0[r] = NEG;
        if (dq - c - 32 < 0) p1[r] = NEG;
    }
}
__device__ __forceinline__ void partialSM(f32x16& p0, f32x16& p1, float& m_reg, float& mn, float& alpha) {
    float pmax = p0[0]; for (int r = 1; r < 16; ++r) pmax = fmaxf(pmax, p0[r]); for (int r = 0; r < 16; ++r) pmax = fmaxf(pmax, p1[r]);
    { auto rr = __builtin_amdgcn_permlane32_swap(__float_as_uint(pmax), __float_as_uint(pmax), false, false);
      pmax = fmaxf(__uint_as_float(rr[0]), __uint_as_float(rr[1])); }
    constexpr float C2 = 1.4426950408889634f * SCALE;
    if (__builtin_expect(__all((pmax - m_reg) * SCALE <= THR), 1)) { mn = m_reg; alpha = 1.f; }
    else { mn = fmaxf(m_reg, pmax); alpha = __builtin_amdgcn_exp2f((m_reg - mn) * C2); m_reg = mn; }
    const float mnL = -mn * C2;
    for (int r = 0; r < 16; ++r) p0[r] = fmaf(p0[r], C2, mnL); for (int r = 0; r < 16; ++r) p1[r] = fmaf(p1[r], C2, mnL);
    for (int r = 0; r < 16; ++r) p0[r] = __builtin_amdgcn_exp2f(p0[r]);
}
__device__ __forceinline__ void finishSM(f32x16& p0, f32x16& p1, float alpha, float& l_reg, bf16x8& pa0, bf16x8& pa1, bf16x8& pa2, bf16x8& pa3) {
    for (int r = 0; r < 16; ++r) p1[r] = __builtin_amdgcn_exp2f(p1[r]);
    float ps = 0; for (int r = 0; r < 16; ++r) ps += p0[r]; for (int r = 0; r < 16; ++r) ps += p1[r];
    { auto rr = __builtin_amdgcn_permlane32_swap(__float_as_uint(ps), __float_as_uint(ps), false, false);
      ps = __uint_as_float(rr[0]) + __uint_as_float(rr[1]); }
    l_reg = l_reg * alpha + ps;
#define PK4(P, B_, OUT) do { unsigned a0 = cvtpk(P[B_+0], P[B_+1]), a1 = cvtpk(P[B_+2], P[B_+3]);                          \
        unsigned b0 = cvtpk(P[B_+4], P[B_+5]), b1 = cvtpk(P[B_+6], P[B_+7]);                                             \
        auto r0 = __builtin_amdgcn_permlane32_swap(a0, b0, false, false); auto r1 = __builtin_amdgcn_permlane32_swap(a1, b1, false, false); \
        u32x4 w = {r0[0], r1[0], r0[1], r1[1]}; OUT = *reinterpret_cast<bf16x8*>(&w); } while (0)
    PK4(p0, 0, pa0); PK4(p0, 8, pa1); PK4(p1, 0, pa2); PK4(p1, 8, pa3);
#undef PK4
}
template <int KB>
__device__ __forceinline__ void qkt(f32x16& p0, f32x16& p1, const char* K_lds, const float* fb, int r32, int hi, const bf16x8* qr) {
#pragma unroll
    for (int g = 0; g < 4; ++g) { const f32x4 a = *(const f32x4*)(fb + 8 * g), b = *(const f32x4*)(fb + 32 + 8 * g);
        p0[4 * g] = a[0]; p0[4 * g + 1] = a[1]; p0[4 * g + 2] = a[2]; p0[4 * g + 3] = a[3];
        p1[4 * g] = b[0]; p1[4 * g + 1] = b[1]; p1[4 * g + 2] = b[2]; p1[4 * g + 3] = b[3]; }
    const char* kb[4];
#pragma unroll
    for (int dd = 0; dd < 4; ++dd) kb[dd] = K_lds + KB * SHM_K + KSWZ(r32, (dd * 16 + hi * 8) * 2);
#pragma unroll
    for (int d0 = 0; d0 < 8; ++d0) { const char* a = kb[d0 & 3] + (d0 >> 2) * 128;
        bf16x8 b0 = *reinterpret_cast<const bf16x8*>(a);
        bf16x8 b1 = *reinterpret_cast<const bf16x8*>(a + 32 * 256);
        p0 = __builtin_amdgcn_mfma_f32_32x32x16_bf16(b0, qr[d0], p0, 0, 0, 0);
        p1 = __builtin_amdgcn_mfma_f32_32x32x16_bf16(b1, qr[d0], p1, 0, 0, 0); }
}
template <int VB>
__device__ __forceinline__ void pv_tile(f32x16* o, int vb0, bf16x8 pa0, bf16x8 pa1, bf16x8 pa2, bf16x8 pa3) {
#define TRRD(dst, off) asm volatile("ds_read_b64_tr_b16 %0, %1 offset:%2" : "=&v"(dst) : "v"(vb0), "i"(off) : "memory")
#define PV_D0(d0) do { s16x4 l0, l1, l2, l3, h0, h1, h2, h3; constexpr int b_ = VB * SHM_V + v_rd_off(d0, 0, 0); \
        TRRD(l0, b_); TRRD(h0, b_ + 2048); TRRD(l1, b_ + 4096); TRRD(h1, b_ + 6144); TRRD(l2, b_ + 8192); TRRD(h2, b_ + 10240); TRRD(l3, b_ + 12288); TRRD(h3, b_ + 14336); \
        asm volatile("s_waitcnt lgkmcnt(0)" ::: "memory"); SBAR();   \
        o[d0] = __builtin_amdgcn_mfma_f32_32x32x16_bf16(pa0, (bf16x8){l0[0], l0[1], l0[2], l0[3], h0[0], h0[1], h0[2], h0[3]}, o[d0], 0, 0, 0);   \
        o[d0] = __builtin_amdgcn_mfma_f32_32x32x16_bf16(pa1, (bf16x8){l1[0], l1[1], l1[2], l1[3], h1[0], h1[1], h1[2], h1[3]}, o[d0], 0, 0, 0);   \
        o[d0] = __builtin_amdgcn_mfma_f32_32x32x16_bf16(pa2, (bf16x8){l2[0], l2[1], l2[2], l2[3], h2[0], h2[1], h2[2], h2[3]}, o[d0], 0, 0, 0);   \
        o[d0] = __builtin_amdgcn_mfma_f32_32x32x16_bf16(pa3, (bf16x8){l3[0], l3[1], l3[2], l3[3], h3[0], h3[1], h3[2], h3[3]}, o[d0], 0, 0, 0); } while (0)
    PV_D0(0); PV_D0(1); PV_D0(2); PV_D0(3);
#undef PV_D0
#undef TRRD
}
struct BlockRef { const bf16_t* Q; const bf16_t* K; const bf16_t* V; int P0, j_lo, j_hi; };
struct Seam { bf16x8 qr[8]; bf16x8 st_v0, st_v1, st_k0, st_k1; };
#define ROW(p, k0, rr) ((p) + (size_t)((k0) + (rr)) * LDQ + sc)
#define VMWN(n) asm volatile("s_waitcnt vmcnt(%0)" :: "i"(n) : "memory")
#define SLOAD_H(Kp, Vp, k0) do { S.st_v0 = load8(ROW(Vp, k0, sr)); S.st_v1 = load8(ROW(Vp, k0, 32 + sr)); S.st_k0 = load8(ROW(Kp, k0, sr)); S.st_k1 = load8(ROW(Kp, k0, 32 + sr)); } while (0)
#define SWRITE_HK(bf) do { *(bf16x8*)(K_lds + (bf) * SHM_K + kws) = S.st_k0; *(bf16x8*)(K_lds + (bf) * SHM_K + kws + 32 * 256) = S.st_k1; } while (0)
#define SWRITE_HV(bf) do { *(bf16x8*)(V_lds + (bf) * SHM_V + vst0) = S.st_v0; *(bf16x8*)(V_lds + (bf) * SHM_V + vst1) = S.st_v1; } while (0)
#define SWRITE_H(bf) do { SWRITE_HV(bf); SWRITE_HK(bf); } while (0)
__device__ __forceinline__ void prime(const BlockRef& cur, char* lds, Seam& S) {
    const int tid = threadIdx.x, wid = __builtin_amdgcn_readfirstlane(tid >> 6), lane = tid & 63, r32 = lane & 31, hi = lane >> 5;
    const int sr = tid >> 4, sc = (tid & 15) * 8, kws = KSWZ(sr, sc * 2); char* K_lds = lds + 2 * SHM_V;
    const int kb0 = cur.j_lo * KVBLK;
    for (int d0 = 0; d0 < 8; ++d0) S.qr[d0] = load8(cur.Q + (size_t)(wid * QBLK + r32) * LDQ + d0 * 16 + hi * 8);
    SLOAD_H(cur.K, cur.V, kb0); VM_WAIT(); SWRITE_HK(0);
    __syncthreads();
}
template <class Epi>
__device__ __forceinline__ void block(const BlockRef& cur, const BlockRef& nxt, char* lds, Seam& S, const Epi& E) {
    const int tid = threadIdx.x, wid = __builtin_amdgcn_readfirstlane(tid >> 6), lane = tid & 63, r32 = lane & 31, hi = lane >> 5;
    const int j_lo = cur.j_lo, j_hi = cur.j_hi;
    const int NT = j_hi - j_lo;
    const int kbn = nxt.j_lo * KVBLK;
    const int qlo = cur.P0 + wid * QBLK, qm = qlo + r32 - 4 * hi;
    char* V_lds = lds; char* K_lds = lds + 2 * SHM_V;
    float* ws = (float*)(lds + LDS_WS) + wid * 64; float* li_l = ws, * al_l = ws + 32;
    const float* FB = (const float*)(lds + LDS_FB) + 4 * hi;
    float m_reg = -1e30f, l_reg = 0; f32x16 o[4] = {};
    const int sr = tid >> 4, sc = (tid & 15) * 8, vst0 = v_st(sr, sc), vst1 = v_st(32 + sr, sc), kws = KSWZ(sr, sc * 2);
    const int vb0 = (int)(uintptr_t)V_lds + v_rd_base(lane);
    const bf16_t* Kh = cur.K; const bf16_t* Vh = cur.V;
#define RESC(a) do { if (__any((a) < 1.f)) { if (hi == 0) al_l[r32] = (a); asm volatile("s_waitcnt lgkmcnt(0)" ::: "memory");              \
                     for (int d_ = 0; d_ < 4; ++d_) for (int r = 0; r < 16; ++r) o[d_][r] *= al_l[crow(r, hi)]; } } while (0)
#define KBASE(t) ((j_lo + (t)) * KVBLK)
#define MASKT(P0_, P1_, t) do { const int kb_ = KBASE(t); if (kb_ + KVBLK - 1 > qlo) mask_tile(P0_, P1_, qm - kb_); } while (0)
    constexpr int NQL = 8;
#define SEAM_K0() do { VMWN(NQL); SWRITE_HK(0); SBAR(); } while (0)
    f32x16 pA0, pA1, pB0, pB1; float mnA, mnB, alA, alB; bf16x8 pa0, pa1, pa2, pa3;
    SWRITE_HV(0); SBAR();
    if (NT > 1) { SLOAD_H(Kh, Vh, KBASE(1)); }
    SBAR(); qkt<0>(pA0, pA1, K_lds, FB + KBASE(0), r32, hi, S.qr);
    MASKT(pA0, pA1, 0); partialSM(pA0, pA1, m_reg, mnA, alA);
    if (NT > 1) { VM_WAIT(); SWRITE_H(1); }
    __syncthreads();
#define HALF_STEP(PX0, PX1, mnX, alX, PY0, PY1, alY, t, KB, VB, SB) do {                                                      \
        SBAR(); qkt<KB>(PX0, PX1, K_lds, FB + KBASE(t), r32, hi, S.qr);                                                      \
        finishSM(PY0, PY1, alY, l_reg, pa0, pa1, pa2, pa3); SBAR();                                                           \
        if ((t) + 1 < NT) { SLOAD_H(Kh, Vh, KBASE((t) + 1)); SBAR(); }                                                       \
        pv_tile<VB>(o, vb0, pa0, pa1, pa2, pa3); MASKT(PX0, PX1, (t)); partialSM(PX0, PX1, m_reg, mnX, alX);                  \
        __syncthreads();                                                                                                      \
        if ((t) + 1 < NT) { VM_WAIT(); SWRITE_H(SB); }                                                                        \
        RESC(alX); __syncthreads(); } while (0)
    for (int t = 1; t + 1 < NT; t += 2) {
        HALF_STEP(pB0, pB1, mnB, alB, pA0, pA1, alA, t, 1, 0, 0);
        HALF_STEP(pA0, pA1, mnA, alA, pB0, pB1, alB, t + 1, 0, 1, 1);
    }
    const bool even = (NT & 1) == 0;
    if (even) { SBAR(); qkt<1>(pB0, pB1, K_lds, FB + KBASE(NT - 1), r32, hi, S.qr); SBAR(); }
    SLOAD_H(nxt.K, nxt.V, kbn); SBAR();
#pragma unroll
    for (int d0 = 0; d0 < 8; ++d0) S.qr[d0] = load8(nxt.Q + (size_t)(wid * QBLK + r32) * LDQ + d0 * 16 + hi * 8);
    SBAR();
    finishSM(pA0, pA1, alA, l_reg, pa0, pa1, pa2, pa3); SBAR();
    pv_tile<0>(o, vb0, pa0, pa1, pa2, pa3);
    if (even) { MASKT(pB0, pB1, NT - 1); partialSM(pB0, pB1, m_reg, mnB, alB); __syncthreads(); RESC(alB);
        finishSM(pB0, pB1, alB, l_reg, pa0, pa1, pa2, pa3); SBAR(); pv_tile<1>(o, vb0, pa0, pa1, pa2, pa3); }
    SBAR(); SEAM_K0();
    if (hi == 0) li_l[r32] = l_reg; asm volatile("s_waitcnt lgkmcnt(0)" ::: "memory");
    E(o, li_l, m_reg, cur.P0 + wid * QBLK, r32, hi);
    __syncthreads();
#undef RESC
#undef KBASE
#undef MASKT
#undef SEAM_K0
#undef HALF_STEP
}
#undef ROW
#undef VMWN
#undef SLOAD_H
#undef SWRITE_HK
#undef SWRITE_HV
#undef SWRITE_H
struct EpiNormBf16 {
    bf16_t* out; int ldo; const float* gain;
    __device__ __forceinline__ void operator()(const f32x16* o, const float* li_l, float  , int row0, int r32, int hi) const {
        const float g0 = gain[r32], g1 = gain[32 + r32], g2 = gain[64 + r32], g3 = gain[96 + r32];
#pragma unroll
        for (int r = 0; r < 16; ++r) { const int orow = crow(r, hi); const float rl = __builtin_amdgcn_rcpf(li_l[orow]);
            const float v0 = o[0][r] * rl, v1 = o[1][r] * rl, v2 = o[2][r] * rl, v3 = o[3][r] * rl;
            float ss = (v0 * v0 + v1 * v1) + (v2 * v2 + v3 * v3);
            ss += __shfl_xor(ss, 1); ss += __shfl_xor(ss, 2); ss += __shfl_xor(ss, 4); ss += __shfl_xor(ss, 8); ss += __shfl_xor(ss, 16);
            const float rs = 1.0f / sqrtf(ss * (1.0f / 128.0f) + EPS);
            u32x2 w; w.x = cvtpk(v0 * rs * g0, v1 * rs * g1); w.y = cvtpk(v2 * rs * g2, v3 * rs * g3);
            *(u32x2*)(out + (size_t)(row0 + orow) * ldo + r32 * 4) = w; }
    }
};
struct EpiPartial {
    float* O; float* ML;
    __device__ __forceinline__ void operator()(const f32x16* o, const float* li_l, float m, int row0, int r32, int hi) const {
#pragma unroll
        for (int r = 0; r < 16; ++r) { const int orow = crow(r, hi); u32x2 w; w.x = cvtpk(o[0][r], o[1][r]); w.y = cvtpk(o[2][r], o[3][r]); *(u32x2*)((bf16_t*)O + (size_t)(row0 + orow) * 512 + r32 * 4) = w; }
        if (hi == 0) *(f32x2*)(ML + (size_t)(row0 + r32) * 8) = (f32x2){m, li_l[r32]};
    }
};
}

constexpr size_t MiB = 1u << 20;
constexpr size_t WS_CTL = 0, CTL_ZERO_BYTES = 65536;
constexpr size_t WS_WSM = 1 * MiB;
constexpr size_t WS_RSTD = 2 * MiB;
constexpr size_t WS_SMALL = 3 * MiB;
constexpr size_t WS_GATE = 5 * MiB;
constexpr size_t WS_ROWLIST = 6 * MiB;
constexpr size_t WS_WMKV = 8 * MiB, WS_WOUT = 12 * MiB, WS_WIN = 20 * MiB;
constexpr size_t WS_MEMB = 40 * MiB;
constexpr size_t WS_KVM = 44 * MiB;
constexpr size_t WS_GLAD = 46 * MiB;
constexpr size_t WS_XB = 48 * MiB;
constexpr size_t WS_PROJ = 112 * MiB;
constexpr size_t WS_MIX = 272 * MiB;
constexpr size_t WS_X1 = 336 * MiB;
constexpr size_t WS_X1B = 464 * MiB;
constexpr size_t WS_GLAKV = 528 * MiB;
constexpr size_t WS_GLAO = 656 * MiB;
constexpr size_t WS_WUP = 720 * MiB;
constexpr size_t WS_WDOWN = 1232 * MiB;
constexpr size_t WS_ACT = 1488 * MiB;
constexpr size_t WS_Y = 1776 * MiB;
constexpr size_t WS_IDENT = 5 * MiB + 512 * 1024;
constexpr size_t WS_LA = 2032 * MiB;
constexpr size_t WS_FOXO = 2064 * MiB;
constexpr size_t WS_FOXML = 2192 * MiB;
constexpr size_t WS_ROWGATE = 2194 * MiB, WS_ROWRSTD = 2196 * MiB;
constexpr size_t WS_END = 2198 * MiB;
constexpr int CW_BAR = 4096;
constexpr int CW_CNT = 8192;

constexpr int RING_BYTES = 131072;
constexpr int TAB_OFF = RING_BYTES;
constexpr int MISC_OFF = 147456;
constexpr int LDS_BYTES = 147456 + 1024 + 8192;

#define XB_TMO      128
#define XB_XCNT(j)  (256  + 64 * (j))
#define XB_XSUB(j)  (1280 + 64 * (j))
#define XB_XGEN(j)  (2304 + 64 * (j))
#define XB_TOP      3328
#define XB_TOPGEN   3392
#define XCD_BAR_WORDS 3456
#define XB_SPIN_CAP (1u << 18)
__device__ __forceinline__ unsigned xb_ld(unsigned* p)              { return __hip_atomic_load(p, __ATOMIC_RELAXED, __HIP_MEMORY_SCOPE_AGENT); }
__device__ __forceinline__ unsigned xb_add(unsigned* p, unsigned v) { return __hip_atomic_fetch_add(p, v, __ATOMIC_RELAXED, __HIP_MEMORY_SCOPE_AGENT); }
__device__ __forceinline__ unsigned xb_xcc_id() { return (unsigned)__builtin_amdgcn_s_getreg((3 << 11) | 20) & 0xFu; }
#define XB_SPIN(cond, bar) do { unsigned _sp = 0; while (cond) { __builtin_amdgcn_s_sleep(1); \
    if ((++_sp & 255u) == 0u) { if (xb_ld(&(bar)[XB_TMO])) break; if (_sp > XB_SPIN_CAP) { atomicAdd(&(bar)[XB_TMO], 1u); break; } } } } while (0)
struct XcdBarrier { unsigned* bar; unsigned x; volatile LAS unsigned* st; };
__device__ __forceinline__ XcdBarrier xcd_barrier_post(unsigned* bar, volatile LAS unsigned* st) {
    XcdBarrier b; b.bar = bar; b.x = xb_xcc_id(); b.st = st;
    if (threadIdx.x == 0) (void)xb_add(&bar[XB_XCNT(b.x)], 1u);
    return b;
}
__device__ __forceinline__ void xcd_barrier_complete(unsigned* bar, unsigned x, unsigned& nloc, unsigned& nx) {
    const unsigned G = gridDim.x * gridDim.y * gridDim.z;
    unsigned sum, cnt, mine, sp = 0u;
    for (;;) {
        sum = 0u; cnt = 0u; mine = 0u;
#pragma unroll
        for (unsigned j = 0; j < 16; ++j) { const unsigned c = xb_ld(&bar[XB_XCNT(j)]); sum += c; cnt += (c > 0u) ? 1u : 0u; mine = (j == x) ? c : mine; }
        if (sum == G) break;
        __builtin_amdgcn_s_sleep(1);
        if ((++sp & 255u) == 0u) { if (xb_ld(&bar[XB_TMO])) break; if (sp > XB_SPIN_CAP) { atomicAdd(&bar[XB_TMO], 1u); break; } }
    }
    nloc = mine > 0u ? mine : 1u; nx = cnt > 0u ? cnt : 1u;
}
__device__ __forceinline__ void xcd_barrier(const XcdBarrier& b) {
    asm volatile("s_waitcnt vmcnt(0)" ::: "memory");
    __syncthreads();
    if (threadIdx.x == 0) {
        unsigned* bar = b.bar;
        __builtin_amdgcn_s_waitcnt(0);
        unsigned nloc = b.st[0], nx = b.st[1];
        if (nloc == 0u) { xcd_barrier_complete(bar, b.x, nloc, nx); b.st[0] = nloc; b.st[1] = nx; }
        const unsigned old = xb_add(&bar[XB_XSUB(b.x)], 1u);
        const unsigned gen = old / nloc;
        if (old + 1u == (gen + 1u) * nloc) {
            __builtin_amdgcn_fence(__ATOMIC_RELEASE, "agent");
            asm volatile("s_waitcnt vmcnt(0)" ::: "memory");
            const unsigned og = xb_add(&bar[XB_TOP], 1u);
            const unsigned tg = og / nx;
            if (og + 1u == (tg + 1u) * nx) xb_add(&bar[XB_TOPGEN], 1u);
            else XB_SPIN(xb_ld(&bar[XB_TOPGEN]) == tg, bar);
            __builtin_amdgcn_fence(__ATOMIC_ACQUIRE, "agent");
            xb_add(&bar[XB_XGEN(b.x)], 1u);
            asm volatile("s_waitcnt vmcnt(0)" ::: "memory");
        } else {
            XB_SPIN(xb_ld(&bar[XB_XGEN(b.x)]) == gen, bar);
            __builtin_amdgcn_fence(__ATOMIC_ACQUIRE, "agent");
            asm volatile("s_waitcnt vmcnt(0)" ::: "memory");
        }
    }
    __syncthreads();
}

__device__ __forceinline__ unsigned f2bf(float f) { unsigned u = __builtin_bit_cast(unsigned, f); return (u + 0x7fffu + ((u >> 16) & 1u)) >> 16; }
__device__ __forceinline__ unsigned pk2(float lo, float hi) { return f2bf(lo) | (f2bf(hi) << 16); }
__device__ __forceinline__ int head_perm(int x) { return (x & 3) * 32 + (x >> 2); }
template <bool KPERM>
__device__ __forceinline__ void transpose_item(const float* W, size_t ldw, int k0, int scol0, bf16_t* WT, int K, const float* g, float cs, LAS float* scr, int lane) {
#pragma unroll 16
    for (int i = 0; i < 32; ++i) { const int kk = 2 * i + (lane >> 5); int sk = k0 + kk; if (KPERM) sk = (sk & ~127) + head_perm(sk & 127);
        float v = W[(size_t)sk * ldw + scol0 + (lane & 31)]; if (g) v *= g[sk]; scr[kk * 33 + (lane & 31)] = v * cs; }
    LDS_WAIT(); asm volatile("" ::: "memory");
    const int c = lane & 7;
#pragma unroll
    for (int j = 0; j < 4; ++j) { const int n = (lane >> 3) + 8 * j; const LAS float* s = scr + (8 * c) * 33 + n;
        u32x4 o; o.x = pk2(s[0 * 33], s[1 * 33]); o.y = pk2(s[2 * 33], s[3 * 33]); o.z = pk2(s[4 * 33], s[5 * 33]); o.w = pk2(s[6 * 33], s[7 * 33]);
        *(GAS u32x4*)(WT + (size_t)n * K + k0 + 8 * c) = o; }
    LDS_WAIT(); asm volatile("" ::: "memory");
}
template <bool KPERM>
__device__ __forceinline__ void tr_item(const float* W, size_t ldw, int k0, int scol0, bf16_t* WT, int K, const float* g, float cs, LAS unsigned char* scr, int lane) {
    const int kr = lane >> 5, c4 = lane & 31;
    f32x4 a[16], b[16]; float ga[16], gb[16];
#pragma unroll
    for (int i = 0; i < 16; ++i) { int sa = k0 + 4 * i + 2 * kr, sb = sa + 1; if (KPERM) { sa = (sa & ~127) + head_perm(sa & 127); sb = (sb & ~127) + head_perm(sb & 127); }
        a[i] = *(const f32x4*)(W + (size_t)sa * ldw + scol0 + c4 * 4); b[i] = *(const f32x4*)(W + (size_t)sb * ldw + scol0 + c4 * 4);
        ga[i] = g ? g[sa] * cs : cs; gb[i] = g ? g[sb] * cs : cs; }
#pragma unroll
    for (int i = 0; i < 16; ++i) {
#pragma unroll
        for (int j = 0; j < 4; ++j) *(LAS unsigned*)(scr + (4 * c4 + j) * 144 + (2 * i + kr) * 4) = cvt_pk_bf16(a[i][j] * ga[i], b[i][j] * gb[i]); }
    LDS_WAIT(); asm volatile("" ::: "memory");
    const int q = lane & 7;
#pragma unroll
    for (int t = 0; t < 16; ++t) { const int n = 8 * t + (lane >> 3); const u32x4 v = *(const LAS u32x4*)(scr + n * 144 + q * 16);
        *(GAS u32x4*)(WT + (size_t)n * K + k0 + 8 * q) = v; }
    LDS_WAIT(); asm volatile("" ::: "memory");
}
__device__ __forceinline__ void tr_item_fp8(const float* W, size_t ldw, int k0, int scol0, unsigned char* WT, int K, const float* g, float cs, LAS unsigned char* scr, int lane) {
    const int kr = lane >> 4, c4 = lane & 15;
    const float* wl = W + (size_t)(4 * kr) * ldw + scol0 + c4 * 4;
    f32x4 a[8][4]; f32x4 gs[8];
#pragma unroll
    for (int i = 0; i < 8; ++i) {
#pragma unroll
        for (int t = 0; t < 4; ++t) a[i][t] = __builtin_nontemporal_load((const f32x4*)(wl + (size_t)(k0 + 16 * i + t) * ldw));
        gs[i] = g ? *(const f32x4*)(g + k0 + 16 * i + 4 * kr) * cs : (f32x4){cs, cs, cs, cs}; }
#pragma unroll
    for (int i = 0; i < 8; ++i)
#pragma unroll
        for (int j = 0; j < 4; ++j) *(LAS unsigned*)(scr + (4 * c4 + j) * 144 + (4 * i + kr) * 4) = pk_fp8x4(a[i][0][j] * gs[i][0], a[i][1][j] * gs[i][1], a[i][2][j] * gs[i][2], a[i][3][j] * gs[i][3]);
    LDS_WAIT(); asm volatile("" ::: "memory");
    const int q = lane & 7;
#pragma unroll
    for (int t = 0; t < 8; ++t) { const int n = 8 * t + (lane >> 3); const u32x4 v = *(const LAS u32x4*)(scr + n * 144 + q * 16);
        __builtin_nontemporal_store(v, (u32x4*)(WT + (size_t)n * K + k0 + 16 * q)); }
    LDS_WAIT(); asm volatile("" ::: "memory");
}
__device__ __forceinline__ void thin_item(int which, const float* W, const float* g, int k0, bf16_t* hi, bf16_t* lo, LAS float* scr, int lane) {
#pragma unroll 8
    for (int i = 0; i < 32; ++i) { const int kk = 2 * i + (lane >> 5), n = lane & 31, sk = k0 + kk; float v = 0.f;
        if (which == 0) { if (n < 16) v = W[(size_t)sk * 5140 + 3072 + n]; else if (n < 20) v = W[(size_t)sk * 5140 + 4624 + (n - 16)]; }
        else v = W[(size_t)sk * 32 + n];
        scr[kk * 33 + n] = v * g[sk]; }
    LDS_WAIT(); asm volatile("" ::: "memory");
    const int c = lane & 7;
#pragma unroll
    for (int j = 0; j < 4; ++j) { const int n = (lane >> 3) + 8 * j; const LAS float* s = scr + (8 * c) * 33 + n; float v[8], l[8];
#pragma unroll
        for (int t = 0; t < 8; ++t) { v[t] = s[t * 33]; l[t] = v[t] - __uint_as_float(f2bf(v[t]) << 16); }
        u32x4 o; o.x = pk2(v[0], v[1]); o.y = pk2(v[2], v[3]); o.z = pk2(v[4], v[5]); o.w = pk2(v[6], v[7]);
        *(GAS u32x4*)(hi + (size_t)n * 2048 + k0 + 8 * c) = o;
        o.x = pk2(l[0], l[1]); o.y = pk2(l[2], l[3]); o.z = pk2(l[4], l[5]); o.w = pk2(l[6], l[7]);
        *(GAS u32x4*)(lo + (size_t)n * 2048 + k0 + 8 * c) = o; }
    LDS_WAIT(); asm volatile("" ::: "memory");
}
__device__ __forceinline__ f32x4 bf_up4(bf16x8 h, int half) {
    f32x4 r;
#pragma unroll
    for (int j = 0; j < 4; ++j) r[j] = __uint_as_float(((unsigned)(unsigned short)h[4 * half + j]) << 16);
    return r;
}
template <int NT, bool Q8 = false>
__device__ __forceinline__ void rowpass16(const float* X, int row0, bf16_t* XB, const bf16_t* WT_hi, const bf16_t* WT_lo, f32x4 (&acc)[2], float& rstd_r, int lane) {
    const int r = lane & 15, q = lane >> 4;
    const float* xp = X + (size_t)(row0 + r) * DM + q * 16;
    bf16_t* xo = XB + (size_t)(row0 + r) * DM + q * 16;
    float ss = 0.f; acc[0] = (f32x4){0.f, 0.f, 0.f, 0.f}; acc[1] = acc[0];
#pragma unroll 2
    for (int kb = 0; kb < 32; ++kb) {
        const f32x4 v0 = *(const f32x4*)(xp + kb * 64), v1 = *(const f32x4*)(xp + kb * 64 + 4), v2 = *(const f32x4*)(xp + kb * 64 + 8), v3 = *(const f32x4*)(xp + kb * 64 + 12);
        ss += (v0[0] * v0[0] + v0[1] * v0[1]) + (v0[2] * v0[2] + v0[3] * v0[3]) + (v1[0] * v1[0] + v1[1] * v1[1]) + (v1[2] * v1[2] + v1[3] * v1[3]);
        ss += (v2[0] * v2[0] + v2[1] * v2[1]) + (v2[2] * v2[2] + v2[3] * v2[3]) + (v3[0] * v3[0] + v3[1] * v3[1]) + (v3[2] * v3[2] + v3[3] * v3[3]);
        const bf16x8 h0 = pack8(v0, v1), h1 = pack8(v2, v3);
        if constexpr (Q8) { u32x4 w8 = {pk_fp8x4(v0[0], v0[1], v0[2], v0[3]), pk_fp8x4(v1[0], v1[1], v1[2], v1[3]), pk_fp8x4(v2[0], v2[1], v2[2], v2[3]), pk_fp8x4(v3[0], v3[1], v3[2], v3[3])};
            *(u32x4*)((unsigned char*)XB + (size_t)(row0 + r) * DM + q * 16 + kb * 64) = w8; }
        else { *(bf16x8*)(xo + kb * 64) = h0; *(bf16x8*)(xo + kb * 64 + 8) = h1; }
        if constexpr (NT > 0) {
            const bf16x8 l0 = pack8(v0 - bf_up4(h0, 0), v1 - bf_up4(h0, 1)), l1 = pack8(v2 - bf_up4(h1, 0), v3 - bf_up4(h1, 1));
#pragma unroll
            for (int nt = 0; nt < NT; ++nt) {
                const bf16_t* wh = WT_hi + (size_t)(nt * 16 + r) * DM + kb * 64 + q * 16; const bf16_t* wl = WT_lo + (size_t)(nt * 16 + r) * DM + kb * 64 + q * 16;
                const bf16x8 bh0 = *(const bf16x8*)wh, bh1 = *(const bf16x8*)(wh + 8), bl0 = *(const bf16x8*)wl, bl1 = *(const bf16x8*)(wl + 8);
                acc[nt] = __builtin_amdgcn_mfma_f32_16x16x32_bf16(h0, bh0, acc[nt], 0, 0, 0); acc[nt] = __builtin_amdgcn_mfma_f32_16x16x32_bf16(l0, bh0, acc[nt], 0, 0, 0);
                acc[nt] = __builtin_amdgcn_mfma_f32_16x16x32_bf16(h0, bl0, acc[nt], 0, 0, 0);
                acc[nt] = __builtin_amdgcn_mfma_f32_16x16x32_bf16(h1, bh1, acc[nt], 0, 0, 0); acc[nt] = __builtin_amdgcn_mfma_f32_16x16x32_bf16(l1, bh1, acc[nt], 0, 0, 0);
                acc[nt] = __builtin_amdgcn_mfma_f32_16x16x32_bf16(h1, bl1, acc[nt], 0, 0, 0);
            }
        }
    }
    ss += __shfl_xor(ss, 16); ss += __shfl_xor(ss, 32);
    rstd_r = 1.0f / sqrtf(ss * (1.0f / DM) + EPS);
}

template <bool Q8>
__device__ __forceinline__ void rowpass_wg(const float* X, int row0, bf16_t* XB, const bf16_t* WT_hi, const bf16_t* WT_lo, f32x4 (&acc)[2], float& rstd_r, LAS unsigned char* wlds) {
    const int tid = threadIdx.x, lane = tid & 63, wave = __builtin_amdgcn_readfirstlane(tid >> 6), r = lane & 15, q = lane >> 4;
    const int rw = row0 + 16 * wave;
    const float* xp = X + (size_t)(rw + r) * DM + q * 16;
    bf16_t* xo = XB + (size_t)(rw + r) * DM + q * 16;
    float ss = 0.f; acc[0] = (f32x4){0.f, 0.f, 0.f, 0.f}; acc[1] = acc[0];
    f32x4 xa[4][4], xbuf[4][4]; u32x4 wst[4];
#define RW_LOADX(dst, c) do { _Pragma("unroll") for (int k4 = 0; k4 < 4; ++k4) _Pragma("unroll") for (int j = 0; j < 4; ++j) dst[k4][j] = *(const f32x4*)(xp + ((c) * 4 + k4) * 64 + 4 * j); } while (0)
#define RW_LOADW(c) do { _Pragma("unroll") for (int i = 0; i < 4; ++i) { const int p = tid + 512 * i, pp = p & 1023; const bf16_t* src = ((p >> 10) ? WT_lo : WT_hi) + (size_t)(pp >> 5) * DM + (c) * 256 + (pp & 31) * 8; \
        wst[i] = *(const u32x4*)src; } } while (0)
#define RW_STOREW() do { _Pragma("unroll") for (int i = 0; i < 4; ++i) { const int p = tid + 512 * i, pp = p & 1023; *(LAS u32x4*)(wlds + (p >> 10) * 16896 + (pp >> 5) * 528 + (pp & 31) * 16) = wst[i]; } } while (0)
#define RW_USE(src, c) do { _Pragma("unroll") for (int k4 = 0; k4 < 4; ++k4) { asm volatile("" ::: "memory"); const int kb = (c) * 4 + k4; const f32x4 v0 = src[k4][0], v1 = src[k4][1], v2 = src[k4][2], v3 = src[k4][3]; \
        ss += (v0[0] * v0[0] + v0[1] * v0[1]) + (v0[2] * v0[2] + v0[3] * v0[3]) + (v1[0] * v1[0] + v1[1] * v1[1]) + (v1[2] * v1[2] + v1[3] * v1[3]); \
        ss += (v2[0] * v2[0] + v2[1] * v2[1]) + (v2[2] * v2[2] + v2[3] * v2[3]) + (v3[0] * v3[0] + v3[1] * v3[1]) + (v3[2] * v3[2] + v3[3] * v3[3]); \
        const bf16x8 h0 = pack8_raw(v0, v1), h1 = pack8_raw(v2, v3); \
        if constexpr (Q8) { u32x4 w8 = {pk_fp8x4(v0[0], v0[1], v0[2], v0[3]), pk_fp8x4(v1[0], v1[1], v1[2], v1[3]), pk_fp8x4(v2[0], v2[1], v2[2], v2[3]), pk_fp8x4(v3[0], v3[1], v3[2], v3[3])}; \
            *(u32x4*)((unsigned char*)XB + (size_t)(rw + r) * DM + q * 16 + kb * 64) = w8; } \
        else { *(bf16x8*)(xo + kb * 64) = h0; *(bf16x8*)(xo + kb * 64 + 8) = h1; } \
        const bf16x8 l0 = pack8_raw(v0 - bf_up4(h0, 0), v1 - bf_up4(h0, 1)), l1 = pack8_raw(v2 - bf_up4(h1, 0), v3 - bf_up4(h1, 1)); \
        _Pragma("unroll") for (int nt = 0; nt < 2; ++nt) { const LAS unsigned char* wp = wlds + (nt * 16 + r) * 528 + (k4 * 64 + q * 16) * 2; \
            const bf16x8 bh0 = *(const LAS bf16x8*)wp, bh1 = *(const LAS bf16x8*)(wp + 16), bl0 = *(const LAS bf16x8*)(wp + 16896), bl1 = *(const LAS bf16x8*)(wp + 16896 + 16); \
            acc[nt] = __builtin_amdgcn_mfma_f32_16x16x32_bf16(h0, bh0, acc[nt], 0, 0, 0); acc[nt] = __builtin_amdgcn_mfma_f32_16x16x32_bf16(l0, bh0, acc[nt], 0, 0, 0); \
            acc[nt] = __builtin_amdgcn_mfma_f32_16x16x32_bf16(h0, bl0, acc[nt], 0, 0, 0); \
            acc[nt] = __builtin_amdgcn_mfma_f32_16x16x32_bf16(h1, bh1, acc[nt], 0, 0, 0); acc[nt] = __builtin_amdgcn_mfma_f32_16x16x32_bf16(l1, bh1, acc[nt], 0, 0, 0); \
            acc[nt] = __builtin_amdgcn_mfma_f32_16x16x32_bf16(h1, bl1, acc[nt], 0, 0, 0); } } } while (0)
    RW_LOADX(xa, 0);
#pragma unroll 1
    for (int c = 0; c < 8; c += 2) {
        RW_LOADW(c); RW_LOADX(xbuf, c + 1);
        __syncthreads(); RW_STOREW(); LDS_WAIT(); __syncthreads();
        RW_USE(xa, c);
        RW_LOADW(c + 1); if (c + 2 < 8) RW_LOADX(xa, c + 2);
        __syncthreads(); RW_STOREW(); LDS_WAIT(); __syncthreads();
        RW_USE(xbuf, c + 1);
    }
#undef RW_LOADX
#undef RW_LOADW
#undef RW_STOREW
#undef RW_USE
    ss += __shfl_xor(ss, 16); ss += __shfl_xor(ss, 32);
    rstd_r = 1.0f / sqrtf(ss * (1.0f / DM) + EPS);
    __syncthreads();
}

namespace pg8 {
struct EpiRowScaleBf16 {
    static constexpr bool PERM = true, META = false;
    bf16_t* O; int ldc; const float* rowscale;
    __device__ __forceinline__ void operator()(const f32x4 (&acc)[2][2][4][2], const Unit& u, int wr, int wc, int fr, int fq) const {
        const int row0 = u.pm * BM + wr * 64 + fr, col0 = u.pn * BM + wc * 32 + 8 * fq;
        float sc[2][4];
#pragma unroll
        for (int ai = 0; ai < 2; ++ai)
#pragma unroll
            for (int m = 0; m < 4; ++m) sc[ai][m] = rowscale[row0 + ai * HALF + m * 16];
        asm volatile("" : "+v"(sc[0][0]), "+v"(sc[0][1]), "+v"(sc[0][2]), "+v"(sc[0][3]), "+v"(sc[1][0]), "+v"(sc[1][1]), "+v"(sc[1][2]), "+v"(sc[1][3]));
#pragma unroll
        for (int ai = 0; ai < 2; ++ai)
#pragma unroll
            for (int m = 0; m < 4; ++m) { const int row = row0 + ai * HALF + m * 16; const float s = sc[ai][m]; bf16_t* rowp = O + (size_t)row * ldc + col0;
#pragma unroll
                for (int bj = 0; bj < 2; ++bj) { const f32x4 v0 = acc[ai][bj][m][0] * s, v1 = acc[ai][bj][m][1] * s;
                    u32x4 w; w.x = cvt_pk_bf16(v0[0], v0[1]); w.y = cvt_pk_bf16(v0[2], v0[3]); w.z = cvt_pk_bf16(v1[0], v1[1]); w.w = cvt_pk_bf16(v1[2], v1[3]);
                    *(u32x4*)(rowp + bj * HALF) = w; } }
    }
};
struct EpiResF32 {
    static constexpr bool PERM = false, META = false;
    const float* base; float* C; int ldc;
    __device__ __forceinline__ void operator()(const f32x4 (&acc)[2][2][4][2], const Unit& u, int wr, int wc, int fr, int fq) const {
        const int row0 = u.pm * BM + wr * 64 + fr, col0 = u.pn * BM + wc * 32 + 4 * fq;
#pragma unroll
        for (int ai = 0; ai < 2; ++ai) { f32x4 bs[4][2][2];
#pragma unroll
            for (int m = 0; m < 4; ++m)
#pragma unroll
                for (int bj = 0; bj < 2; ++bj)
#pragma unroll
                    for (int n = 0; n < 2; ++n) bs[m][bj][n] = *(const f32x4*)(base + (size_t)(row0 + ai * HALF + m * 16) * ldc + col0 + bj * HALF + n * 16);
#pragma unroll
            for (int m = 0; m < 4; ++m) asm volatile("" : "+v"(bs[m][0][0]), "+v"(bs[m][0][1]), "+v"(bs[m][1][0]), "+v"(bs[m][1][1]));
#pragma unroll
            for (int m = 0; m < 4; ++m)
#pragma unroll
                for (int bj = 0; bj < 2; ++bj)
#pragma unroll
                    for (int n = 0; n < 2; ++n) *(f32x4*)(C + (size_t)(row0 + ai * HALF + m * 16) * ldc + col0 + bj * HALF + n * 16) = bs[m][bj][n] + acc[ai][bj][m][n]; }
    }
};
struct EpiMoeUp {
    static constexpr bool PERM = true, META = false;
    bf16_t* ACT; const float* rstd; const float* bias;
    __device__ __forceinline__ void operator()(const f32x4 (&acc)[2][2][4][2], const Unit& u, int wr, int wc, int fr, int fq) const {
        asm volatile("" : "+v"(fr), "+v"(fq));
        const int j0 = u.pn * HALF + wc * 32 + 8 * fq; const float* bg = bias + (size_t)u.e * 4096 + j0; const float* bu = bg + 2048;
        int tk[2][4];
#pragma unroll
        for (int ai = 0; ai < 2; ++ai)
#pragma unroll
            for (int m = 0; m < 4; ++m) { const int r = ai * HALF + wr * 64 + m * 16 + fr; tk[ai][m] = u.rowidx[r < u.rows ? r : 0]; }
        f32x4 bg0 = *(const f32x4*)bg, bg1 = *(const f32x4*)(bg + 4), bu0 = *(const f32x4*)bu, bu1 = *(const f32x4*)(bu + 4);
        asm volatile("" : "+v"(tk[0][0]), "+v"(tk[0][1]), "+v"(tk[0][2]), "+v"(tk[0][3]), "+v"(tk[1][0]), "+v"(tk[1][1]), "+v"(tk[1][2]), "+v"(tk[1][3]), "+v"(bg0), "+v"(bg1), "+v"(bu0), "+v"(bu1));
        float sc[2][4];
#pragma unroll
        for (int ai = 0; ai < 2; ++ai)
#pragma unroll
            for (int m = 0; m < 4; ++m) sc[ai][m] = rstd[tk[ai][m] >> 2];
        asm volatile("" : "+v"(sc[0][0]), "+v"(sc[0][1]), "+v"(sc[0][2]), "+v"(sc[0][3]), "+v"(sc[1][0]), "+v"(sc[1][1]), "+v"(sc[1][2]), "+v"(sc[1][3]));
#pragma unroll
        for (int ai = 0; ai < 2; ++ai)
#pragma unroll
            for (int m = 0; m < 4; ++m) { const int r = ai * HALF + wr * 64 + m * 16 + fr; const float s = sc[ai][m];
                f32x4 o[2];
#pragma unroll
                for (int n = 0; n < 2; ++n) { const f32x4 g = acc[ai][0][m][n] * s + (n ? bg1 : bg0), up = acc[ai][1][m][n] * s + (n ? bu1 : bu0);
#pragma unroll
                    for (int i = 0; i < 4; ++i) { const float gg = fminf(g[i], 7.0f), uu = fminf(fmaxf(up[i], -7.0f), 7.0f);
                        const float sg = __builtin_amdgcn_rcpf(1.0f + __builtin_amdgcn_exp2f(-1.702f * 1.4426950408889634f * gg)); o[n][i] = gg * sg * (uu + 1.0f); } }
                u32x4 w; w.x = cvt_pk_bf16(o[0][0], o[0][1]); w.y = cvt_pk_bf16(o[0][2], o[0][3]); w.z = cvt_pk_bf16(o[1][0], o[1][1]); w.w = cvt_pk_bf16(o[1][2], o[1][3]);
                *(u32x4*)(ACT + ((size_t)u.pm * BM + r) * DFF + j0) = w; }
    }
};
struct EpiMoeDown {
    static constexpr bool PERM = true, META = true;
    bf16_t* Y; const float* gate; const float* bias;
    __device__ __forceinline__ void post(const Unit& u, LAS unsigned char* mb, int wid, int lane) const {
        const int r = (wid & 3) * 64 + lane, rc = r < u.rows ? r : 0;
        if (wid < 4) { __builtin_amdgcn_global_load_lds((const unsigned*)(u.rowidx + rc), (LAS unsigned*)(mb + wid * 256), 4, 0, 0);
                       __builtin_amdgcn_global_load_lds((const unsigned*)((const char*)(u.rowidx + rc) + (WS_ROWGATE - WS_ROWLIST)), (LAS unsigned*)(mb + 1024 + wid * 256), 4, 0, 0); }
        else __builtin_amdgcn_global_load_lds((const unsigned*)(bias + (size_t)u.e * DM + u.pn * BM + (wid - 4) * 64 + lane), (LAS unsigned*)(mb + 2048 + (wid - 4) * 256), 4, 0, 0);
    }
    __device__ __forceinline__ void operator()(const f32x4 (&acc)[2][2][4][2], const Unit& u, int wr, int wc, int fr, int fq, const LAS unsigned char* mb) const {
        asm volatile("" : "+v"(fr), "+v"(fq));
        const int col0 = u.pn * BM + wc * 32 + 8 * fq;
        f32x4 bv[2][2];
#pragma unroll
        for (int bj = 0; bj < 2; ++bj)
#pragma unroll
            for (int n = 0; n < 2; ++n) bv[bj][n] = *(const LAS f32x4*)(mb + 2048 + (bj * HALF + wc * 32 + 8 * fq + 4 * n) * 4);
#pragma unroll
        for (int ai = 0; ai < 2; ++ai)
#pragma unroll
            for (int m = 0; m < 4; ++m) { const int r = ai * HALF + wr * 64 + m * 16 + fr;
                const int a = (r < u.rows) ? *(const LAS int*)(mb + r * 4) : NASSIGN;
                const float g = *(const LAS float*)(mb + 1024 + r * 4);
#if Y_FP8
                unsigned char* rowp = (unsigned char*)Y + (size_t)a * DM + col0; const float g16 = g * 16.0f;
#pragma unroll
                for (int bj = 0; bj < 2; ++bj) { const f32x4 v0 = (acc[ai][bj][m][0] + bv[bj][0]) * g16, v1 = (acc[ai][bj][m][1] + bv[bj][1]) * g16;
                    u32x2 w; w.x = pk_fp8x4(v0[0], v0[1], v0[2], v0[3]); w.y = pk_fp8x4(v1[0], v1[1], v1[2], v1[3]);
                    *(u32x2*)(rowp + bj * HALF) = w; } }
#else
                bf16_t* rowp = Y + (size_t)a * DM + col0;
#pragma unroll
                for (int bj = 0; bj < 2; ++bj) { const f32x4 v0 = (acc[ai][bj][m][0] + bv[bj][0]) * g, v1 = (acc[ai][bj][m][1] + bv[bj][1]) * g;
                    u32x4 w; w.x = cvt_pk_bf16(v0[0], v0[1]); w.y = cvt_pk_bf16(v0[2], v0[3]); w.z = cvt_pk_bf16(v1[0], v1[1]); w.w = cvt_pk_bf16(v1[2], v1[3]);
                    *(u32x4*)(rowp + bj * HALF) = w; } }
#endif
    }
};
struct EpiMoeUpQ {
    static constexpr bool PERM = true, META = true;
    unsigned char* ACT; const float* rstd; const float* bias;
    __device__ __forceinline__ void post(const Unit& u, LAS unsigned char* mb, int wid, int lane) const {
        const int r = (wid & 3) * 64 + lane, rc = r < u.rows ? r : 0;
        if (wid < 4) __builtin_amdgcn_global_load_lds((const unsigned*)((const char*)(u.rowidx + rc) + (WS_ROWRSTD - WS_ROWLIST)), (LAS unsigned*)(mb + wid * 256), 4, 0, 0);
        else __builtin_amdgcn_global_load_lds((const unsigned*)(bias + (size_t)u.e * 4096 + ((wid - 4) >> 1) * 2048 + u.pn * HALF + ((wid - 4) & 1) * 64 + lane), (LAS unsigned*)(mb + 1024 + (wid - 4) * 256), 4, 0, 0);
    }
    __device__ __forceinline__ void operator()(const f32x4 (&acc)[2][2][4][2], const Unit& u, int wr, int wc, int fr, int fq, const LAS unsigned char* mb) const {
        asm volatile("" : "+v"(fr), "+v"(fq));
        const int j0 = u.pn * HALF + wc * 32 + 8 * fq, jl = wc * 32 + 8 * fq;
        const f32x4 bg0 = *(const LAS f32x4*)(mb + 1024 + jl * 4), bg1 = *(const LAS f32x4*)(mb + 1024 + jl * 4 + 16), bu0 = *(const LAS f32x4*)(mb + 1536 + jl * 4), bu1 = *(const LAS f32x4*)(mb + 1536 + jl * 4 + 16);
#pragma unroll
        for (int ai = 0; ai < 2; ++ai)
#pragma unroll
            for (int m = 0; m < 4; ++m) { const int r = ai * HALF + wr * 64 + m * 16 + fr; const float s = *(const LAS float*)(mb + r * 4);
                f32x4 o[2];
#pragma unroll
                for (int n = 0; n < 2; ++n) { const f32x4 g4 = acc[ai][0][m][n] * s + (n ? bg1 : bg0), u4 = acc[ai][1][m][n] * s + (n ? bu1 : bu0);
#pragma unroll
                    for (int hh = 0; hh < 2; ++hh) { f32x2 g = {g4[2 * hh], g4[2 * hh + 1]}, up = {u4[2 * hh], u4[2 * hh + 1]};
                        g = __builtin_elementwise_min(g, (f32x2){7.0f, 7.0f}); up = __builtin_elementwise_min(__builtin_elementwise_max(up, (f32x2){-7.0f, -7.0f}), (f32x2){7.0f, 7.0f});
                        const f32x2 ea = g * (-1.702f * 1.4426950408889634f); f32x2 e; e.x = __builtin_amdgcn_exp2f(ea.x); e.y = __builtin_amdgcn_exp2f(ea.y);
                        const f32x2 d = e + 1.0f; f32x2 sg; sg.x = __builtin_amdgcn_rcpf(d.x); sg.y = __builtin_amdgcn_rcpf(d.y);
                        const f32x2 t = g * 4.0f, r2 = (t * up + t) * sg; o[n][2 * hh] = r2.x; o[n][2 * hh + 1] = r2.y; } }
                u32x2 w; w.x = pk_fp8x4(o[0][0], o[0][1], o[0][2], o[0][3]); w.y = pk_fp8x4(o[1][0], o[1][1], o[1][2], o[1][3]);
                *(u32x2*)(ACT + ((size_t)u.pm * BM + r) * DFF + j0) = w; }
    }
};
struct MoeOrder {
    const char* A; const char* B; const int* rowlist; const int* ident; const LAS int* tab; int NT, K; size_t bexp; int G, c;
    __device__ __forceinline__ bool next(int i, Unit& u) const {
        if (i >= 32) return false;
        const LAS int* en = tab + 1024 + 8 * i;
        const int valid = __builtin_amdgcn_readfirstlane(en[0]); if (!valid) return false;
        const int e = __builtin_amdgcn_readfirstlane(en[1]), ntile = __builtin_amdgcn_readfirstlane(en[2]), pm = __builtin_amdgcn_readfirstlane(en[3]), rows = __builtin_amdgcn_readfirstlane(en[4]),
                  mrow = __builtin_amdgcn_readfirstlane(en[5]);
        u.e = e; u.pn = ntile; u.pm = pm; u.rows = rows;
        u.rowidx = rowlist + (size_t)e * NTOK + (size_t)mrow * BM;
        u.B = B + (size_t)e * bexp + (size_t)ntile * BM * K * 2;
        u.A = A;
        if (ident) { u.gidx = ident + (size_t)u.pm * BM; u.grows = BM; } else { u.gidx = u.rowidx; u.grows = u.rows; }
        return true;
    }
};
}
__device__ __forceinline__ void moe_build_table(LAS int* tab, const unsigned* cnt, int NT) {
    if (threadIdx.x == 0) { int ng = 0, start = 0, slot = 0;
        for (int e = 0; e < NEXP; ++e) { const int c = (int)cnt[e]; const int tiles = (c + 255) >> 8;
            for (int mt0 = 0; mt0 < tiles; mt0 += 8) { const int gsz = (tiles - mt0) < 8 ? (tiles - mt0) : 8; LAS int* en = tab + 8 + 8 * ng;
                en[0] = start; en[1] = e; en[2] = mt0; en[3] = gsz; en[4] = slot + mt0; en[5] = c - mt0 * 256; ++ng; start += gsz * NT; }
            slot += tiles; }
        tab[0] = ng; tab[1] = start; }
    __syncthreads();
    if (threadIdx.x < 32) { const int i = threadIdx.x, G = gridDim.x, c = blockIdx.x; const int total = tab[1], ng = tab[0]; LAS int* en = tab + 1024 + 8 * i;
        const long L = (long)i * G + c;
        if (L >= total) { en[0] = 0; }
        else { int p = (int)L; { const int q = total / pg8::NXCD, r = total % pg8::NXCD, xcd = p % pg8::NXCD, off = p / pg8::NXCD; p = (xcd < r ? xcd * (q + 1) : r * (q + 1) + (xcd - r) * q) + off; }
            int g = 0; while (g + 1 < ng && tab[8 + 8 * (g + 1)] <= p) ++g;
            const LAS int* ge = tab + 8 + 8 * g; const int qn = p - ge[0], gsz = ge[3], ntile = qn / gsz, mi = qn - ntile * gsz, rl = ge[5] - mi * 256;
            en[0] = 1; en[1] = ge[1]; en[2] = ntile; en[3] = ge[4] + mi; en[4] = rl < 256 ? rl : 256; en[5] = ge[2] + mi; } }
    __syncthreads();
}
__device__ __forceinline__ void gla_chunk_kv(int unit, const bf16_t* proj, const float* la, float* KV, float* Dc, char* lds) {
    const int tid = threadIdx.x, wid = __builtin_amdgcn_readfirstlane(tid >> 6), lane = tid & 63, r32 = lane & 31, hi = lane >> 5;
    const int b = unit >> 8, h = (unit >> 6) & 3, c = unit & 63; const size_t tok0 = (size_t)b * SEQ + (size_t)c * 64;
    char* V_lds = lds;
    const int dk = 32 * (wid & 3) + r32, hd = h * 128 + dk;
    float lav[64];
#pragma unroll
    for (int s = 0; s < 64; ++s) lav[s] = la[(tok0 + s) * 512 + hd];
    float kv[4][8];
#pragma unroll
    for (int ks = 0; ks < 4; ++ks)
#pragma unroll
        for (int j = 0; j < 8; ++j) kv[ks][j] = bf2f(proj[(tok0 + 16 * ks + 8 * hi + j) * NPROJ + C_KG + hd]);
    { const int sr = tid >> 4, sc = (tid & 15) * 8;
#pragma unroll
      for (int hf = 0; hf < 2; ++hf) { const bf16_t* vp = proj + (tok0 + sr) * NPROJ + C_VG + h * 256 + hf * 128 + sc;
          const bf16x8 a = *(const bf16x8*)vp, bb = *(const bf16x8*)(vp + (size_t)32 * NPROJ);
          *(bf16x8*)(V_lds + hf * fox::SHM_V + fox::v_st(sr, sc)) = a; *(bf16x8*)(V_lds + hf * fox::SHM_V + fox::v_st(32 + sr, sc)) = bb; } }
    float rsum = 0.f; float fr[4][8];
#pragma unroll
    for (int ks = 3; ks >= 0; --ks)
#pragma unroll
        for (int h2 = 1; h2 >= 0; --h2)
#pragma unroll
            for (int j = 7; j >= 0; --j) { const int s = 16 * ks + 8 * h2 + j;
                const float dec = __builtin_amdgcn_exp2f(rsum * 1.4426950408889634f);
                if (h2 == hi) fr[ks][j] = kv[ks][j] * dec;
                rsum += lav[s]; }
    bf16x8 pa[4];
#pragma unroll
    for (int ks = 0; ks < 4; ++ks) pa[ks] = pack8((f32x4){fr[ks][0], fr[ks][1], fr[ks][2], fr[ks][3]}, (f32x4){fr[ks][4], fr[ks][5], fr[ks][6], fr[ks][7]});
    __syncthreads();
    f32x16 o[4] = {};
    const int vb0 = (int)(uintptr_t)V_lds + fox::v_rd_base(lane);
    if ((wid >> 2) == 0) fox::pv_tile<0>(o, vb0, pa[0], pa[1], pa[2], pa[3]); else fox::pv_tile<1>(o, vb0, pa[0], pa[1], pa[2], pa[3]);
    bf16_t* kvo = (bf16_t*)KV + (size_t)unit * (128 * 256) + (size_t)((wid >> 2) * 128 + r32) * 128 + 32 * (wid & 3) + 4 * hi;
#pragma unroll
    for (int d0 = 0; d0 < 4; ++d0)
#pragma unroll
        for (int g = 0; g < 4; ++g) { u32x2 w; w.x = cvt_pk_bf16(o[d0][4 * g], o[d0][4 * g + 1]); w.y = cvt_pk_bf16(o[d0][4 * g + 2], o[d0][4 * g + 3]); *(u32x2*)(kvo + (size_t)d0 * 32 * 128 + 8 * g) = w; }
    if (hi == 0 && (wid >> 2) == 0) Dc[(size_t)unit * 128 + dk] = __builtin_amdgcn_exp2f(rsum * 1.4426950408889634f);
    __syncthreads();
}
struct GlaSet { bf16x8 kv[4]; bf16x8 qf[4]; };
__device__ __forceinline__ void gla_ld(GlaSet& R, int c, int b, int h, int sl, int mt, const bf16_t* proj, const bf16_t* KV, int r, int q) {
    const bf16_t* kvp = KV + (size_t)((b * 4 + h) * 64 + c) * (128 * 256) + (size_t)(sl * 16 + r) * 128 + 8 * q;
    const bf16_t* qp = proj + ((size_t)b * SEQ + (size_t)c * 64 + 16 * mt + r) * NPROJ + C_QG + h * 128 + 8 * q;
#pragma unroll
    for (int ks = 0; ks < 4; ++ks) { R.qf[ks] = *(const bf16x8*)(qp + 32 * ks); R.kv[ks] = *(const bf16x8*)(kvp + 32 * ks); }
}
typedef _Float16 f16x4 __attribute__((ext_vector_type(4)));
typedef _Float16 f16x8 __attribute__((ext_vector_type(8)));
__device__ __forceinline__ void gla_step(const GlaSet& R, f32x4 (&S)[4][2], const LAS _Float16* dl, int c, int b, int h, int sl, int mt, float* GO, int r, int q) {
    f32x4 o = {0.f, 0.f, 0.f, 0.f};
#pragma unroll
    for (int ks = 0; ks < 4; ++ks) { const f16x8 dh = *(const LAS f16x8*)(dl + c * 128 + 32 * ks + 8 * q);
        const f32x4 d0 = {(float)dh[0], (float)dh[1], (float)dh[2], (float)dh[3]}, d1 = {(float)dh[4], (float)dh[5], (float)dh[6], (float)dh[7]};
        S[ks][0] = d0 * S[ks][0] + bf_up4(R.kv[ks], 0); S[ks][1] = d1 * S[ks][1] + bf_up4(R.kv[ks], 1);
        o = __builtin_amdgcn_mfma_f32_16x16x32_bf16(pack8(S[ks][0], S[ks][1]), R.qf[ks], o, 0, 0, 0); }
    u32x2 w; w.x = cvt_pk_bf16(o[0], o[1]); w.y = cvt_pk_bf16(o[2], o[3]);
    *(u32x2*)((bf16_t*)GO + ((size_t)b * SEQ + (size_t)c * 64 + 16 * mt + r) * 1024 + h * 256 + sl * 16 + 4 * q) = w;
}
__device__ __forceinline__ void gla_scan(int unit, const bf16_t* proj, const float* KVf, float* GO, const LAS _Float16* dl, int lane) {
    const bf16_t* KV = (const bf16_t*)KVf;
    const int mt = unit & 3, u2 = unit >> 2, b = u2 >> 6, h = (u2 >> 4) & 3, sl = u2 & 15, r = lane & 15, q = lane >> 4;
    f32x4 S[4][2];
#pragma unroll
    for (int ks = 0; ks < 4; ++ks) { S[ks][0] = (f32x4){0.f, 0.f, 0.f, 0.f}; S[ks][1] = S[ks][0]; }
    GlaSet R0, R1, R2, R3;
    gla_ld(R0, 0, b, h, sl, mt, proj, KV, r, q); gla_ld(R1, 1, b, h, sl, mt, proj, KV, r, q); gla_ld(R2, 2, b, h, sl, mt, proj, KV, r, q);
#pragma unroll 1
    for (int c = 0; c < 64; c += 4) {
        gla_ld(R3, c + 3, b, h, sl, mt, proj, KV, r, q);
        gla_step(R0, S, dl, c, b, h, sl, mt, GO, r, q);
        if (c + 4 < 64) gla_ld(R0, c + 4, b, h, sl, mt, proj, KV, r, q);
        gla_step(R1, S, dl, c + 1, b, h, sl, mt, GO, r, q);
        if (c + 4 < 64) gla_ld(R1, c + 5, b, h, sl, mt, proj, KV, r, q);
        gla_step(R2, S, dl, c + 2, b, h, sl, mt, GO, r, q);
        if (c + 4 < 64) gla_ld(R2, c + 6, b, h, sl, mt, proj, KV, r, q);
        gla_step(R3, S, dl, c + 3, b, h, sl, mt, GO, r, q);
    }
    LDS_WAIT(); asm volatile("" ::: "memory");
}
__device__ __forceinline__ void gla_finish8(int th0, const float* GO, const bf16_t* proj, const float* gain, bf16_t* mix, int lane) {
    f32x4 v[8]; u32x2 gw[8];
#pragma unroll
    for (int i = 0; i < 8; ++i) { const int th = th0 + i, tok = th >> 2, h = th & 3;
        { const u32x2 w = *(const u32x2*)((const bf16_t*)GO + (size_t)tok * 1024 + h * 256 + lane * 4); v[i] = (f32x4){__uint_as_float(w.x << 16), __uint_as_float(w.x & 0xffff0000u), __uint_as_float(w.y << 16), __uint_as_float(w.y & 0xffff0000u)}; } gw[i] = *(const u32x2*)(proj + (size_t)tok * NPROJ + C_GG + h * 256 + lane * 4); }
#pragma unroll
    for (int i = 0; i < 8; ++i) { const int th = th0 + i, tok = th >> 2, h = th & 3;
        const float ss = wave_sum((v[i][0] * v[i][0] + v[i][1] * v[i][1]) + (v[i][2] * v[i][2] + v[i][3] * v[i][3]));
        const float rs = 1.0f / sqrtf(ss * (1.0f / 256.0f) + EPS);
        const f32x4 g = *(const f32x4*)(gain + h * 256 + lane * 4);
        const float g0 = __uint_as_float(gw[i].x << 16), g1 = __uint_as_float(gw[i].x & 0xffff0000u), g2 = __uint_as_float(gw[i].y << 16), g3 = __uint_as_float(gw[i].y & 0xffff0000u);
        auto silu = [](float x) { return x * __builtin_amdgcn_rcpf(1.0f + __expf(-x)); };
        u32x2 w; w.x = cvt_pk_bf16(v[i][0] * rs * g[0] * silu(g0), v[i][1] * rs * g[1] * silu(g1)); w.y = cvt_pk_bf16(v[i][2] * rs * g[2] * silu(g2), v[i][3] * rs * g[3] * silu(g3));
        *(u32x2*)(mix + (size_t)tok * DM + h * 256 + lane * 4) = w; }
}

__device__ __forceinline__ void fox_combine8(int th0, const float* PO, const float* ML, const float* gain, bf16_t* mix, int lane) {
    const int l32 = lane & 31, sub = lane >> 5; constexpr float C2 = 1.4426950408889634f * 0.08838834764831845f;
    f32x4 o0[4], o1[4]; f32x2 ml0[4], ml1[4];
#pragma unroll
    for (int i = 0; i < 4; ++i) { const size_t th = (size_t)(th0 + 2 * i + sub);
        { const u32x2 w0 = *(const u32x2*)((const bf16_t*)PO + th * 128 + l32 * 4), w1 = *(const u32x2*)((const bf16_t*)PO + (size_t)NTOK * 512 + th * 128 + l32 * 4);
          o0[i] = (f32x4){__uint_as_float(w0.x << 16), __uint_as_float(w0.x & 0xffff0000u), __uint_as_float(w0.y << 16), __uint_as_float(w0.y & 0xffff0000u)};
          o1[i] = (f32x4){__uint_as_float(w1.x << 16), __uint_as_float(w1.x & 0xffff0000u), __uint_as_float(w1.y << 16), __uint_as_float(w1.y & 0xffff0000u)}; }
        ml0[i] = *(const f32x2*)(ML + th * 2); ml1[i] = *(const f32x2*)(ML + (size_t)NTOK * 8 + th * 2); }
#pragma unroll
    for (int i = 0; i < 4; ++i) { const int th = th0 + 2 * i + sub, tok = th >> 2, h = th & 3;
        const float m = fmaxf(ml0[i][0], ml1[i][0]), a0 = __builtin_amdgcn_exp2f((ml0[i][0] - m) * C2), a1 = __builtin_amdgcn_exp2f((ml1[i][0] - m) * C2);
        const float inv = 1.0f / (ml0[i][1] * a0 + ml1[i][1] * a1);
        const f32x4 v = (o0[i] * a0 + o1[i] * a1) * inv;
        float ss = (v[0] * v[0] + v[1] * v[1]) + (v[2] * v[2] + v[3] * v[3]);
        ss += __shfl_xor(ss, 1); ss += __shfl_xor(ss, 2); ss += __shfl_xor(ss, 4); ss += __shfl_xor(ss, 8); ss += __shfl_xor(ss, 16);
        const float rs = 1.0f / sqrtf(ss * (1.0f / 128.0f) + EPS);
        const float* g = gain + h * 128 + l32;
        u32x2 w; w.x = cvt_pk_bf16(v[0] * rs * g[0], v[1] * rs * g[32]); w.y = cvt_pk_bf16(v[2] * rs * g[64], v[3] * rs * g[96]);
        *(u32x2*)(mix + (size_t)tok * DM + 1024 + h * 128 + l32 * 4) = w; }
}

__device__ __forceinline__ void memkv_tile(int t, const bf16_t* memb, const bf16_t* WT, const float* rstd, bf16_t* KM, bf16_t* VT, int lane) {
    const int rt = t >> 5, ct = t & 31, r = lane & 15, q = lane >> 4;
    const bf16_t* ap = memb + (size_t)(rt * 32 + r) * DM + q * 16; const bf16_t* bp = WT + (size_t)(ct * 32 + r) * DM + q * 16;
    f32x4 acc[2][2] = {};
#pragma unroll 4
    for (int kb = 0; kb < 32; ++kb) {
        bf16x8 a[2][2], bb[2][2];
#pragma unroll
        for (int i = 0; i < 2; ++i)
#pragma unroll
            for (int s = 0; s < 2; ++s) { a[i][s] = *(const bf16x8*)(ap + (size_t)i * 16 * DM + kb * 64 + s * 8); bb[i][s] = *(const bf16x8*)(bp + (size_t)i * 16 * DM + kb * 64 + s * 8); }
#pragma unroll
        for (int i = 0; i < 2; ++i)
#pragma unroll
            for (int j = 0; j < 2; ++j)
#pragma unroll
                for (int s = 0; s < 2; ++s) acc[i][j] = __builtin_amdgcn_mfma_f32_16x16x32_bf16(a[i][s], bb[j][s], acc[i][j], 0, 0, 0);
    }
#pragma unroll
    for (int i = 0; i < 2; ++i) { const int row = rt * 32 + 16 * i + 4 * q;
        const f32x4 rs = *(const f32x4*)(rstd + row);
#pragma unroll
        for (int j = 0; j < 2; ++j) { const int col = ct * 32 + 16 * j + r; const f32x4 v = acc[i][j] * rs;
            if (col < 512) {
#pragma unroll
                for (int tt = 0; tt < 4; ++tt) KM[(size_t)(row + tt) * 512 + col] = (bf16_t)(cvt_pk_bf16(v[tt], 0.f) & 0xffffu); }
            else { const int hd = col - 512, bb2 = row >> 8, key = row & 255; u32x2 w; w.x = cvt_pk_bf16(v[0], v[1]); w.y = cvt_pk_bf16(v[2], v[3]);
                *(u32x2*)(VT + ((size_t)(bb2 * 4 + (hd >> 7)) * 128 + (hd & 127)) * 256 + key) = w; } } }
}
__device__ __forceinline__ void memattn_unit(int bh, int qt, const bf16_t* proj, const LAS unsigned char* kl, const LAS unsigned char* vl, const float* gain, bf16_t* mix, int lane) {
    const int b = bh >> 2, h = bh & 3, r32 = lane & 31, hi = lane >> 5;
    const size_t tok0 = (size_t)b * SEQ + (size_t)qt * 32;
    bf16x8 qr[8];
#pragma unroll
    for (int d0 = 0; d0 < 8; ++d0) qr[d0] = *(const bf16x8*)(proj + (tok0 + r32) * NPROJ + C_QM + h * 128 + d0 * 16 + hi * 8);
    const int sw = r32 & 15;
    const LAS unsigned char* ka[8];
#pragma unroll
    for (int d0 = 0; d0 < 8; ++d0) ka[d0] = kl + r32 * 256 + (((2 * d0 + hi) ^ sw) << 4);
    float mx = -3.0e38f;
#pragma unroll 1
    for (int j = 0; j < 8; ++j) { f32x16 p = {}; const int ko = j * 32 * 256;
#pragma unroll
        for (int d0 = 0; d0 < 8; ++d0) p = __builtin_amdgcn_mfma_f32_32x32x16_bf16(*(const LAS bf16x8*)(ka[d0] + ko), qr[d0], p, 0, 0, 0);
#pragma unroll
        for (int r = 0; r < 16; ++r) mx = fmaxf(mx, p[r]); }
    { auto rr = __builtin_amdgcn_permlane32_swap(__float_as_uint(mx), __float_as_uint(mx), false, false); mx = fmaxf(__uint_as_float(rr[0]), __uint_as_float(rr[1])); }
    constexpr float C2 = 1.4426950408889634f * 0.08838834764831845f; const float mL = -mx * C2;
    float ps = 0.f;
    f32x16 o[4] = {};
    const LAS unsigned char* va[4];
#pragma unroll
    for (int ks = 0; ks < 4; ++ks) va[ks] = vl + r32 * 512 + (((2 * ks + hi) ^ (sw & 7)) << 4);
#define PK4(P, B_, OUT) do { unsigned a0 = cvt_pk_bf16(P[B_+0], P[B_+1]), a1 = cvt_pk_bf16(P[B_+2], P[B_+3]), b0 = cvt_pk_bf16(P[B_+4], P[B_+5]), b1 = cvt_pk_bf16(P[B_+6], P[B_+7]); \
        auto r0 = __builtin_amdgcn_permlane32_swap(a0, b0, false, false); auto r1 = __builtin_amdgcn_permlane32_swap(a1, b1, false, false); \
        u32x4 w = {r0[0], r1[0], r0[1], r1[1]}; OUT = __builtin_bit_cast(bf16x8, w); } while (0)
#pragma unroll 1
    for (int jj = 0; jj < 4; ++jj) { f32x16 p0 = {}, p1 = {}; const int ko = jj * 64 * 256;
#pragma unroll
        for (int d0 = 0; d0 < 8; ++d0) { p0 = __builtin_amdgcn_mfma_f32_32x32x16_bf16(*(const LAS bf16x8*)(ka[d0] + ko), qr[d0], p0, 0, 0, 0);
                                         p1 = __builtin_amdgcn_mfma_f32_32x32x16_bf16(*(const LAS bf16x8*)(ka[d0] + ko + 32 * 256), qr[d0], p1, 0, 0, 0); }
#pragma unroll
        for (int r = 0; r < 16; ++r) { p0[r] = __builtin_amdgcn_exp2f(fmaf(p0[r], C2, mL)); p1[r] = __builtin_amdgcn_exp2f(fmaf(p1[r], C2, mL)); ps += p0[r] + p1[r]; }
        bf16x8 pa[4];
        PK4(p0, 0, pa[0]); PK4(p0, 8, pa[1]); PK4(p1, 0, pa[2]); PK4(p1, 8, pa[3]);
        const int vo = (jj >> 1) * 256 + ((((jj & 1) << 3) ^ (sw & 8)) << 4);
#pragma unroll
        for (int ks = 0; ks < 4; ++ks)
#pragma unroll
            for (int d0 = 0; d0 < 4; ++d0) o[d0] = __builtin_amdgcn_mfma_f32_32x32x16_bf16(pa[ks], *(const LAS bf16x8*)(va[ks] + vo + d0 * 32 * 512), o[d0], 0, 0, 0); }
#undef PK4
    { auto rr = __builtin_amdgcn_permlane32_swap(__float_as_uint(ps), __float_as_uint(ps), false, false); ps = __uint_as_float(rr[0]) + __uint_as_float(rr[1]); }
    const float rl = __builtin_amdgcn_rcpf(ps);
    const float g0 = gain[h * 128 + r32], g1 = gain[h * 128 + 32 + r32], g2 = gain[h * 128 + 64 + r32], g3 = gain[h * 128 + 96 + r32];
    bf16_t* out = mix + tok0 * DM + 1536 + h * 128;
#pragma unroll
    for (int r = 0; r < 16; ++r) { const int orow = fox::crow(r, hi); const float rlr = __shfl(rl, orow);
        const float v0 = o[0][r] * rlr, v1 = o[1][r] * rlr, v2 = o[2][r] * rlr, v3 = o[3][r] * rlr;
        float ss = (v0 * v0 + v1 * v1) + (v2 * v2 + v3 * v3);
        ss += __shfl_xor(ss, 1); ss += __shfl_xor(ss, 2); ss += __shfl_xor(ss, 4); ss += __shfl_xor(ss, 8); ss += __shfl_xor(ss, 16);
        const float rs = 1.0f / sqrtf(ss * (1.0f / 128.0f) + EPS);
        u32x2 w; w.x = cvt_pk_bf16(v0 * rs * g0, v1 * rs * g1); w.y = cvt_pk_bf16(v2 * rs * g2, v3 * rs * g3);
        *(u32x2*)(out + (size_t)orow * DM + r32 * 4) = w; }
}

constexpr int NWAVES = 8;
constexpr int CONV_ALL = 49152, CONV_P1 = 3072, CONV_P7 = 3072, CONV_P2 = CONV_ALL - CONV_P1 - CONV_P7;
#ifndef MK_N_LAUNCHES
#define MK_N_LAUNCHES 1
#endif
#ifndef REP_PHASE
#define REP_PHASE -1
#endif
#ifndef REP_EXTRA
#define REP_EXTRA 1
#endif
#define REP_SUB 0
constexpr int PER_PHASE = 11;
constexpr int N_LAUNCHES = MK_N_LAUNCHES;
struct Args {
    const float *x, *mem, *g_attn, *g_mem, *w_in, *w_a2, *b_a, *g_gla, *b_fox, *g_fox, *w_mkv, *g_memo, *w_out, *g_ffn, *w_router, *b_router, *w_up, *b_up, *w_down, *b_down, *g_final;
    float* out; unsigned char* ws; int ph_lo, ph_hi;
};
typedef const __attribute__((address_space(4))) Args* KArgs;
__device__ __forceinline__ KArgs kargs() { KArgs p = (KArgs)__builtin_amdgcn_kernarg_segment_ptr(); asm volatile("" : "+s"(p)); return p; }
__global__ void __launch_bounds__(NWAVES * 64, 2) fwd(Args a_unused) {
    extern __shared__ __attribute__((aligned(16))) unsigned char lds_raw[];
    LAS unsigned char* lds = (LAS unsigned char*)lds_raw;
    const int tid = threadIdx.x, lane = tid & 63, wave = __builtin_amdgcn_readfirstlane(tid >> 6);
    const int G = gridDim.x, bx = blockIdx.x;
    const int vcu = (G % 8 == 0) ? (bx % 8) * (G / 8) + bx / 8 : bx;
    const int gw = vcu * NWAVES + wave, NGW = G * NWAVES;
    unsigned char* ws = kargs()->ws;
    unsigned* ctl = (unsigned*)(ws + WS_CTL);
    volatile LAS unsigned* MISC = (volatile LAS unsigned*)(lds + MISC_OFF);
    for (int u = tid; u < (LDS_BYTES - MISC_OFF) / 4; u += NWAVES * 64) ((LAS unsigned*)(lds + MISC_OFF))[u] = 0u;
    __syncthreads();
    XcdBarrier bar; bar.bar = ctl + CW_BAR; bar.x = 0; bar.st = nullptr;
    if (N_LAUNCHES == 1) bar = xcd_barrier_post(ctl + CW_BAR, MISC + 8);
#define GRID_BAR() do { if (N_LAUNCHES == 1) xcd_barrier(bar); } while (0)
    const int lo = kargs()->ph_lo, hi_ph = kargs()->ph_hi & 0xff, sub = kargs()->ph_hi >> 8;
#define PART(i) (sub == 0 || ((sub >> (i)) & 1))
#ifndef PH_MASK
#define PH_MASK 0xFFFF
#endif
#define IN(k) (((PH_MASK >> (k)) & 1) && lo <= (k) && (k) < hi_ph)
#define BOTH(k) (IN(k) && IN((k) + 1))
    bf16_t* WsmT = (bf16_t*)(ws + WS_WSM); bf16_t* WrT = (bf16_t*)(ws + WS_WSM + 256 * 1024);
    float* rstd1 = (float*)(ws + WS_RSTD); float* rstdm = rstd1 + 16384; float* rstd2 = rstd1 + 32768;
    float* small = (float*)(ws + WS_SMALL); float* gate_a = (float*)(ws + WS_GATE); int* rowlist = (int*)(ws + WS_ROWLIST);
    bf16_t* WmkvT = (bf16_t*)(ws + WS_WMKV); bf16_t* WoutT = (bf16_t*)(ws + WS_WOUT); bf16_t* WinT = (bf16_t*)(ws + WS_WIN);
    bf16_t* memb = (bf16_t*)(ws + WS_MEMB); bf16_t* KM = (bf16_t*)(ws + WS_KVM); bf16_t* VT = (bf16_t*)(ws + WS_KVM + MiB);
    float* glaD = (float*)(ws + WS_GLAD); bf16_t* xb = (bf16_t*)(ws + WS_XB); bf16_t* proj = (bf16_t*)(ws + WS_PROJ); bf16_t* mix = (bf16_t*)(ws + WS_MIX);
    float* x1 = (float*)(ws + WS_X1); bf16_t* x1b = (bf16_t*)(ws + WS_X1B); float* glaKV = (float*)(ws + WS_GLAKV); float* glaO = (float*)(ws + WS_GLAO);
    bf16_t* WupT = (bf16_t*)(ws + WS_WUP); bf16_t* WdownT = (bf16_t*)(ws + WS_WDOWN); bf16_t* act = (bf16_t*)(ws + WS_ACT); bf16_t* ybuf = (bf16_t*)(ws + WS_Y);
    unsigned* cnt = ctl + CW_CNT; float* la = (float*)(ws + WS_LA); int* ident = (int*)(ws + WS_IDENT); float* rowgate = (float*)(ws + WS_ROWGATE); float* rowrstd = (float*)(ws + WS_ROWRSTD);

#if MOE_FP8
#define MOE_CONV_ITEM(r_) do { const int r = (int)(r_); KArgs kq = kargs(); LAS unsigned char* scr = lds + wave * 18432; \
        if (r < 32768) { const int e = r >> 10, q = r & 1023, kb = q >> 6, nb = q & 63, nt = nb >> 2, bj = (nb >> 1) & 1, j64 = nb & 1; \
            tr_item_fp8(kq->w_up + (size_t)e * DM * 4096, 4096, kb * 128, bj * 2048 + nt * 128 + j64 * 64, (unsigned char*)WupT + ((size_t)e * 4096 + nb * 64) * DM, DM, kq->g_ffn, 32.0f, scr, lane); } \
        else { const int r2 = r - 32768, e = r2 >> 9, q = r2 & 511, kb = q >> 5, nb = q & 31; \
            tr_item_fp8(kq->w_down + (size_t)e * DFF * DM, DM, kb * 128, nb * 64, (unsigned char*)WdownT + ((size_t)e * DM + nb * 64) * DFF, DFF, nullptr, 32.0f, scr, lane); } } while (0)
#else
#define MOE_CONV_ITEM(r_) do { const int r = (int)(r_); KArgs kq = kargs(); LAS unsigned char* scr = lds + wave * 18432; \
        if (r < 32768) { const int e = r >> 10, q = r & 1023, kb = q >> 5, nb = q & 31, nt = nb >> 1, bj = nb & 1; \
            tr_item<false>(kq->w_up + (size_t)e * DM * 4096, 4096, kb * 64, bj * 2048 + nt * 128, WupT + ((size_t)e * 4096 + nb * 128) * DM, DM, kq->g_ffn, 1.0f, scr, lane); } \
        else { const int r2 = r - 32768, e = r2 >> 9, q = r2 & 511, kb = q >> 4, nb = q & 15; \
            tr_item<false>(kq->w_down + (size_t)e * DFF * DM, DM, kb * 64, nb * 128, WdownT + ((size_t)e * DM + nb * 128) * DFF, DFF, nullptr, 1.0f, scr, lane); } } while (0)
#endif
    if (IN(0)) {
        KArgs ka = kargs();
        LAS unsigned char* scr = lds + wave * 18432; LAS float* scrf = (LAS float*)scr;
        constexpr int I_IN = 32 * 40, I_OUT = 32 * 16, I_MKV = 32 * 8, I_TH = 32;
        constexpr int NITEMS = I_IN + I_OUT + I_MKV + 2 * I_TH;
        for (int it = gw; it < NITEMS; it += NGW) {
            int r = it;
            if (r < I_IN) { const int kb = r / 40, nb = r % 40, n0 = nb * 128; const int sc0 = n0 < 3072 ? n0 : (n0 < 4608 ? n0 + 16 : n0 + 20);
                tr_item<false>(ka->w_in, 5140, kb * 64, sc0, WinT + (size_t)n0 * DM, DM, ka->g_attn, n0 < 512 ? 0.08838834764831845f : 1.0f, scr, lane); continue; } r -= I_IN;
            if (r < I_OUT) { const int kb = r >> 4, nb = r & 15;
                if (kb < 16) tr_item<false>(ka->w_out, DM, kb * 64, nb * 128, WoutT + (size_t)nb * 128 * DM, DM, nullptr, 1.0f, scr, lane);
                else tr_item<true>(ka->w_out, DM, kb * 64, nb * 128, WoutT + (size_t)nb * 128 * DM, DM, nullptr, 1.0f, scr, lane);
                continue; } r -= I_OUT;
            if (r < I_MKV) { const int kb = r >> 3, nb = r & 7;
                tr_item<false>(ka->w_mkv, 1024, kb * 64, nb * 128, WmkvT + (size_t)nb * 128 * DM, DM, ka->g_mem, 1.0f, scr, lane); continue; } r -= I_MKV;
            if (r < I_TH) { thin_item(0, ka->w_in, ka->g_attn, r * 64, WsmT, WsmT + 32 * 2048, scrf, lane); continue; } r -= I_TH;
            thin_item(1, ka->w_router, ka->g_ffn, r * 64, WrT, WrT + 32 * 2048, scrf, lane);
        }
        for (int i = gw * 64 + lane; i < MAXTILES * 256; i += NGW * 64) ident[i] = i << 2;
        for (int row = gw; row < NB * NMEM; row += NGW) {
            const float* xr = ka->mem + (size_t)row * DM + lane * 4; f32x4 v[8]; float ss = 0.f;
#pragma unroll
            for (int j = 0; j < 8; ++j) v[j] = *(const f32x4*)(xr + j * 256);
#pragma unroll
            for (int j = 0; j < 8; ++j) { ss += (v[j][0] * v[j][0] + v[j][1] * v[j][1]) + (v[j][2] * v[j][2] + v[j][3] * v[j][3]);
                u32x2 w; w.x = cvt_pk_bf16(v[j][0], v[j][1]); w.y = cvt_pk_bf16(v[j][2], v[j][3]); *(u32x2*)(memb + (size_t)row * DM + j * 256 + lane * 4) = w; }
            ss = wave_sum(ss); if (lane == 0) rstdm[row] = 1.0f / sqrtf(ss * (1.0f / DM) + EPS); }
        if (BOTH(0)) GRID_BAR();
    }
    if (IN(1)) {
        KArgs ka = kargs();
        LAS float* alw = (LAS float*)(lds + wave * 1024);
        LAS unsigned char* wl = lds + 8192;
        for (int gq8 = vcu; gq8 < NTOK / 128; gq8 += G) { const int gq = gq8 * 8 + wave; f32x4 acc2[2]; float rs;
            rowpass_wg<false>(ka->x, gq8 * 128, xb, WsmT, WsmT + 32 * 2048, acc2, rs, wl);
            int lane = tid & 63; asm volatile("" : "+v"(lane));
            if (lane < 16) rstd1[gq * 16 + lane] = rs;
            const int r = lane & 15, q = lane >> 4;
#pragma unroll
            for (int i = 0; i < 4; ++i) { const float rr = __shfl(rs, 4 * q + i);
                alw[(4 * q + i) * 16 + r] = acc2[0][i] * rr; small[(size_t)(gq * 16 + 4 * q + i) * 32 + 16 + r] = acc2[1][i] * rr; }
            LDS_WAIT(); asm volatile("" ::: "memory");
#pragma unroll 1
            for (int hb = 0; hb < 8; ++hb) { const int hd = hb * 64 + lane; float w[16];
#pragma unroll
                for (int k2 = 0; k2 < 16; ++k2) w[k2] = ka->w_a2[k2 * 512 + hd];
                const float ba = ka->b_a[hd];
#pragma unroll 4
                for (int rw = 0; rw < 16; ++rw) { const f32x4 a0 = *(const LAS f32x4*)(alw + rw * 16), a1 = *(const LAS f32x4*)(alw + rw * 16 + 4), a2 = *(const LAS f32x4*)(alw + rw * 16 + 8), a3 = *(const LAS f32x4*)(alw + rw * 16 + 12);
                    float z = ba;
                    z += a0[0] * w[0] + a0[1] * w[1] + a0[2] * w[2] + a0[3] * w[3]; z += a1[0] * w[4] + a1[1] * w[5] + a1[2] * w[6] + a1[3] * w[7];
                    z += a2[0] * w[8] + a2[1] * w[9] + a2[2] * w[10] + a2[3] * w[11]; z += a3[0] * w[12] + a3[1] * w[13] + a3[2] * w[14] + a3[3] * w[15];
                    const float ls = fminf(z, 0.f) - __logf(1.0f + __expf(-fabsf(z)));
                    la[(size_t)(gq * 16 + rw) * 512 + hd] = ls * (1.0f / 16.0f); } }
            LDS_WAIT(); asm volatile("" ::: "memory"); }
        for (int t = gw - NTOK / 16; t < 1024; t += NGW) if (t >= 0) memkv_tile(t, memb, WmkvT, rstdm, KM, VT, lane);
        if (NGW == 2048 && gw >= 1024) { for (int it = CONV_P2 + (gw - 1024); it < CONV_P2 + CONV_P1; it += 1024) MOE_CONV_ITEM(it); }
        else if (NGW != 2048) { for (int it = CONV_P2 + gw; it < CONV_P2 + CONV_P1; it += NGW) MOE_CONV_ITEM(it); }
        if (BOTH(1)) GRID_BAR();
    }
    if (IN(2)) {
        KArgs ka = kargs();
        pg8::StaticOrder S; S.init(xb, WinT, NTOK, NPROJ, DM, G, bx);
        pg8::EpiRowScaleBf16 E{proj, NPROJ, rstd1};
        const bool conv_first = (bx & 7) < 4;
        if (conv_first) { for (int it = gw; it < CONV_P2; it += NGW) MOE_CONV_ITEM(it); __syncthreads(); }
        pg8::gemm_phase<pg8::EpiRowScaleBf16, pg8::StaticOrder, false>(lds, DM, S, E);
        if (!conv_first) { __syncthreads(); for (int it = gw; it < CONV_P2; it += NGW) MOE_CONV_ITEM(it); }
        if (BOTH(2)) GRID_BAR();
    }
    if (IN(3)) {
        KArgs ka = kargs();
        if (G == 256) {
            const int j = bx >> 3, bh = 2 * (bx & 7) + (j >> 4), x = j & 7, sh = (j >> 3) & 1, b = bh >> 2, h = bh & 3;
            char* l = (char*)lds_raw; float* Fb = (float*)(l + fox::LDS_FB); float* wsum = (float*)(l + fox::LDS_WS);
            bf16_t* PO = (bf16_t*)(ws + WS_FOXO) + (size_t)sh * NTOK * 512; float* PML = (float*)(ws + WS_FOXML) + (size_t)sh * NTOK * 8;
            {
                const float bf = ka->b_fox[h]; float v[8]; float run = 0.f;
#pragma unroll
                for (int i = 0; i < 8; ++i) { const int k = tid * 8 + i; const float lf = log_sigmoid(small[((size_t)b * SEQ + k) * 32 + 16 + h] + bf); run += lf; v[i] = run; }
                float inc = run;
#pragma unroll
                for (int o = 1; o < 64; o <<= 1) { const float t2 = __shfl_up(inc, o); if (lane >= o) inc += t2; }
                if (lane == 63) wsum[wave] = inc;
                __syncthreads();
                float woff = 0.f; for (int w2 = 0; w2 < wave; ++w2) woff += wsum[w2];
                const float base = woff + inc - run;
#pragma unroll
                for (int i = 0; i < 8; ++i) Fb[tid * 8 + i] = -(base + v[i]) * (1.0f / fox::SCALE);
                __syncthreads(); }
#pragma unroll 1
            for (int pass = 0; pass < 2; ++pass) { const int qb = pass ? 15 - x : x, n = 4 * (qb + 1);
                fox::BlockRef cur; cur.Q = proj + (size_t)(b * SEQ + qb * 256) * NPROJ + C_QF + h * 128; cur.K = proj + (size_t)b * SEQ * NPROJ + C_KF + h * 128; cur.V = proj + (size_t)b * SEQ * NPROJ + C_VF + h * 128;
                cur.P0 = qb * 256; cur.j_lo = sh ? n / 2 : 0; cur.j_hi = sh ? n : n / 2;
                fox::Seam Sm; fox::prime(cur, l, Sm);
                fox::EpiPartial E{(float*)(PO + ((size_t)b * SEQ * 4 + h) * 128), PML + ((size_t)b * SEQ * 4 + h) * 2};
                fox::block<fox::EpiPartial>(cur, cur, l, Sm, E); }
        }
        for (int u = bx; u < 1024; u += G) gla_chunk_kv(u, proj, la, glaKV, glaD, (char*)lds_raw);
        if (BOTH(3)) GRID_BAR();
    }
    if (IN(4)) {
        KArgs ka = kargs();
#pragma unroll 1
        for (int g = vcu; g < 256; g += G) {
            const int bh = g >> 4; int tl = tid, ll = lane; asm volatile("" : "+v"(tl), "+v"(ll));
            { const float* dsrc = glaD + (size_t)bh * 8192; const bf16_t* ksrc = KM + (size_t)((bh >> 2) * 256) * 512 + (bh & 3) * 128; const bf16_t* vsrc = VT + (size_t)bh * 128 * 256;
              f32x4 t[4]; bf16x8 kk[8], vv[8];
#pragma unroll
              for (int i = 0; i < 4; ++i) t[i] = *(const f32x4*)(dsrc + (i * 512 + tl) * 4);
#pragma unroll
              for (int i = 0; i < 8; ++i) { const int idx = i * 512 + tl; kk[i] = *(const bf16x8*)(ksrc + (size_t)(idx >> 4) * 512 + (idx & 15) * 8); }
#pragma unroll
              for (int i = 0; i < 8; ++i) vv[i] = *(const bf16x8*)(vsrc + (size_t)(i * 512 + tl) * 8);
#pragma unroll
              for (int i = 0; i < 4; ++i) { const f16x4 hv = {(_Float16)t[i][0], (_Float16)t[i][1], (_Float16)t[i][2], (_Float16)t[i][3]}; *(LAS f16x4*)(lds + (i * 512 + tl) * 8) = hv; }
#pragma unroll
              for (int i = 0; i < 8; ++i) { const int idx = i * 512 + tl, row = idx >> 4, ch = idx & 15; *(LAS bf16x8*)(lds + 16384 + row * 256 + ((ch ^ (row & 15)) << 4)) = kk[i]; }
#pragma unroll
              for (int i = 0; i < 8; ++i) { const int idx = i * 512 + tl, row = idx >> 5, ch = idx & 31; *(LAS bf16x8*)(lds + 81920 + row * 512 + ((ch ^ (row & 15)) << 4)) = vv[i]; }
              __syncthreads(); }
            if (wave < 4) { if (PART(0)) gla_scan(g * 4 + wave, proj, glaKV, glaO, (const LAS _Float16*)lds, ll); }
            else if (PART(1)) { for (int i = 0; i < 2; ++i) memattn_unit(bh, (g & 15) * 8 + i * 4 + (wave - 4), proj, lds + 16384, lds + 81920, ka->g_memo, mix, ll); }
            __syncthreads();
        }
        if (BOTH(4)) GRID_BAR();
    }
    if (IN(5)) {
        KArgs ka = kargs();
        for (int th = gw * 8; th < NTOK * 4; th += NGW * 8) gla_finish8(th, glaO, proj, ka->g_gla, mix, lane);
        for (int th = gw * 8; th < NTOK * 4; th += NGW * 8) fox_combine8(th, (const float*)(ws + WS_FOXO), (const float*)(ws + WS_FOXML), ka->g_fox, mix, lane);
        if (BOTH(5)) GRID_BAR();
    }
    if (IN(6)) {
        KArgs ka = kargs();
        pg8::StaticOrder S; S.init(mix, WoutT, NTOK, DM, DM, G, bx);
        pg8::EpiResF32 E{ka->x, x1, DM};
        pg8::gemm_phase<pg8::EpiResF32, pg8::StaticOrder, false>(lds, DM, S, E);
        if (BOTH(6)) GRID_BAR();
    }
    if (IN(7)) {
        KArgs ka = kargs();
        LAS float* lg = (LAS float*)(lds + wave * 2048);
        LAS unsigned char* wl = lds + 16384;
        for (int gq8 = vcu; gq8 < NTOK / 128; gq8 += G) { const int gq = gq8 * 8 + wave; f32x4 acc2[2]; float rs;
            rowpass_wg<MOE_FP8 != 0>(x1, gq8 * 128, x1b, WrT, WrT + 32 * 2048, acc2, rs, wl);
            int lane = tid & 63; asm volatile("" : "+v"(lane));
            if (lane < 16) rstd2[gq * 16 + lane] = rs;
            const int r = lane & 15, q = lane >> 4;
#pragma unroll
            for (int i = 0; i < 4; ++i) { const float rr = __shfl(rs, 4 * q + i);
                lg[(4 * q + i) * 32 + r] = acc2[0][i] * rr + ka->b_router[r]; lg[(4 * q + i) * 32 + 16 + r] = acc2[1][i] * rr + ka->b_router[16 + r]; }
            LDS_WAIT(); asm volatile("" ::: "memory");
            if (lane < 16) { const int tok = gq * 16 + lane; const float rsrow = rs; float v[32];
#pragma unroll
                for (int e = 0; e < 32; ++e) v[e] = lg[lane * 32 + e];
                int idx[4]; float val[4];
#pragma unroll
                for (int k = 0; k < 4; ++k) { float best = -3.0e38f; int bi = 0;
#pragma unroll
                    for (int e = 0; e < 32; ++e) { const bool better = v[e] > best; best = better ? v[e] : best; bi = better ? e : bi; }
                    idx[k] = bi; val[k] = best;
#pragma unroll
                    for (int e = 0; e < 32; ++e) v[e] = (e == bi) ? -3.0e38f : v[e]; }
                const float e0 = 1.0f, e1 = __expf(val[1] - val[0]), e2 = __expf(val[2] - val[0]), e3 = __expf(val[3] - val[0]); const float inv = 1.0f / (e0 + e1 + e2 + e3);
                const float gt[4] = {e0 * inv, e1 * inv, e2 * inv, e3 * inv};
#pragma unroll
                for (int k = 0; k < 4; ++k) { const int asg = tok * 4 + k; const unsigned pos = atomicAdd(&cnt[idx[k]], 1u); const size_t rp = (size_t)idx[k] * NTOK + pos; rowlist[rp] = asg; rowgate[rp] = gt[k]; rowrstd[rp] = rsrow; } }
            LDS_WAIT(); asm volatile("" ::: "memory");
        }
        if (NGW == 2048 && gw >= 1024) { for (int it = CONV_P2 + CONV_P1 + (gw - 1024); it < CONV_ALL; it += 1024) MOE_CONV_ITEM(it); }
        else if (NGW != 2048) { for (int it = CONV_P2 + CONV_P1 + gw; it < CONV_ALL; it += NGW) MOE_CONV_ITEM(it); }
        if (BOTH(7)) GRID_BAR();
    }
    if (IN(8)) {
        KArgs ka = kargs();
        LAS int* tab = (LAS int*)(lds + TAB_OFF);
        moe_build_table(tab, cnt, 16);
#if MOE_FP8
        pg8::MoeOrder S{(const char*)x1b, (const char*)WupT, rowlist, nullptr, tab, 16, DM / 2, (size_t)4096 * DM, G, bx};
        pg8::EpiMoeUpQ E{(unsigned char*)act, rstd2, ka->b_up};
        pg8::gemm_phase<pg8::EpiMoeUpQ, pg8::MoeOrder, true, true, 127, 122>(lds, DM / 2, S, E);
#else
        pg8::MoeOrder S{(const char*)x1b, (const char*)WupT, rowlist, nullptr, tab, 16, DM, (size_t)4096 * DM * 2, G, bx};
        pg8::EpiMoeUp E{act, rstd2, ka->b_up};
        pg8::gemm_phase<pg8::EpiMoeUp, pg8::MoeOrder, true>(lds, DM, S, E);
#endif
        if (BOTH(8)) GRID_BAR();
    }
    if (IN(9)) {
        KArgs ka = kargs();
        LAS int* tab = (LAS int*)(lds + TAB_OFF);
        __syncthreads();
        moe_build_table(tab, cnt, 8);
#if MOE_FP8
        pg8::MoeOrder S{(const char*)act, (const char*)WdownT, rowlist, ident, tab, 8, DFF / 2, (size_t)DM * DFF, G, bx};
        pg8::EpiMoeDown E{ybuf, gate_a, ka->b_down};
        pg8::gemm_phase<pg8::EpiMoeDown, pg8::MoeOrder, true, true, 125, 122>(lds, DFF / 2, S, E);
#else
        pg8::MoeOrder S{(const char*)act, (const char*)WdownT, rowlist, ident, tab, 8, DFF, (size_t)DM * DFF * 2, G, bx};
        pg8::EpiMoeDown E{ybuf, gate_a, ka->b_down};
        pg8::gemm_phase<pg8::EpiMoeDown, pg8::MoeOrder, true>(lds, DFF, S, E);
#endif
        if (BOTH(9)) GRID_BAR();
    }
    if (IN(10)) {
        KArgs ka = kargs();
        const int lane = (int)__builtin_amdgcn_mbcnt_hi(~0u, __builtin_amdgcn_mbcnt_lo(~0u, 0u));
        for (int tok = gw; tok < NTOK; tok += NGW) {
            f32x4 v[8]; float ss = 0.f;
#if Y_FP8
            unsigned yw[4][8];
#pragma unroll
            for (int j = 0; j < 8; ++j) { v[j] = __builtin_nontemporal_load((const f32x4*)(x1 + (size_t)tok * DM + j * 256 + lane * 4));
#pragma unroll
                for (int k = 0; k < 4; ++k) yw[k][j] = __builtin_nontemporal_load((const unsigned*)((const unsigned char*)ybuf + ((size_t)tok * 4 + k) * DM + j * 256 + lane * 4)); }
#pragma unroll
            for (int j = 0; j < 8; ++j) {
#pragma unroll
                for (int k = 0; k < 4; ++k) { const f32x2 lo = __builtin_amdgcn_cvt_pk_f32_fp8((int)yw[k][j], false), hi2 = __builtin_amdgcn_cvt_pk_f32_fp8((int)yw[k][j], true);
                    v[j][0] += lo[0] * 0.0625f; v[j][1] += lo[1] * 0.0625f; v[j][2] += hi2[0] * 0.0625f; v[j][3] += hi2[1] * 0.0625f; }
#else
            u32x2 yw[4][8];
#pragma unroll
            for (int j = 0; j < 8; ++j) { v[j] = __builtin_nontemporal_load((const f32x4*)(x1 + (size_t)tok * DM + j * 256 + lane * 4));
#pragma unroll
                for (int k = 0; k < 4; ++k) yw[k][j] = __builtin_nontemporal_load((const u32x2*)(ybuf + ((size_t)tok * 4 + k) * DM + j * 256 + lane * 4)); }
#pragma unroll
            for (int j = 0; j < 8; ++j) {
#pragma unroll
                for (int k = 0; k < 4; ++k) { const u32x2 w = yw[k][j];
                    v[j][0] += __uint_as_float(w.x << 16); v[j][1] += __uint_as_float(w.x & 0xffff0000u); v[j][2] += __uint_as_float(w.y << 16); v[j][3] += __uint_as_float(w.y & 0xffff0000u); }
#endif
                ss += (v[j][0] * v[j][0] + v[j][1] * v[j][1]) + (v[j][2] * v[j][2] + v[j][3] * v[j][3]); }
            const float rs = 1.0f / sqrtf(wave_sum(ss) * (1.0f / DM) + EPS);
#pragma unroll
            for (int j = 0; j < 8; ++j) { const f32x4 g = *(const f32x4*)(ka->g_final + j * 256 + lane * 4); __builtin_nontemporal_store(v[j] * rs * g, (f32x4*)(ka->out + (size_t)tok * DM + j * 256 + lane * 4)); }
        }
    }
#undef IN
#undef BOTH
#undef GRID_BAR
}

extern "C" void kernel_launch(void* const* d_in, const int* in_sizes, int n_in, void* d_out, int out_size, void* d_ws, size_t ws_size, hipStream_t stream) {
    static int grid = 0;
    if (grid == 0) {
        if (n_in != 21 || in_sizes[0] != NTOK * DM || out_size != NTOK * DM || ws_size < WS_END) { fprintf(stderr, "kernel_launch: unexpected shapes (n_in %d, in0 %d, out %d, ws %zu)\n", n_in, n_in > 0 ? in_sizes[0] : -1, out_size, ws_size); grid = -1; return; }
        int dev = 0, cus = 0;
        if (hipGetDevice(&dev) != hipSuccess || hipDeviceGetAttribute(&cus, hipDeviceAttributeMultiprocessorCount, dev) != hipSuccess) { grid = -1; return; }
        if (hipFuncSetAttribute((const void*)fwd, hipFuncAttributeMaxDynamicSharedMemorySize, LDS_BYTES) != hipSuccess) { fprintf(stderr, "kernel_launch: hipFuncSetAttribute failed\n"); grid = -1; return; }
        int per_cu = 0; (void)hipOccupancyMaxActiveBlocksPerMultiprocessor(&per_cu, (const void*)fwd, NWAVES * 64, LDS_BYTES); (void)hipGetLastError();
        if (per_cu < 1) fprintf(stderr, "kernel_launch: occupancy query says %d\n", per_cu);
        grid = cus;
    }
    if (grid < 0) return;
    (void)hipMemsetAsync((char*)d_ws + WS_CTL, 0, CTL_ZERO_BYTES, stream);
    Args a{};
    const float** fp = (const float**)&a.x;
    for (int i = 0; i < 21; ++i) fp[i] = (const float*)d_in[i];
    a.out = (float*)d_out; a.ws = (unsigned char*)d_ws;
    if (N_LAUNCHES == 1) { a.ph_lo = 0; a.ph_hi = PER_PHASE; hipLaunchKernelGGL(fwd, dim3(grid), dim3(NWAVES * 64), LDS_BYTES, stream, a); }
    else for (int p = 0; p < PER_PHASE; ++p) { a.ph_lo = p; a.ph_hi = p + 1;
        for (int rep = 0; rep < ((p == REP_PHASE) ? 1 + REP_EXTRA : 1); ++rep) { a.ph_hi = (p + 1) | ((rep > 0 ? REP_SUB : 0) << 8); hipLaunchKernelGGL(fwd, dim3(grid), dim3(NWAVES * 64), LDS_BYTES, stream, a); } }
}
```

```cpp
#include <hip/hip_runtime.h>
#include <cstdio>
#include <cstdint>

#define GAS __attribute__((address_space(1)))
#define LAS __attribute__((address_space(3)))
typedef unsigned short bf16_t;
typedef short bf16x8 __attribute__((ext_vector_type(8)));
typedef short s16x4 __attribute__((ext_vector_type(4)));
typedef float f32x2 __attribute__((ext_vector_type(2)));
typedef float f32x4 __attribute__((ext_vector_type(4)));
typedef float f32x16 __attribute__((ext_vector_type(16)));
typedef unsigned u32x2 __attribute__((ext_vector_type(2)));
typedef unsigned u32x4 __attribute__((ext_vector_type(4)));
typedef GAS unsigned gu32;
#define RLX_AGENT __ATOMIC_RELAXED, __HIP_MEMORY_SCOPE_AGENT
#define LDS_WAIT() asm volatile("s_waitcnt lgkmcnt(0)" ::: "memory")
#define VM_WAIT() asm volatile("s_waitcnt vmcnt(0)" ::: "memory")
#define SBAR() __builtin_amdgcn_sched_barrier(0)

#ifndef Y_FP8
#define Y_FP8 1
#endif
#ifndef MOE_FP8
#define MOE_FP8 1
#endif
constexpr int DM = 2048, NB = 4, SEQ = 4096, NTOK = NB * SEQ, NMEM = 256;
constexpr int NPROJ = 5120;
constexpr int C_QG = 0, C_KG = 512, C_VG = 1024, C_GG = 2048, C_QF = 3072, C_KF = 3584, C_VF = 4096, C_QM = 4608;
constexpr int NEXP = 32, TOPK = 4, DFF = 2048, NASSIGN = NTOK * TOPK, MAXTILES = NASSIGN / 256 + NEXP;
constexpr float EPS = 1e-5f;

typedef __bf16 bf16v2_t __attribute__((ext_vector_type(2)));
__device__ __forceinline__ unsigned cvt_pk_bf16(float lo, float hi) { const f32x2 v = {lo, hi}; return __builtin_bit_cast(unsigned, __builtin_convertvector(v, bf16v2_t)); }
__device__ __forceinline__ unsigned pk_fp8x4(float a, float b, float c, float d) { int w = 0; w = __builtin_amdgcn_cvt_pk_fp8_f32(a, b, w, false); w = __builtin_amdgcn_cvt_pk_fp8_f32(c, d, w, true); return (unsigned)w; }
__device__ __forceinline__ float bf2f(unsigned short b) { return __uint_as_float(((unsigned)b) << 16); }
__device__ __forceinline__ bf16x8 pack8(f32x4 a, f32x4 b) { u32x4 w = {cvt_pk_bf16(a[0], a[1]), cvt_pk_bf16(a[2], a[3]), cvt_pk_bf16(b[0], b[1]), cvt_pk_bf16(b[2], b[3])}; return __builtin_bit_cast(bf16x8, w); }
__device__ __forceinline__ unsigned cvt_pk_bf16_raw(float lo, float hi) { unsigned r; asm volatile("v_cvt_pk_bf16_f32 %0, %1, %2" : "=v"(r) : "v"(lo), "v"(hi)); return r; }
__device__ __forceinline__ bf16x8 pack8_raw(f32x4 a, f32x4 b) { u32x4 w = {cvt_pk_bf16_raw(a[0], a[1]), cvt_pk_bf16_raw(a[2], a[3]), cvt_pk_bf16_raw(b[0], b[1]), cvt_pk_bf16_raw(b[2], b[3])}; return __builtin_bit_cast(bf16x8, w); }
__device__ __forceinline__ float wave_sum(float v) {
#pragma unroll
    for (int o = 1; o < 64; o <<= 1) v += __shfl_xor(v, o);
    return v;
}
__device__ __forceinline__ float log_sigmoid(float z) { return fminf(z, 0.f) - log1pf(__expf(-fabsf(z))); }

namespace pg8 {
constexpr int META_OFF = 148480, META_BYTES = 4096;
constexpr int GSLOT_OFF = 131072 + 8192;
constexpr int BM = 256, BK = 64, HALF = 128, HTB = HALF * BK * 2, STAGE_BYTES = 8 * HTB, NXCD = 8, WGM = 8;
__host__ __device__ __forceinline__ int lds_byte(int r, int c) { const int st = (r >> 4) * 2 + (c >> 5), rr = r & 15, cc = c & 31, ob = rr * 64 + cc * 2; return st * 1024 + (ob ^ (((ob >> 9) & 1) << 5)); }
__host__ __device__ __forceinline__ void stage_rc(int b, int& R, int& C) { const int st = b / 1024, sb = b % 1024, swz = sb ^ (((sb >> 9) & 1) << 5); R = (st >> 1) * 16 + swz / 64; C = (st & 1) * 32 + (swz % 64) / 2; }
__host__ __device__ __forceinline__ int perm32(int rho) { const int n = rho >> 4, i = rho & 15; return 8 * (i >> 2) + 4 * n + (i & 3); }

struct Unit { const char* A; const char* B; const int* rowidx; const int* gidx; int pm, pn, e, rows, grows; };

struct StaticOrder {
    const char* A; const char* B; int K; int nM, nN, nwg, G, c;
    __device__ void init(const void* A_, const void* B_, int M, int N, int K_, int G_, int c_) { A = (const char*)A_; B = (const char*)B_; K = K_; nM = M / BM; nN = N / BM; nwg = nM * nN; G = G_; c = c_; }
    __device__ __forceinline__ bool next(int i, Unit& u) const {
        const long L = (long)i * G + c; if (L >= nwg) return false;
        int wgid = (int)L; { const int q = nwg / NXCD, r = nwg % NXCD, xcd = wgid % NXCD, off = wgid / NXCD; wgid = (xcd < r ? xcd * (q + 1) : r * (q + 1) + (xcd - r) * q) + off; }
        const int nig = WGM * nN, gid = wgid / nig, fm = gid * WGM, gsz = (nM - fm) < WGM ? (nM - fm) : WGM;
        u.pm = fm + ((wgid % nig) % gsz); u.pn = (wgid % nig) / gsz; u.e = 0; u.rows = BM; u.rowidx = nullptr; u.gidx = nullptr; u.grows = BM;
        u.A = A + (size_t)u.pm * BM * K * 2; u.B = B + (size_t)u.pn * BM * K * 2; return true;
    }
};

typedef int v4i_t __attribute__((ext_vector_type(4)));
typedef int v8i_t __attribute__((ext_vector_type(8)));
template <class Epi, class Sched, bool GATHER, bool FP8 = false, int SCA = 127, int SCB = 127>
__device__ __forceinline__ void gemm_phase(LAS unsigned char* lds, const int K, const Sched& S, const Epi& E) {
    const int tid = threadIdx.x, wid = __builtin_amdgcn_readfirstlane(tid >> 6), lane = tid & 63, wr = wid >> 2, wc = wid & 3, fr = lane & 15, fq = lane >> 4;
    const int nt = K / BK;
    unsigned voffA[2], voffB[2]; int RA[2], CA[2];
#pragma unroll
    for (int i = 0; i < 2; ++i) { int R, C; stage_rc(tid * 16 + i * 8192, R, C); const int Rb = Epi::PERM ? ((R & ~31) + perm32(R & 31)) : R;
        RA[i] = R; CA[i] = C; voffA[i] = (unsigned)(R * K + C) * 2u; voffB[i] = (unsigned)(Rb * K + C) * 2u; }
    const size_t kstep = (size_t)(BK * 2);
    const size_t hstep = (size_t)HALF * K * 2;
    const unsigned ldsw = (unsigned)wid * 1024u;
    const int aoff = lds_byte(wr * 64 + fr, fq * 8), boff = lds_byte(wc * 32 + fr, fq * 8);
    unsigned gcur[2][2];
#define PG8_SA(b, h) (((b) * 2 + (h)) * HTB)
#define PG8_SB(b, h) ((4 + (b) * 2 + (h)) * HTB)
#define PG8_STAGE(bufoff, gbase, voff) do { _Pragma("unroll") for (int _i = 0; _i < 2; ++_i) \
        __builtin_amdgcn_global_load_lds((const unsigned*)((const char*)(gbase) + (voff)[_i]), (LAS unsigned*)(lds + (bufoff) + ldsw + _i * 8192), 16, 0, 0); } while (0)
#define PG8_STAGE_A(bufoff, base, kb, h, NX) do { if constexpr (GATHER) { PG8_STAGE(bufoff, (base) + (kb), gcur[h]); } \
        else PG8_STAGE(bufoff, (base) + (kb) + (h) * hstep, voffA); } while (0)
#define PG8_LDA(dst, b, h) do { _Pragma("unroll") for (int m = 0; m < 4; ++m) { dst[m].lo = *(const LAS v4i_t*)(lds + PG8_SA(b, h) + aoff + m * 2048); dst[m].hi = *(const LAS v4i_t*)(lds + PG8_SA(b, h) + aoff + m * 2048 + 1024); } } while (0)
#define PG8_LDB(dst, b, h) do { _Pragma("unroll") for (int n = 0; n < 2; ++n) { dst[n].lo = *(const LAS v4i_t*)(lds + PG8_SB(b, h) + boff + n * 2048); dst[n].hi = *(const LAS v4i_t*)(lds + PG8_SB(b, h) + boff + n * 2048 + 1024); } } while (0)
#define PG8_BF(x) __builtin_bit_cast(bf16x8, (v4i_t)(x))
#define PG8_MMA(ai, bj, At, Bt) do { __builtin_amdgcn_s_setprio(1); _Pragma("unroll") for (int m = 0; m < 4; ++m) _Pragma("unroll") for (int n = 0; n < 2; ++n) { \
        if constexpr (FP8) acc[ai][bj][m][n] = __builtin_amdgcn_mfma_scale_f32_16x16x128_f8f6f4(Bt[n], At[m], acc[ai][bj][m][n], 0, 0, 0, SCB * 0x01010101, 0, SCA * 0x01010101); \
        else { acc[ai][bj][m][n] = __builtin_amdgcn_mfma_f32_16x16x32_bf16(PG8_BF(Bt[n].lo), PG8_BF(At[m].lo), acc[ai][bj][m][n], 0, 0, 0); \
               acc[ai][bj][m][n] = __builtin_amdgcn_mfma_f32_16x16x32_bf16(PG8_BF(Bt[n].hi), PG8_BF(At[m].hi), acc[ai][bj][m][n], 0, 0, 0); } } \
        __builtin_amdgcn_s_setprio(0); } while (0)
#define PG8_WAIT_V(n) asm volatile("s_waitcnt vmcnt(" #n ")" ::: "memory")
#define PG8_WAIT_L(n) asm volatile("s_waitcnt lgkmcnt(" #n ")" ::: "memory")
#define PG8_BAR __builtin_amdgcn_s_barrier()
#define PG8_SCHED __builtin_amdgcn_sched_barrier(0)
#define PG8_GIDX(dst, u) do { _Pragma("unroll") for (int _h = 0; _h < 2; ++_h) _Pragma("unroll") for (int _i = 0; _i < 2; ++_i) { \
        const int _r = _h * HALF + RA[_i]; const int _t = (u).gidx[_r < (u).grows ? _r : 0] >> 2; dst[_h][_i] = (unsigned)(_t * K + CA[_i]) * 2u; } } while (0)
#define PG8_GPOST(u) do { _Pragma("unroll") for (int _h = 0; _h < 2; ++_h) _Pragma("unroll") for (int _i = 0; _i < 2; ++_i) { const int _r = _h * HALF + RA[_i]; \
        __builtin_amdgcn_global_load_lds((const unsigned*)((u).gidx + (_r < (u).grows ? _r : 0)), (LAS unsigned*)(lds + GSLOT_OFF + (_h * 2 + _i) * 2048 + wid * 256), 4, 0, 0); } } while (0)
#define PG8_GTAKE() do { _Pragma("unroll") for (int _h = 0; _h < 2; ++_h) _Pragma("unroll") for (int _i = 0; _i < 2; ++_i) { \
        const int _t = *(const LAS int*)(lds + GSLOT_OFF + (_h * 2 + _i) * 2048 + wid * 256 + lane * 4) >> 2; gcur[_h][_i] = (unsigned)(_t * K + CA[_i]) * 2u; } } while (0)
    Unit cur, nxt; int ui = 0;
    if (!S.next(0, cur)) return;
    f32x4 acc[2][2][4][2];
#pragma unroll
    for (int a = 0; a < 2; ++a)
#pragma unroll
        for (int b = 0; b < 2; ++b)
#pragma unroll
            for (int m = 0; m < 4; ++m)
#pragma unroll
                for (int n = 0; n < 2; ++n) acc[a][b][m][n] = (f32x4){0.f, 0.f, 0.f, 0.f};
    v8i_t At[4], B0[2], B1[2];
    const char* cA = cur.A; const char* cB = cur.B;
    if constexpr (GATHER) { PG8_GIDX(gcur, cur); }
    PG8_STAGE(PG8_SB(0, 0), cB, voffB); PG8_STAGE(PG8_SB(0, 1), cB + hstep, voffB); PG8_STAGE_A(PG8_SA(0, 0), cA, 0, 0, false); PG8_STAGE_A(PG8_SA(0, 1), cA, 0, 1, false);
    if (wr == 1) PG8_BAR;
    PG8_WAIT_V(2); PG8_BAR;
    PG8_STAGE(PG8_SB(1, 0), cB + kstep, voffB); PG8_STAGE_A(PG8_SA(1, 0), cA, kstep, 0, false); PG8_STAGE(PG8_SB(1, 1), cB + hstep + kstep, voffB);
    PG8_WAIT_V(6); PG8_BAR;
    for (;;) {
        const bool has_next = S.next(ui + 1, nxt);
        const char* nA = has_next ? nxt.A : cA; const char* nB = has_next ? nxt.B : cB;
        if constexpr (GATHER) { if (has_next) { PG8_GPOST(nxt); } else { PG8_GPOST(cur); } }
        if constexpr (Epi::META) E.post(cur, lds + META_OFF + (ui & 1) * META_BYTES, wid, lane);
        for (int t = 0; t < nt; t += 2) {
            const bool last = (t == nt - 2);
            const size_t k1 = (size_t)(t + 1) * kstep;
            const char* a2 = last ? nA : cA; const char* b2 = last ? nB : cB + (size_t)(t + 2) * kstep;
            const size_t ka2 = last ? 0 : (size_t)(t + 2) * kstep, ka3 = ka2 + kstep; const char* b3 = b2 + kstep;
            PG8_LDB(B0, 0, 0); PG8_LDB(B1, 0, 1); PG8_SCHED; PG8_LDA(At, 0, 0); PG8_STAGE_A(PG8_SA(1, 1), cA, k1, 1, false);
            if constexpr (GATHER) { if (last) { PG8_GTAKE(); } }
            PG8_WAIT_V(8); PG8_WAIT_L(0); PG8_BAR; PG8_MMA(0, 0, At, B0); PG8_MMA(0, 1, At, B1); PG8_BAR; PG8_SCHED;
            PG8_LDA(At, 0, 1); PG8_STAGE(PG8_SB(0, 0), b2, voffB); PG8_STAGE(PG8_SB(0, 1), b2 + hstep, voffB); PG8_STAGE_A(PG8_SA(0, 0), a2, ka2, 0, last);
            PG8_WAIT_V(8); PG8_WAIT_L(0); PG8_BAR; PG8_MMA(1, 0, At, B0); PG8_MMA(1, 1, At, B1); PG8_BAR; PG8_SCHED;
            PG8_LDB(B0, 1, 0); PG8_LDB(B1, 1, 1); PG8_SCHED; PG8_LDA(At, 1, 0); PG8_STAGE_A(PG8_SA(0, 1), a2, ka2, 1, last);
            PG8_WAIT_V(8); PG8_WAIT_L(0); PG8_BAR; PG8_MMA(0, 0, At, B0); PG8_MMA(0, 1, At, B1); PG8_BAR; PG8_SCHED;
            PG8_LDA(At, 1, 1); PG8_STAGE(PG8_SB(1, 0), b3, voffB); PG8_STAGE(PG8_SB(1, 1), b3 + hstep, voffB); PG8_STAGE_A(PG8_SA(1, 0), a2, ka3, 0, last);
            PG8_WAIT_V(8); PG8_WAIT_L(0); PG8_BAR; PG8_MMA(1, 0, At, B0); PG8_MMA(1, 1, At, B1); PG8_BAR; PG8_SCHED;
        }
        if (wr == 0) PG8_BAR;
        if constexpr (Epi::META) E(acc, cur, wr, wc, fr, fq, lds + META_OFF + (ui & 1) * META_BYTES); else E(acc, cur, wr, wc, fr, fq);
        if (!has_next) break;
#pragma unroll
        for (int a = 0; a < 2; ++a)
#pragma unroll
            for (int b = 0; b < 2; ++b)
#pragma unroll
                for (int m = 0; m < 4; ++m)
#pragma unroll
                    for (int n = 0; n < 2; ++n) acc[a][b][m][n] = (f32x4){0.f, 0.f, 0.f, 0.f};
        cur = nxt; cA = nA; cB = nB; ++ui;
        if (wr == 1) PG8_BAR;
    }
    PG8_WAIT_V(0);
    PG8_BAR;
#undef PG8_SA
#undef PG8_SB
#undef PG8_STAGE
#undef PG8_STAGE_A
#undef PG8_LDA
#undef PG8_LDB
#undef PG8_MMA
#undef PG8_BF
#undef PG8_WAIT_V
#undef PG8_WAIT_L
#undef PG8_BAR
#undef PG8_SCHED
#undef PG8_GIDX
#undef PG8_GPOST
#undef PG8_GTAKE
}
}

namespace fox {
constexpr int D = 128, NW = 8, QBLK = 32, KVBLK = 64, QB = NW * QBLK;
constexpr int SHM_V = KVBLK * D * 2, SHM_K = KVBLK * D * 2;
constexpr int LDS_WS = 2 * SHM_V + 2 * SHM_K, LDS_FB = LDS_WS + NW * 64 * 4, LDS_BYTES = LDS_FB + 4096 * 4 + 64;
constexpr float SCALE = 0.08838834764831845f;
constexpr float THR = 8.f;
constexpr int LDQ = NPROJ;
#define KSWZ(row, colB) ((row) * 256 + ((colB) ^ (((row) & 7) << 4)))
__device__ __forceinline__ int v_st(int k, int c) { const int kk = (k & ~0xC) | ((k & 4) << 1) | ((k & 8) >> 1); return ((kk >> 3) * 4 + (c >> 5)) * 512 + ((kk & 7) * 32 + (c & 31)) * 2; }
__device__ __forceinline__ int v_rd_base(int lane) { return ((lane & 3) << 3) | (((lane >> 2) & 3) << 6) | (((lane >> 4) & 1) << 5) | (((lane >> 5) & 1) << 8); }
constexpr int v_rd_off(int d0, int ks, int half) { return d0 * 512 + ks * 4096 + half * 2048; }
__device__ __forceinline__ int crow(int r, int hi) { return (r & 3) + 8 * (r >> 2) + 4 * hi; }
__device__ __forceinline__ unsigned cvtpk(float lo, float hi) { return cvt_pk_bf16(lo, hi); }
__device__ __forceinline__ bf16x8 load8(const bf16_t* p) { return *reinterpret_cast<const bf16x8*>(p); }
__device__ __forceinline__ void mask_tile(f32x16& p0, f32x16& p1, int dq) {
    const float NEG = -__builtin_inff();
#pragma unroll
    for (int r = 0; r < 16; ++r) {
        const int c = (r & 3) + 8 * (r >> 2);
        if (dq - c < 0) p0[r] = NEG;
        if (dq - c - 32 < 0) p1[r] = NEG;
    }
}
__device__ __forceinline__ void partialSM(f32x16& p0, f32x16& p1, float& m_reg, float& mn, float& alpha) {
    float pmax = p0[0]; for (int r = 1; r < 16; ++r) pmax = fmaxf(pmax, p0[r]); for (int r = 0; r < 16; ++r) pmax = fmaxf(pmax, p1[r]);
    { auto rr = __builtin_amdgcn_permlane32_swap(__float_as_uint(pmax), __float_as_uint(pmax), false, false);
      pmax = fmaxf(__uint_as_float(rr[0]), __uint_as_float(rr[1])); }
    constexpr float C2 = 1.4426950408889634f * SCALE;
    if (__builtin_expect(__all((pmax - m_reg) * SCALE <= THR), 1)) { mn = m_reg; alpha = 1.f; }
    else { mn = fmaxf(m_reg, pmax); alpha = __builtin_amdgcn_exp2f((m_reg - mn) * C2); m_reg = mn; }
    const float mnL = -mn * C2;
    for (int r = 0; r < 16; ++r) p0[r] = fmaf(p0[r], C2, mnL); for (int r = 0; r < 16; ++r) p1[r] = fmaf(p1[r], C2, mnL);
    for (int r = 0; r < 16; ++r) p0[r] = __builtin_amdgcn_exp2f(p0[r]);
}
__device__ __forceinline__ void finishSM(f32x16& p0, f32x16& p1, float alpha, float& l_reg, bf16x8& pa0, bf16x8& pa1, bf16x8& pa2, bf16x8& pa3) {
    for (int r = 0; r < 16; ++r) p1[r] = __builtin_amdgcn_exp2f(p1[r]);
    float ps = 0; for (int r = 0; r < 16; ++r) ps += p0[r]; for (int r = 0; r < 16; ++r) ps += p1[r];
    { auto rr = __builtin_amdgcn_permlane32_swap(__float_as_uint(ps), __float_as_uint(ps), false, false);
      ps = __uint_as_float(rr[0]) + __uint_as_float(rr[1]); }
    l_reg = l_reg * alpha + ps;
#define PK4(P, B_, OUT) do { unsigned a0 = cvtpk(P[B_+0], P[B_+1]), a1 = cvtpk(P[B_+2], P[B_+3]);                          \
        unsigned b0 = cvtpk(P[B_+4], P[B_+5]), b1 = cvtpk(P[B_+6], P[B_+7]);                                             \
        auto r0 = __builtin_amdgcn_permlane32_swap(a0, b0, false, false); auto r1 = __builtin_amdgcn_permlane32_swap(a1, b1, false, false); \
        u32x4 w = {r0[0], r1[0], r0[1], r1[1]}; OUT = *reinterpret_cast<bf16x8*>(&w); } while (0)
    PK4(p0, 0, pa0); PK4(p0, 8, pa1); PK4(p1, 0, pa2); PK4(p1, 8, pa3);
#undef PK4
}
template <int KB>
__device__ __forceinline__ void qkt(f32x16& p0, f32x16& p1, const char* K_lds, const float* fb, int r32, int hi, const bf16x8* qr) {
#pragma unroll
    for (int g = 0; g < 4; ++g) { const f32x4 a = *(const f32x4*)(fb + 8 * g), b = *(const f32x4*)(fb + 32 + 8 * g);
        p0[4 * g] = a[0]; p0[4 * g + 1] = a[1]; p0[4 * g + 2] = a[2]; p0[4 * g + 3] = a[3];
        p1[4 * g] = b[0]; p1[4 * g + 1] = b[1]; p1[4 * g + 2] = b[2]; p1[4 * g + 3] = b[3]; }
    const char* kb[4];
#pragma unroll
    for (int dd = 0; dd < 4; ++dd) kb[dd] = K_lds + KB * SHM_K + KSWZ(r32, (dd * 16 + hi * 8) * 2);
#pragma unroll
    for (int d0 = 0; d0 < 8; ++d0) { const char* a = kb[d0 & 3] + (d0 >> 2) * 128;
        bf16x8 b0 = *reinterpret_cast<const bf16x8*>(a);
        bf16x8 b1 = *reinterpret_cast<const bf16x8*>(a + 32 * 256);
        p0 = __builtin_amdgcn_mfma_f32_32x32x16_bf16(b0, qr[d0], p0, 0, 0, 0);
        p1 = __builtin_amdgcn_mfma_f32_32x32x16_bf16(b1, qr[d0], p1, 0, 0, 0); }
}
template <int VB>
__device__ __forceinline__ void pv_tile(f32x16* o, int vb0, bf16x8 pa0, bf16x8 pa1, bf16x8 pa2, bf16x8 pa3) {
#define TRRD(dst, off) asm volatile("ds_read_b64_tr_b16 %0, %1 offset:%2" : "=&v"(dst) : "v"(vb0), "i"(off) : "memory")
#define PV_D0(d0) do { s16x4 l0, l1, l2, l3, h0, h1, h2, h3; constexpr int b_ = VB * SHM_V + v_rd_off(d0, 0, 0); \
        TRRD(l0, b_); TRRD(h0, b_ + 2048); TRRD(l1, b_ + 4096); TRRD(h1, b_ + 6144); TRRD(l2, b_ + 8192); TRRD(h2, b_ + 10240); TRRD(l3, b_ + 12288); TRRD(h3, b_ + 14336); \
        asm volatile("s_waitcnt lgkmcnt(0)" ::: "memory"); SBAR();   \
        o[d0] = __builtin_amdgcn_mfma_f32_32x32x16_bf16(pa0, (bf16x8){l0[0], l0[1], l0[2], l0[3], h0[0], h0[1], h0[2], h0[3]}, o[d0], 0, 0, 0);   \
        o[d0] = __builtin_amdgcn_mfma_f32_32x32x16_bf16(pa1, (bf16x8){l1[0], l1[1], l1[2], l1[3], h1[0], h1[1], h1[2], h1[3]}, o[d0], 0, 0, 0);   \
        o[d0] = __builtin_amdgcn_mfma_f32_32x32x16_bf16(pa2, (bf16x8){l2[0], l2[1], l2[2], l2[3], h2[0], h2[1], h2[2], h2[3]}, o[d0], 0, 0, 0);   \
        o[d0] = __builtin_amdgcn_mfma_f32_32x32x16_bf16(pa3, (bf16x8){l3[0], l3[1], l3[2], l3[3], h3[0], h3[1], h3[2], h3[3]}, o[d0], 0, 0, 0); } while (0)
    PV_D0(0); PV_D0(1); PV_D0(2); PV_D0(3);
#undef PV_D0
#undef TRRD
}
struct BlockRef { const bf16_t* Q; const bf16_t* K; const bf16_t* V; int P0, j_lo, j_hi; };
struct Seam { bf16x8 qr[8]; bf16x8 st_v0, st_v1, st_k0, st_k1; };
#define ROW(p, k0, rr) ((p) + (size_t)((k0) + (rr)) * LDQ + sc)
#define VMWN(n) asm volatile("s_waitcnt vmcnt(%0)" :: "i"(n) : "memory")
#define SLOAD_H(Kp, Vp, k0) do { S.st_v0 = load8(ROW(Vp, k0, sr)); S.st_v1 = load8(ROW(Vp, k0, 32 + sr)); S.st_k0 = load8(ROW(Kp, k0, sr)); S.st_k1 = load8(ROW(Kp, k0, 32 + sr)); } while (0)
#define SWRITE_HK(bf) do { *(bf16x8*)(K_lds + (bf) * SHM_K + kws) = S.st_k0; *(bf16x8*)(K_lds + (bf) * SHM_K + kws + 32 * 256) = S.st_k1; } while (0)
#define SWRITE_HV(bf) do { *(bf16x8*)(V_lds + (bf) * SHM_V + vst0) = S.st_v0; *(bf16x8*)(V_lds + (bf) * SHM_V + vst1) = S.st_v1; } while (0)
#define SWRITE_H(bf) do { SWRITE_HV(bf); SWRITE_HK(bf); } while (0)
__device__ __forceinline__ void prime(const BlockRef& cur, char* lds, Seam& S) {
    const int tid = threadIdx.x, wid = __builtin_amdgcn_readfirstlane(tid >> 6), lane = tid & 63, r32 = lane & 31, hi = lane >> 5;
    const int sr = tid >> 4, sc = (tid & 15) * 8, kws = KSWZ(sr, sc * 2); char* K_lds = lds + 2 * SHM_V;
    const int kb0 = cur.j_lo * KVBLK;
    for (int d0 = 0; d0 < 8; ++d0) S.qr[d0] = load8(cur.Q + (size_t)(wid * QBLK + r32) * LDQ + d0 * 16 + hi * 8);
    SLOAD_H(cur.K, cur.V, kb0); VM_WAIT(); SWRITE_HK(0);
    __syncthreads();
}
template <class Epi>
__device__ __forceinline__ void block(const BlockRef& cur, const BlockRef& nxt, char* lds, Seam& S, const Epi& E) {
    const int tid = threadIdx.x, wid = __builtin_amdgcn_readfirstlane(tid >> 6), lane = tid & 63, r32 = lane & 31, hi = lane >> 5;
    const int j_lo = cur.j_lo, j_hi = cur.j_hi;
    const int NT = j_hi - j_lo;
    const int kbn = nxt.j_lo * KVBLK;
    const int qlo = cur.P0 + wid * QBLK, qm = qlo + r32 - 4 * hi;
    char* V_lds = lds; char* K_lds = lds + 2 * SHM_V;
    float* ws = (float*)(lds + LDS_WS) + wid * 64; float* li_l = ws, * al_l = ws + 32;
    const float* FB = (const float*)(lds + LDS_FB) + 4 * hi;
    float m_reg = -1e30f, l_reg = 0; f32x16 o[4] = {};
    const int sr = tid >> 4, sc = (tid & 15) * 8, vst0 = v_st(sr, sc), vst1 = v_st(32 + sr, sc), kws = KSWZ(sr, sc * 2);
    const int vb0 = (int)(uintptr_t)V_lds + v_rd_base(lane);
    const bf16_t* Kh = cur.K; const bf16_t* Vh = cur.V;
#define RESC(a) do { if (__any((a) < 1.f)) { if (hi == 0) al_l[r32] = (a); asm volatile("s_waitcnt lgkmcnt(0)" ::: "memory");              \
                     for (int d_ = 0; d_ < 4; ++d_) for (int r = 0; r < 16; ++r) o[d_][r] *= al_l[crow(r, hi)]; } } while (0)
#define KBASE(t) ((j_lo + (t)) * KVBLK)
#define MASKT(P0_, P1_, t) do { const int kb_ = KBASE(t); if (kb_ + KVBLK - 1 > qlo) mask_tile(P0_, P1_, qm - kb_); } while (0)
    constexpr int NQL = 8;
#define SEAM_K0() do { VMWN(NQL); SWRITE_HK(0); SBAR(); } while (0)
    f32x16 pA0, pA1, pB0, pB1; float mnA, mnB, alA, alB; bf16x8 pa0, pa1, pa2, pa3;
    SWRITE_HV(0); SBAR();
    if (NT > 1) { SLOAD_H(Kh, Vh, KBASE(1)); }
    SBAR(); qkt<0>(pA0, pA1, K_lds, FB + KBASE(0), r32, hi, S.qr);
    MASKT(pA0, pA1, 0); partialSM(pA0, pA1, m_reg, mnA, alA);
    if (NT > 1) { VM_WAIT(); SWRITE_H(1); }
    __syncthreads();
#define HALF_STEP(PX0, PX1, mnX, alX, PY0, PY1, alY, t, KB, VB, SB) do {                                                      \
        SBAR(); qkt<KB>(PX0, PX1, K_lds, FB + KBASE(t), r32, hi, S.qr);                                                      \
        finishSM(PY0, PY1, alY, l_reg, pa0, pa1, pa2, pa3); SBAR();                                                           \
        if ((t) + 1 < NT) { SLOAD_H(Kh, Vh, KBASE((t) + 1)); SBAR(); }                                                       \
        pv_tile<VB>(o, vb0, pa0, pa1, pa2, pa3); MASKT(PX0, PX1, (t)); partialSM(PX0, PX1, m_reg, mnX, alX);                  \
        __syncthreads();                                                                                                      \
        if ((t) + 1 < NT) { VM_WAIT(); SWRITE_H(SB); }                                                                        \
        RESC(alX); __syncthreads(); } while (0)
    for (int t = 1; t + 1 < NT; t += 2) {
        HALF_STEP(pB0, pB1, mnB, alB, pA0, pA1, alA, t, 1, 0, 0);
        HALF_STEP(pA0, pA1, mnA, alA, pB0, pB1, alB, t + 1, 0, 1, 1);
    }
    const bool even = (NT & 1) == 0;
    if (even) { SBAR(); qkt<1>(pB0, pB1, K_lds, FB + KBASE(NT - 1), r32, hi, S.qr); SBAR(); }
    SLOAD_H(nxt.K, nxt.V, kbn); SBAR();
#pragma unroll
    for (int d0 = 0; d0 < 8; ++d0) S.qr[d0] = load8(nxt.Q + (size_t)(wid * QBLK + r32) * LDQ + d0 * 16 + hi * 8);
    SBAR();
    finishSM(pA0, pA1, alA, l_reg, pa0, pa1, pa2, pa3); SBAR();
    pv_tile<0>(o, vb0, pa0, pa1, pa2, pa3);
    if (even) { MASKT(pB0, pB1, NT - 1); partialSM(pB0, pB1, m_reg, mnB, alB); __syncthreads(); RESC(alB);
        finishSM(pB0, pB1, alB, l_reg, pa0, pa1, pa2, pa3); SBAR(); pv_tile<1>(o, vb0, pa0, pa1, pa2, pa3); }
    SBAR(); SEAM_K0();
    if (hi == 0) li_l[r32] = l_reg; asm volatile("s_waitcnt lgkmcnt(0)" ::: "memory");
    E(o, li_l, m_reg, cur.P0 + wid * QBLK, r32, hi);
    __syncthreads();
#undef RESC
#undef KBASE
#undef MASKT
#undef SEAM_K0
#undef HALF_STEP
}
#undef ROW
#undef VMWN
#undef SLOAD_H
#undef SWRITE_HK
#undef SWRITE_HV
#undef SWRITE_H
struct EpiNormBf16 {
    bf16_t* out; int ldo; const float* gain;
    __device__ __forceinline__ void operator()(const f32x16* o, const float* li_l, float  , int row0, int r32, int hi) const {
        const float g0 = gain[r32], g1 = gain[32 + r32], g2 = gain[64 + r32], g3 = gain[96 + r32];
#pragma unroll
        for (int r = 0; r < 16; ++r) { const int orow = crow(r, hi); const float rl = __builtin_amdgcn_rcpf(li_l[orow]);
            const float v0 = o[0][r] * rl, v1 = o[1][r] * rl, v2 = o[2][r] * rl, v3 = o[3][r] * rl;
            float ss = (v0 * v0 + v1 * v1) + (v2 * v2 + v3 * v3);
            ss += __shfl_xor(ss, 1); ss += __shfl_xor(ss, 2); ss += __shfl_xor(ss, 4); ss += __shfl_xor(ss, 8); ss += __shfl_xor(ss, 16);
            const float rs = 1.0f / sqrtf(ss * (1.0f / 128.0f) + EPS);
            u32x2 w; w.x = cvtpk(v0 * rs * g0, v1 * rs * g1); w.y = cvtpk(v2 * rs * g2, v3 * rs * g3);
            *(u32x2*)(out + (size_t)(row0 + orow) * ldo + r32 * 4) = w; }
    }
};
struct EpiPartial {
    float* O; float* ML;
    __device__ __forceinline__ void operator()(const f32x16* o, const float* li_l, float m, int row0, int r32, int hi) const {
#pragma unroll
        for (int r = 0; r < 16; ++r) { const int orow = crow(r, hi); u32x2 w; w.x = cvtpk(o[0][r], o[1][r]); w.y = cvtpk(o[2][r], o[3][r]); *(u32x2*)((bf16_t*)O + (size_t)(row0 + orow) * 512 + r32 * 4) = w; }
        if (hi == 0) *(f32x2*)(ML + (size_t)(row0 + r32) * 8) = (f32x2){m, li_l[r32]};
    }
};
}

constexpr size_t MiB = 1u << 20;
constexpr size_t WS_CTL = 0, CTL_ZERO_BYTES = 65536;
constexpr size_t WS_WSM = 1 * MiB;
constexpr size_t WS_RSTD = 2 * MiB;
constexpr size_t WS_SMALL = 3 * MiB;
constexpr size_t WS_GATE = 5 * MiB;
constexpr size_t WS_ROWLIST = 6 * MiB;
constexpr size_t WS_WMKV = 8 * MiB, WS_WOUT = 12 * MiB, WS_WIN = 20 * MiB;
constexpr size_t WS_MEMB = 40 * MiB;
constexpr size_t WS_KVM = 44 * MiB;
constexpr size_t WS_GLAD = 46 * MiB;
constexpr size_t WS_XB = 48 * MiB;
constexpr size_t WS_PROJ = 112 * MiB;
constexpr size_t WS_MIX = 272 * MiB;
constexpr size_t WS_X1 = 336 * MiB;
constexpr size_t WS_X1B = 464 * MiB;
constexpr size_t WS_GLAKV = 528 * MiB;
constexpr size_t WS_GLAO = 656 * MiB;
constexpr size_t WS_WUP = 720 * MiB;
constexpr size_t WS_WDOWN = 1232 * MiB;
constexpr size_t WS_ACT = 1488 * MiB;
constexpr size_t WS_Y = 1776 * MiB;
constexpr size_t WS_IDENT = 5 * MiB + 512 * 1024;
constexpr size_t WS_LA = 2032 * MiB;
constexpr size_t WS_FOXO = 2064 * MiB;
constexpr size_t WS_FOXML = 2192 * MiB;
constexpr size_t WS_ROWGATE = 2194 * MiB, WS_ROWRSTD = 2196 * MiB;
constexpr size_t WS_END = 2198 * MiB;
constexpr int CW_BAR = 4096;
constexpr int CW_CNT = 8192;

constexpr int RING_BYTES = 131072;
constexpr int TAB_OFF = RING_BYTES;
constexpr int MISC_OFF = 147456;
constexpr int LDS_BYTES = 147456 + 1024 + 8192;

#define XB_TMO      128
#define XB_XCNT(j)  (256  + 64 * (j))
#define XB_XSUB(j)  (1280 + 64 * (j))
#define XB_XGEN(j)  (2304 + 64 * (j))
#define XB_TOP      3328
#define XB_TOPGEN   3392
#define XCD_BAR_WORDS 3456
#define XB_SPIN_CAP (1u << 18)
__device__ __forceinline__ unsigned xb_ld(unsigned* p)              { return __hip_atomic_load(p, __ATOMIC_RELAXED, __HIP_MEMORY_SCOPE_AGENT); }
__device__ __forceinline__ unsigned xb_add(unsigned* p, unsigned v) { return __hip_atomic_fetch_add(p, v, __ATOMIC_RELAXED, __HIP_MEMORY_SCOPE_AGENT); }
__device__ __forceinline__ unsigned xb_xcc_id() { return (unsigned)__builtin_amdgcn_s_getreg((3 << 11) | 20) & 0xFu; }
#define XB_SPIN(cond, bar) do { unsigned _sp = 0; while (cond) { __builtin_amdgcn_s_sleep(1); \
    if ((++_sp & 255u) == 0u) { if (xb_ld(&(bar)[XB_TMO])) break; if (_sp > XB_SPIN_CAP) { atomicAdd(&(bar)[XB_TMO], 1u); break; } } } } while (0)
struct XcdBarrier { unsigned* bar; unsigned x; volatile LAS unsigned* st; };
__device__ __forceinline__ XcdBarrier xcd_barrier_post(unsigned* bar, volatile LAS unsigned* st) {
    XcdBarrier b; b.bar = bar; b.x = xb_xcc_id(); b.st = st;
    if (threadIdx.x == 0) (void)xb_add(&bar[XB_XCNT(b.x)], 1u);
    return b;
}
__device__ __forceinline__ void xcd_barrier_complete(unsigned* bar, unsigned x, unsigned& nloc, unsigned& nx) {
    const unsigned G = gridDim.x * gridDim.y * gridDim.z;
    unsigned sum, cnt, mine, sp = 0u;
    for (;;) {
        sum = 0u; cnt = 0u; mine = 0u;
#pragma unroll
        for (unsigned j = 0; j < 16; ++j) { const unsigned c = xb_ld(&bar[XB_XCNT(j)]); sum += c; cnt += (c > 0u) ? 1u : 0u; mine = (j == x) ? c : mine; }
        if (sum == G) break;
        __builtin_amdgcn_s_sleep(1);
        if ((++sp & 255u) == 0u) { if (xb_ld(&bar[XB_TMO])) break; if (sp > XB_SPIN_CAP) { atomicAdd(&bar[XB_TMO], 1u); break; } }
    }
    nloc = mine > 0u ? mine : 1u; nx = cnt > 0u ? cnt : 1u;
}
__device__ __forceinline__ void xcd_barrier(const XcdBarrier& b) {
    asm volatile("s_waitcnt vmcnt(0)" ::: "memory");
    __syncthreads();
    if (threadIdx.x == 0) {
        unsigned* bar = b.bar;
        __builtin_amdgcn_s_waitcnt(0);
        unsigned nloc = b.st[0], nx = b.st[1];
        if (nloc == 0u) { xcd_barrier_complete(bar, b.x, nloc, nx); b.st[0] = nloc; b.st[1] = nx; }
        const unsigned old = xb_add(&bar[XB_XSUB(b.x)], 1u);
        const unsigned gen = old / nloc;
        if (old + 1u == (gen + 1u) * nloc) {
            __builtin_amdgcn_fence(__ATOMIC_RELEASE, "agent");
            asm volatile("s_waitcnt vmcnt(0)" ::: "memory");
            const unsigned og = xb_add(&bar[XB_TOP], 1u);
            const unsigned tg = og / nx;
            if (og + 1u == (tg + 1u) * nx) xb_add(&bar[XB_TOPGEN], 1u);
            else XB_SPIN(xb_ld(&bar[XB_TOPGEN]) == tg, bar);
            __builtin_amdgcn_fence(__ATOMIC_ACQUIRE, "agent");
            xb_add(&bar[XB_XGEN(b.x)], 1u);
            asm volatile("s_waitcnt vmcnt(0)" ::: "memory");
        } else {
            XB_SPIN(xb_ld(&bar[XB_XGEN(b.x)]) == gen, bar);
            __builtin_amdgcn_fence(__ATOMIC_ACQUIRE, "agent");
            asm volatile("s_waitcnt vmcnt(0)" ::: "memory");
        }
    }
    __syncthreads();
}

__device__ __forceinline__ unsigned f2bf(float f) { unsigned u = __builtin_bit_cast(unsigned, f); return (u + 0x7fffu + ((u >> 16) & 1u)) >> 16; }
__device__ __forceinline__ unsigned pk2(float lo, float hi) { return f2bf(lo) | (f2bf(hi) << 16); }
__device__ __forceinline__ int head_perm(int x) { return (x & 3) * 32 + (x >> 2); }
template <bool KPERM>
__device__ __forceinline__ void transpose_item(const float* W, size_t ldw, int k0, int scol0, bf16_t* WT, int K, const float* g, float cs, LAS float* scr, int lane) {
#pragma unroll 16
    for (int i = 0; i < 32; ++i) { const int kk = 2 * i + (lane >> 5); int sk = k0 + kk; if (KPERM) sk = (sk & ~127) + head_perm(sk & 127);
        float v = W[(size_t)sk * ldw + scol0 + (lane & 31)]; if (g) v *= g[sk]; scr[kk * 33 + (lane & 31)] = v * cs; }
    LDS_WAIT(); asm volatile("" ::: "memory");
    const int c = lane & 7;
#pragma unroll
    for (int j = 0; j < 4; ++j) { const int n = (lane >> 3) + 8 * j; const LAS float* s = scr + (8 * c) * 33 + n;
        u32x4 o; o.x = pk2(s[0 * 33], s[1 * 33]); o.y = pk2(s[2 * 33], s[3 * 33]); o.z = pk2(s[4 * 33], s[5 * 33]); o.w = pk2(s[6 * 33], s[7 * 33]);
        *(GAS u32x4*)(WT + (size_t)n * K + k0 + 8 * c) = o; }
    LDS_WAIT(); asm volatile("" ::: "memory");
}
template <bool KPERM>
__device__ __forceinline__ void tr_item(const float* W, size_t ldw, int k0, int scol0, bf16_t* WT, int K, const float* g, float cs, LAS unsigned char* scr, int lane) {
    const int kr = lane >> 5, c4 = lane & 31;
    f32x4 a[16], b[16]; float ga[16], gb[16];
#pragma unroll
    for (int i = 0; i < 16; ++i) { int sa = k0 + 4 * i + 2 * kr, sb = sa + 1; if (KPERM) { sa = (sa & ~127) + head_perm(sa & 127); sb = (sb & ~127) + head_perm(sb & 127); }
        a[i] = *(const f32x4*)(W + (size_t)sa * ldw + scol0 + c4 * 4); b[i] = *(const f32x4*)(W + (size_t)sb * ldw + scol0 + c4 * 4);
        ga[i] = g ? g[sa] * cs : cs; gb[i] = g ? g[sb] * cs : cs; }
#pragma unroll
    for (int i = 0; i < 16; ++i) {
#pragma unroll
        for (int j = 0; j < 4; ++j) *(LAS unsigned*)(scr + (4 * c4 + j) * 144 + (2 * i + kr) * 4) = cvt_pk_bf16(a[i][j] * ga[i], b[i][j] * gb[i]); }
    LDS_WAIT(); asm volatile("" ::: "memory");
    const int q = lane & 7;
#pragma unroll
    for (int t = 0; t < 16; ++t) { const int n = 8 * t + (lane >> 3); const u32x4 v = *(const LAS u32x4*)(scr + n * 144 + q * 16);
        *(GAS u32x4*)(WT + (size_t)n * K + k0 + 8 * q) = v; }
    LDS_WAIT(); asm volatile("" ::: "memory");
}
__device__ __forceinline__ void tr_item_fp8(const float* W, size_t ldw, int k0, int scol0, unsigned char* WT, int K, const float* g, float cs, LAS unsigned char* scr, int lane) {
    const int kr = lane >> 4, c4 = lane & 15;
    const float* wl = W + (size_t)(4 * kr) * ldw + scol0 + c4 * 4;
    f32x4 a[8][4]; f32x4 gs[8];
#pragma unroll
    for (int i = 0; i < 8; ++i) {
#pragma unroll
        for (int t = 0; t < 4; ++t) a[i][t] = __builtin_nontemporal_load((const f32x4*)(wl + (size_t)(k0 + 16 * i + t) * ldw));
        gs[i] = g ? *(const f32x4*)(g + k0 + 16 * i + 4 * kr) * cs : (f32x4){cs, cs, cs, cs}; }
#pragma unroll
    for (int i = 0; i < 8; ++i)
#pragma unroll
        for (int j = 0; j < 4; ++j) *(LAS unsigned*)(scr + (4 * c4 + j) * 144 + (4 * i + kr) * 4) = pk_fp8x4(a[i][0][j] * gs[i][0], a[i][1][j] * gs[i][1], a[i][2][j] * gs[i][2], a[i][3][j] * gs[i][3]);
    LDS_WAIT(); asm volatile("" ::: "memory");
    const int q = lane & 7;
#pragma unroll
    for (int t = 0; t < 8; ++t) { const int n = 8 * t + (lane >> 3); const u32x4 v = *(const LAS u32x4*)(scr + n * 144 + q * 16);
        __builtin_nontemporal_store(v, (u32x4*)(WT + (size_t)n * K + k0 + 16 * q)); }
    LDS_WAIT(); asm volatile("" ::: "memory");
}
__device__ __forceinline__ void thin_item(int which, const float* W, const float* g, int k0, bf16_t* hi, bf16_t* lo, LAS float* scr, int lane) {
#pragma unroll 8
    for (int i = 0; i < 32; ++i) { const int kk = 2 * i + (lane >> 5), n = lane & 31, sk = k0 + kk; float v = 0.f;
        if (which == 0) { if (n < 16) v = W[(size_t)sk * 5140 + 3072 + n]; else if (n < 20) v = W[(size_t)sk * 5140 + 4624 + (n - 16)]; }
        else v = W[(size_t)sk * 32 + n];
        scr[kk * 33 + n] = v * g[sk]; }
    LDS_WAIT(); asm volatile("" ::: "memory");
    const int c = lane & 7;
#pragma unroll
    for (int j = 0; j < 4; ++j) { const int n = (lane >> 3) + 8 * j; const LAS float* s = scr + (8 * c) * 33 + n; float v[8], l[8];
#pragma unroll
        for (int t = 0; t < 8; ++t) { v[t] = s[t * 33]; l[t] = v[t] - __uint_as_float(f2bf(v[t]) << 16); }
        u32x4 o; o.x = pk2(v[0], v[1]); o.y = pk2(v[2], v[3]); o.z = pk2(v[4], v[5]); o.w = pk2(v[6], v[7]);
        *(GAS u32x4*)(hi + (size_t)n * 2048 + k0 + 8 * c) = o;
        o.x = pk2(l[0], l[1]); o.y = pk2(l[2], l[3]); o.z = pk2(l[4], l[5]); o.w = pk2(l[6], l[7]);
        *(GAS u32x4*)(lo + (size_t)n * 2048 + k0 + 8 * c) = o; }
    LDS_WAIT(); asm volatile("" ::: "memory");
}
__device__ __forceinline__ f32x4 bf_up4(bf16x8 h, int half) {
    f32x4 r;
#pragma unroll
    for (int j = 0; j < 4; ++j) r[j] = __uint_as_float(((unsigned)(unsigned short)h[4 * half + j]) << 16);
    return r;
}
template <int NT, bool Q8 = false>
__device__ __forceinline__ void rowpass16(const float* X, int row0, bf16_t* XB, const bf16_t* WT_hi, const bf16_t* WT_lo, f32x4 (&acc)[2], float& rstd_r, int lane) {
    const int r = lane & 15, q = lane >> 4;
    const float* xp = X + (size_t)(row0 + r) * DM + q * 16;
    bf16_t* xo = XB + (size_t)(row0 + r) * DM + q * 16;
    float ss = 0.f; acc[0] = (f32x4){0.f, 0.f, 0.f, 0.f}; acc[1] = acc[0];
#pragma unroll 2
    for (int kb = 0; kb < 32; ++kb) {
        const f32x4 v0 = *(const f32x4*)(xp + kb * 64), v1 = *(const f32x4*)(xp + kb * 64 + 4), v2 = *(const f32x4*)(xp + kb * 64 + 8), v3 = *(const f32x4*)(xp + kb * 64 + 12);
        ss += (v0[0] * v0[0] + v0[1] * v0[1]) + (v0[2] * v0[2] + v0[3] * v0[3]) + (v1[0] * v1[0] + v1[1] * v1[1]) + (v1[2] * v1[2] + v1[3] * v1[3]);
        ss += (v2[0] * v2[0] + v2[1] * v2[1]) + (v2[2] * v2[2] + v2[3] * v2[3]) + (v3[0] * v3[0] + v3[1] * v3[1]) + (v3[2] * v3[2] + v3[3] * v3[3]);
        const bf16x8 h0 = pack8(v0, v1), h1 = pack8(v2, v3);
        if constexpr (Q8) { u32x4 w8 = {pk_fp8x4(v0[0], v0[1], v0[2], v0[3]), pk_fp8x4(v1[0], v1[1], v1[2], v1[3]), pk_fp8x4(v2[0], v2[1], v2[2], v2[3]), pk_fp8x4(v3[0], v3[1], v3[2], v3[3])};
            *(u32x4*)((unsigned char*)XB + (size_t)(row0 + r) * DM + q * 16 + kb * 64) = w8; }
        else { *(bf16x8*)(xo + kb * 64) = h0; *(bf16x8*)(xo + kb * 64 + 8) = h1; }
        if constexpr (NT > 0) {
            const bf16x8 l0 = pack8(v0 - bf_up4(h0, 0), v1 - bf_up4(h0, 1)), l1 = pack8(v2 - bf_up4(h1, 0), v3 - bf_up4(h1, 1));
#pragma unroll
            for (int nt = 0; nt < NT; ++nt) {
                const bf16_t* wh = WT_hi + (size_t)(nt * 16 + r) * DM + kb * 64 + q * 16; const bf16_t* wl = WT_lo + (size_t)(nt * 16 + r) * DM + kb * 64 + q * 16;
                const bf16x8 bh0 = *(const bf16x8*)wh, bh1 = *(const bf16x8*)(wh + 8), bl0 = *(const bf16x8*)wl, bl1 = *(const bf16x8*)(wl + 8);
                acc[nt] = __builtin_amdgcn_mfma_f32_16x16x32_bf16(h0, bh0, acc[nt], 0, 0, 0); acc[nt] = __builtin_amdgcn_mfma_f32_16x16x32_bf16(l0, bh0, acc[nt], 0, 0, 0);
                acc[nt] = __builtin_amdgcn_mfma_f32_16x16x32_bf16(h0, bl0, acc[nt], 0, 0, 0);
                acc[nt] = __builtin_amdgcn_mfma_f32_16x16x32_bf16(h1, bh1, acc[nt], 0, 0, 0); acc[nt] = __builtin_amdgcn_mfma_f32_16x16x32_bf16(l1, bh1, acc[nt], 0, 0, 0);
                acc[nt] = __builtin_amdgcn_mfma_f32_16x16x32_bf16(h1, bl1, acc[nt], 0, 0, 0);
            }
        }
    }
    ss += __shfl_xor(ss, 16); ss += __shfl_xor(ss, 32);
    rstd_r = 1.0f / sqrtf(ss * (1.0f / DM) + EPS);
}

template <bool Q8>
__device__ __forceinline__ void rowpass_wg(const float* X, int row0, bf16_t* XB, const bf16_t* WT_hi, const bf16_t* WT_lo, f32x4 (&acc)[2], float& rstd_r, LAS unsigned char* wlds) {
    const int tid = threadIdx.x, lane = tid & 63, wave = __builtin_amdgcn_readfirstlane(tid >> 6), r = lane & 15, q = lane >> 4;
    const int rw = row0 + 16 * wave;
    const float* xp = X + (size_t)(rw + r) * DM + q * 16;
    bf16_t* xo = XB + (size_t)(rw + r) * DM + q * 16;
    float ss = 0.f; acc[0] = (f32x4){0.f, 0.f, 0.f, 0.f}; acc[1] = acc[0];
    f32x4 xa[4][4], xbuf[4][4]; u32x4 wst[4];
#define RW_LOADX(dst, c) do { _Pragma("unroll") for (int k4 = 0; k4 < 4; ++k4) _Pragma("unroll") for (int j = 0; j < 4; ++j) dst[k4][j] = *(const f32x4*)(xp + ((c) * 4 + k4) * 64 + 4 * j); } while (0)
#define RW_LOADW(c) do { _Pragma("unroll") for (int i = 0; i < 4; ++i) { const int p = tid + 512 * i, pp = p & 1023; const bf16_t* src = ((p >> 10) ? WT_lo : WT_hi) + (size_t)(pp >> 5) * DM + (c) * 256 + (pp & 31) * 8; \
        wst[i] = *(const u32x4*)src; } } while (0)
#define RW_STOREW() do { _Pragma("unroll") for (int i = 0; i < 4; ++i) { const int p = tid + 512 * i, pp = p & 1023; *(LAS u32x4*)(wlds + (p >> 10) * 16896 + (pp >> 5) * 528 + (pp & 31) * 16) = wst[i]; } } while (0)
#define RW_USE(src, c) do { _Pragma("unroll") for (int k4 = 0; k4 < 4; ++k4) { asm volatile("" ::: "memory"); const int kb = (c) * 4 + k4; const f32x4 v0 = src[k4][0], v1 = src[k4][1], v2 = src[k4][2], v3 = src[k4][3]; \
        ss += (v0[0] * v0[0] + v0[1] * v0[1]) + (v0[2] * v0[2] + v0[3] * v0[3]) + (v1[0] * v1[0] + v1[1] * v1[1]) + (v1[2] * v1[2] + v1[3] * v1[3]); \
        ss += (v2[0] * v2[0] + v2[1] * v2[1]) + (v2[2] * v2[2] + v2[3] * v2[3]) + (v3[0] * v3[0] + v3[1] * v3[1]) + (v3[2] * v3[2] + v3[3] * v3[3]); \
        const bf16x8 h0 = pack8_raw(v0, v1), h1 = pack8_raw(v2, v3); \
        if constexpr (Q8) { u32x4 w8 = {pk_fp8x4(v0[0], v0[1], v0[2], v0[3]), pk_fp8x4(v1[0], v1[1], v1[2], v1[3]), pk_fp8x4(v2[0], v2[1], v2[2], v2[3]), pk_fp8x4(v3[0], v3[1], v3[2], v3[3])}; \
            *(u32x4*)((unsigned char*)XB + (size_t)(rw + r) * DM + q * 16 + kb * 64) = w8; } \
        else { *(bf16x8*)(xo + kb * 64) = h0; *(bf16x8*)(xo + kb * 64 + 8) = h1; } \
        const bf16x8 l0 = pack8_raw(v0 - bf_up4(h0, 0), v1 - bf_up4(h0, 1)), l1 = pack8_raw(v2 - bf_up4(h1, 0), v3 - bf_up4(h1, 1)); \
        _Pragma("unroll") for (int nt = 0; nt < 2; ++nt) { const LAS unsigned char* wp = wlds + (nt * 16 + r) * 528 + (k4 * 64 + q * 16) * 2; \
            const bf16x8 bh0 = *(const LAS bf16x8*)wp, bh1 = *(const LAS bf16x8*)(wp + 16), bl0 = *(const LAS bf16x8*)(wp + 16896), bl1 = *(const LAS bf16x8*)(wp + 16896 + 16); \
            acc[nt] = __builtin_amdgcn_mfma_f32_16x16x32_bf16(h0, bh0, acc[nt], 0, 0, 0); acc[nt] = __builtin_amdgcn_mfma_f32_16x16x32_bf16(l0, bh0, acc[nt], 0, 0, 0); \
            acc[nt] = __builtin_amdgcn_mfma_f32_16x16x32_bf16(h0, bl0, acc[nt], 0, 0, 0); \
            acc[nt] = __builtin_amdgcn_mfma_f32_16x16x32_bf16(h1, bh1, acc[nt], 0, 0, 0); acc[nt] = __builtin_amdgcn_mfma_f32_16x16x32_bf16(l1, bh1, acc[nt], 0, 0, 0); \
            acc[nt] = __builtin_amdgcn_mfma_f32_16x16x32_bf16(h1, bl1, acc[nt], 0, 0, 0); } } } while (0)
    RW_LOADX(xa, 0);
#pragma unroll 1
    for (int c = 0; c < 8; c += 2) {
        RW_LOADW(c); RW_LOADX(xbuf, c + 1);
        __syncthreads(); RW_STOREW(); LDS_WAIT(); __syncthreads();
        RW_USE(xa, c);
        RW_LOADW(c + 1); if (c + 2 < 8) RW_LOADX(xa, c + 2);
        __syncthreads(); RW_STOREW(); LDS_WAIT(); __syncthreads();
        RW_USE(xbuf, c + 1);
    }
#undef RW_LOADX
#undef RW_LOADW
#undef RW_STOREW
#undef RW_USE
    ss += __shfl_xor(ss, 16); ss += __shfl_xor(ss, 32);
    rstd_r = 1.0f / sqrtf(ss * (1.0f / DM) + EPS);
    __syncthreads();
}

namespace pg8 {
struct EpiRowScaleBf16 {
    static constexpr bool PERM = true, META = false;
    bf16_t* O; int ldc; const float* rowscale;
    __device__ __forceinline__ void operator()(const f32x4 (&acc)[2][2][4][2], const Unit& u, int wr, int wc, int fr, int fq) const {
        const int row0 = u.pm * BM + wr * 64 + fr, col0 = u.pn * BM + wc * 32 + 8 * fq;
        float sc[2][4];
#pragma unroll
        for (int ai = 0; ai < 2; ++ai)
#pragma unroll
            for (int m = 0; m < 4; ++m) sc[ai][m] = rowscale[row0 + ai * HALF + m * 16];
        asm volatile("" : "+v"(sc[0][0]), "+v"(sc[0][1]), "+v"(sc[0][2]), "+v"(sc[0][3]), "+v"(sc[1][0]), "+v"(sc[1][1]), "+v"(sc[1][2]), "+v"(sc[1][3]));
#pragma unroll
        for (int ai = 0; ai < 2; ++ai)
#pragma unroll
            for (int m = 0; m < 4; ++m) { const int row = row0 + ai * HALF + m * 16; const float s = sc[ai][m]; bf16_t* rowp = O + (size_t)row * ldc + col0;
#pragma unroll
                for (int bj = 0; bj < 2; ++bj) { const f32x4 v0 = acc[ai][bj][m][0] * s, v1 = acc[ai][bj][m][1] * s;
                    u32x4 w; w.x = cvt_pk_bf16(v0[0], v0[1]); w.y = cvt_pk_bf16(v0[2], v0[3]); w.z = cvt_pk_bf16(v1[0], v1[1]); w.w = cvt_pk_bf16(v1[2], v1[3]);
                    *(u32x4*)(rowp + bj * HALF) = w; } }
    }
};
struct EpiResF32 {
    static constexpr bool PERM = false, META = false;
    const float* base; float* C; int ldc;
    __device__ __forceinline__ void operator()(const f32x4 (&acc)[2][2][4][2], const Unit& u, int wr, int wc, int fr, int fq) const {
        const int row0 = u.pm * BM + wr * 64 + fr, col0 = u.pn * BM + wc * 32 + 4 * fq;
#pragma unroll
        for (int ai = 0; ai < 2; ++ai) { f32x4 bs[4][2][2];
#pragma unroll
            for (int m = 0; m < 4; ++m)
#pragma unroll
                for (int bj = 0; bj < 2; ++bj)
#pragma unroll
                    for (int n = 0; n < 2; ++n) bs[m][bj][n] = *(const f32x4*)(base + (size_t)(row0 + ai * HALF + m * 16) * ldc + col0 + bj * HALF + n * 16);
#pragma unroll
            for (int m = 0; m < 4; ++m) asm volatile("" : "+v"(bs[m][0][0]), "+v"(bs[m][0][1]), "+v"(bs[m][1][0]), "+v"(bs[m][1][1]));
#pragma unroll
            for (int m = 0; m < 4; ++m)
#pragma unroll
                for (int bj = 0; bj < 2; ++bj)
#pragma unroll
                    for (int n = 0; n < 2; ++n) *(f32x4*)(C + (size_t)(row0 + ai * HALF + m * 16) * ldc + col0 + bj * HALF + n * 16) = bs[m][bj][n] + acc[ai][bj][m][n]; }
    }
};
struct EpiMoeUp {
    static constexpr bool PERM = true, META = false;
    bf16_t* ACT; const float* rstd; const float* bias;
    __device__ __forceinline__ void operator()(const f32x4 (&acc)[2][2][4][2], const Unit& u, int wr, int wc, int fr, int fq) const {
        asm volatile("" : "+v"(fr), "+v"(fq));
        const int j0 = u.pn * HALF + wc * 32 + 8 * fq; const float* bg = bias + (size_t)u.e * 4096 + j0; const float* bu = bg + 2048;
        int tk[2][4];
#pragma unroll
        for (int ai = 0; ai < 2; ++ai)
#pragma unroll
            for (int m = 0; m < 4; ++m) { const int r = ai * HALF + wr * 64 + m * 16 + fr; tk[ai][m] = u.rowidx[r < u.rows ? r : 0]; }
        f32x4 bg0 = *(const f32x4*)bg, bg1 = *(const f32x4*)(bg + 4), bu0 = *(const f32x4*)bu, bu1 = *(const f32x4*)(bu + 4);
        asm volatile("" : "+v"(tk[0][0]), "+v"(tk[0][1]), "+v"(tk[0][2]), "+v"(tk[0][3]), "+v"(tk[1][0]), "+v"(tk[1][1]), "+v"(tk[1][2]), "+v"(tk[1][3]), "+v"(bg0), "+v"(bg1), "+v"(bu0), "+v"(bu1));
        float sc[2][4];
#pragma unroll
        for (int ai = 0; ai < 2; ++ai)
#pragma unroll
            for (int m = 0; m < 4; ++m) sc[ai][m] = rstd[tk[ai][m] >> 2];
        asm volatile("" : "+v"(sc[0][0]), "+v"(sc[0][1]), "+v"(sc[0][2]), "+v"(sc[0][3]), "+v"(sc[1][0]), "+v"(sc[1][1]), "+v"(sc[1][2]), "+v"(sc[1][3]));
#pragma unroll
        for (int ai = 0; ai < 2; ++ai)
#pragma unroll
            for (int m = 0; m < 4; ++m) { const int r = ai * HALF + wr * 64 + m * 16 + fr; const float s = sc[ai][m];
                f32x4 o[2];
#pragma unroll
                for (int n = 0; n < 2; ++n) { const f32x4 g = acc[ai][0][m][n] * s + (n ? bg1 : bg0), up = acc[ai][1][m][n] * s + (n ? bu1 : bu0);
#pragma unroll
                    for (int i = 0; i < 4; ++i) { const float gg = fminf(g[i], 7.0f), uu = fminf(fmaxf(up[i], -7.0f), 7.0f);
                        const float sg = __builtin_amdgcn_rcpf(1.0f + __builtin_amdgcn_exp2f(-1.702f * 1.4426950408889634f * gg)); o[n][i] = gg * sg * (uu + 1.0f); } }
                u32x4 w; w.x = cvt_pk_bf16(o[0][0], o[0][1]); w.y = cvt_pk_bf16(o[0][2], o[0][3]); w.z = cvt_pk_bf16(o[1][0], o[1][1]); w.w = cvt_pk_bf16(o[1][2], o[1][3]);
                *(u32x4*)(ACT + ((size_t)u.pm * BM + r) * DFF + j0) = w; }
    }
};
struct EpiMoeDown {
    static constexpr bool PERM = true, META = true;
    bf16_t* Y; const float* gate; const float* bias;
    __device__ __forceinline__ void post(const Unit& u, LAS unsigned char* mb, int wid, int lane) const {
        const int r = (wid & 3) * 64 + lane, rc = r < u.rows ? r : 0;
        if (wid < 4) { __builtin_amdgcn_global_load_lds((const unsigned*)(u.rowidx + rc), (LAS unsigned*)(mb + wid * 256), 4, 0, 0);
                       __builtin_amdgcn_global_load_lds((const unsigned*)((const char*)(u.rowidx + rc) + (WS_ROWGATE - WS_ROWLIST)), (LAS unsigned*)(mb + 1024 + wid * 256), 4, 0, 0); }
        else __builtin_amdgcn_global_load_lds((const unsigned*)(bias + (size_t)u.e * DM + u.pn * BM + (wid - 4) * 64 + lane), (LAS unsigned*)(mb + 2048 + (wid - 4) * 256), 4, 0, 0);
    }
    __device__ __forceinline__ void operator()(const f32x4 (&acc)[2][2][4][2], const Unit& u, int wr, int wc, int fr, int fq, const LAS unsigned char* mb) const {
        asm volatile("" : "+v"(fr), "+v"(fq));
        const int col0 = u.pn * BM + wc * 32 + 8 * fq;
        f32x4 bv[2][2];
#pragma unroll
        for (int bj = 0; bj < 2; ++bj)
#pragma unroll
            for (int n = 0; n < 2; ++n) bv[bj][n] = *(const LAS f32x4*)(mb + 2048 + (bj * HALF + wc * 32 + 8 * fq + 4 * n) * 4);
#pragma unroll
        for (int ai = 0; ai < 2; ++ai)
#pragma unroll
            for (int m = 0; m < 4; ++m) { const int r = ai * HALF + wr * 64 + m * 16 + fr;
                const int a = (r < u.rows) ? *(const LAS int*)(mb + r * 4) : NASSIGN;
                const float g = *(const LAS float*)(mb + 1024 + r * 4);
#if Y_FP8
                unsigned char* rowp = (unsigned char*)Y + (size_t)a * DM + col0; const float g16 = g * 16.0f;
#pragma unroll
                for (int bj = 0; bj < 2; ++bj) { const f32x4 v0 = (acc[ai][bj][m][0] + bv[bj][0]) * g16, v1 = (acc[ai][bj][m][1] + bv[bj][1]) * g16;
                    u32x2 w; w.x = pk_fp8x4(v0[0], v0[1], v0[2], v0[3]); w.y = pk_fp8x4(v1[0], v1[1], v1[2], v1[3]);
                    *(u32x2*)(rowp + bj * HALF) = w; } }
#else
                bf16_t* rowp = Y + (size_t)a * DM + col0;
#pragma unroll
                for (int bj = 0; bj < 2; ++bj) { const f32x4 v0 = (acc[ai][bj][m][0] + bv[bj][0]) * g, v1 = (acc[ai][bj][m][1] + bv[bj][1]) * g;
                    u32x4 w; w.x = cvt_pk_bf16(v0[0], v0[1]); w.y = cvt_pk_bf16(v0[2], v0[3]); w.z = cvt_pk_bf16(v1[0], v1[1]); w.w = cvt_pk_bf16(v1[2], v1[3]);
                    *(u32x4*)(rowp + bj * HALF) = w; } }
#endif
    }
};
struct EpiMoeUpQ {
    static constexpr bool PERM = true, META = true;
    unsigned char* ACT; const float* rstd; const float* bias;
    __device__ __forceinline__ void post(const Unit& u, LAS unsigned char* mb, int wid, int lane) const {
        const int r = (wid & 3) * 64 + lane, rc = r < u.rows ? r : 0;
        if (wid < 4) __builtin_amdgcn_global_load_lds((const unsigned*)((const char*)(u.rowidx + rc) + (WS_ROWRSTD - WS_ROWLIST)), (LAS unsigned*)(mb + wid * 256), 4, 0, 0);
        else __builtin_amdgcn_global_load_lds((const unsigned*)(bias + (size_t)u.e * 4096 + ((wid - 4) >> 1) * 2048 + u.pn * HALF + ((wid - 4) & 1) * 64 + lane), (LAS unsigned*)(mb + 1024 + (wid - 4) * 256), 4, 0, 0);
    }
    __device__ __forceinline__ void operator()(const f32x4 (&acc)[2][2][4][2], const Unit& u, int wr, int wc, int fr, int fq, const LAS unsigned char* mb) const {
        asm volatile("" : "+v"(fr), "+v"(fq));
        const int j0 = u.pn * HALF + wc * 32 + 8 * fq, jl = wc * 32 + 8 * fq;
        const f32x4 bg0 = *(const LAS f32x4*)(mb + 1024 + jl * 4), bg1 = *(const LAS f32x4*)(mb + 1024 + jl * 4 + 16), bu0 = *(const LAS f32x4*)(mb + 1536 + jl * 4), bu1 = *(const LAS f32x4*)(mb + 1536 + jl * 4 + 16);
#pragma unroll
        for (int ai = 0; ai < 2; ++ai)
#pragma unroll
            for (int m = 0; m < 4; ++m) { const int r = ai * HALF + wr * 64 + m * 16 + fr; const float s = *(const LAS float*)(mb + r * 4);
                f32x4 o[2];
#pragma unroll
                for (int n = 0; n < 2; ++n) { const f32x4 g4 = acc[ai][0][m][n] * s + (n ? bg1 : bg0), u4 = acc[ai][1][m][n] * s + (n ? bu1 : bu0);
#pragma unroll
                    for (int hh = 0; hh < 2; ++hh) { f32x2 g = {g4[2 * hh], g4[2 * hh + 1]}, up = {u4[2 * hh], u4[2 * hh + 1]};
                        g = __builtin_elementwise_min(g, (f32x2){7.0f, 7.0f}); up = __builtin_elementwise_min(__builtin_elementwise_max(up, (f32x2){-7.0f, -7.0f}), (f32x2){7.0f, 7.0f});
                        const f32x2 ea = g * (-1.702f * 1.4426950408889634f); f32x2 e; e.x = __builtin_amdgcn_exp2f(ea.x); e.y = __builtin_amdgcn_exp2f(ea.y);
                        const f32x2 d = e + 1.0f; f32x2 sg; sg.x = __builtin_amdgcn_rcpf(d.x); sg.y = __builtin_amdgcn_rcpf(d.y);
                        const f32x2 t = g * 4.0f, r2 = (t * up + t) * sg; o[n][2 * hh] = r2.x; o[n][2 * hh + 1] = r2.y; } }
                u32x2 w; w.x = pk_fp8x4(o[0][0], o[0][1], o[0][2], o[0][3]); w.y = pk_fp8x4(o[1][0], o[1][1], o[1][2], o[1][3]);
                *(u32x2*)(ACT + ((size_t)u.pm * BM + r) * DFF + j0) = w; }
    }
};
struct MoeOrder {
    const char* A; const char* B; const int* rowlist; const int* ident; const LAS int* tab; int NT, K; size_t bexp; int G, c;
    __device__ __forceinline__ bool next(int i, Unit& u) const {
        if (i >= 32) return false;
        const LAS int* en = tab + 1024 + 8 * i;
        const int valid = __builtin_amdgcn_readfirstlane(en[0]); if (!valid) return false;
        const int e = __builtin_amdgcn_readfirstlane(en[1]), ntile = __builtin_amdgcn_readfirstlane(en[2]), pm = __builtin_amdgcn_readfirstlane(en[3]), rows = __builtin_amdgcn_readfirstlane(en[4]),
                  mrow = __builtin_amdgcn_readfirstlane(en[5]);
        u.e = e; u.pn = ntile; u.pm = pm; u.rows = rows;
        u.rowidx = rowlist + (size_t)e * NTOK + (size_t)mrow * BM;
        u.B = B + (size_t)e * bexp + (size_t)ntile * BM * K * 2;
        u.A = A;
        if (ident) { u.gidx = ident + (size_t)u.pm * BM; u.grows = BM; } else { u.gidx = u.rowidx; u.grows = u.rows; }
        return true;
    }
};
}
__device__ __forceinline__ void moe_build_table(LAS int* tab, const unsigned* cnt, int NT) {
    if (threadIdx.x == 0) { int ng = 0, start = 0, slot = 0;
        for (int e = 0; e < NEXP; ++e) { const int c = (int)cnt[e]; const int tiles = (c + 255) >> 8;
            for (int mt0 = 0; mt0 < tiles; mt0 += 8) { const int gsz = (tiles - mt0) < 8 ? (tiles - mt0) : 8; LAS int* en = tab + 8 + 8 * ng;
                en[0] = start; en[1] = e; en[2] = mt0; en[3] = gsz; en[4] = slot + mt0; en[5] = c - mt0 * 256; ++ng; start += gsz * NT; }
            slot += tiles; }
        tab[0] = ng; tab[1] = start; }
    __syncthreads();
    if (threadIdx.x < 32) { const int i = threadIdx.x, G = gridDim.x, c = blockIdx.x; const int total = tab[1], ng = tab[0]; LAS int* en = tab + 1024 + 8 * i;
        const long L = (long)i * G + c;
        if (L >= total) { en[0] = 0; }
        else { int p = (int)L; { const int q = total / pg8::NXCD, r = total % pg8::NXCD, xcd = p % pg8::NXCD, off = p / pg8::NXCD; p = (xcd < r ? xcd * (q + 1) : r * (q + 1) + (xcd - r) * q) + off; }
            int g = 0; while (g + 1 < ng && tab[8 + 8 * (g + 1)] <= p) ++g;
            const LAS int* ge = tab + 8 + 8 * g; const int qn = p - ge[0], gsz = ge[3], ntile = qn / gsz, mi = qn - ntile * gsz, rl = ge[5] - mi * 256;
            en[0] = 1; en[1] = ge[1]; en[2] = ntile; en[3] = ge[4] + mi; en[4] = rl < 256 ? rl : 256; en[5] = ge[2] + mi; } }
    __syncthreads();
}
__device__ __forceinline__ void gla_chunk_kv(int unit, const bf16_t* proj, const float* la, float* KV, float* Dc, char* lds) {
    const int tid = threadIdx.x, wid = __builtin_amdgcn_readfirstlane(tid >> 6), lane = tid & 63, r32 = lane & 31, hi = lane >> 5;
    const int b = unit >> 8, h = (unit >> 6) & 3, c = unit & 63; const size_t tok0 = (size_t)b * SEQ + (size_t)c * 64;
    char* V_lds = lds;
    const int dk = 32 * (wid & 3) + r32, hd = h * 128 + dk;
    float lav[64];
#pragma unroll
    for (int s = 0; s < 64; ++s) lav[s] = la[(tok0 + s) * 512 + hd];
    float kv[4][8];
#pragma unroll
    for (int ks = 0; ks < 4; ++ks)
#pragma unroll
        for (int j = 0; j < 8; ++j) kv[ks][j] = bf2f(proj[(tok0 + 16 * ks + 8 * hi + j) * NPROJ + C_KG + hd]);
    { const int sr = tid >> 4, sc = (tid & 15) * 8;
#pragma unroll
      for (int hf = 0; hf < 2; ++hf) { const bf16_t* vp = proj + (tok0 + sr) * NPROJ + C_VG + h * 256 + hf * 128 + sc;
          const bf16x8 a = *(const bf16x8*)vp, bb = *(const bf16x8*)(vp + (size_t)32 * NPROJ);
          *(bf16x8*)(V_lds + hf * fox::SHM_V + fox::v_st(sr, sc)) = a; *(bf16x8*)(V_lds + hf * fox::SHM_V + fox::v_st(32 + sr, sc)) = bb; } }
    float rsum = 0.f; float fr[4][8];
#pragma unroll
    for (int ks = 3; ks >= 0; --ks)
#pragma unroll
        for (int h2 = 1; h2 >= 0; --h2)
#pragma unroll
            for (int j = 7; j >= 0; --j) { const int s = 16 * ks + 8 * h2 + j;
                const float dec = __builtin_amdgcn_exp2f(rsum * 1.4426950408889634f);
                if (h2 == hi) fr[ks][j] = kv[ks][j] * dec;
                rsum += lav[s]; }
    bf16x8 pa[4];
#pragma unroll
    for (int ks = 0; ks < 4; ++ks) pa[ks] = pack8((f32x4){fr[ks][0], fr[ks][1], fr[ks][2], fr[ks][3]}, (f32x4){fr[ks][4], fr[ks][5], fr[ks][6], fr[ks][7]});
    __syncthreads();
    f32x16 o[4] = {};
    const int vb0 = (int)(uintptr_t)V_lds + fox::v_rd_base(lane);
    if ((wid >> 2) == 0) fox::pv_tile<0>(o, vb0, pa[0], pa[1], pa[2], pa[3]); else fox::pv_tile<1>(o, vb0, pa[0], pa[1], pa[2], pa[3]);
    bf16_t* kvo = (bf16_t*)KV + (size_t)unit * (128 * 256) + (size_t)((wid >> 2) * 128 + r32) * 128 + 32 * (wid & 3) + 4 * hi;
#pragma unroll
    for (int d0 = 0; d0 < 4; ++d0)
#pragma unroll
        for (int g = 0; g < 4; ++g) { u32x2 w; w.x = cvt_pk_bf16(o[d0][4 * g], o[d0][4 * g + 1]); w.y = cvt_pk_bf16(o[d0][4 * g + 2], o[d0][4 * g + 3]); *(u32x2*)(kvo + (size_t)d0 * 32 * 128 + 8 * g) = w; }
    if (hi == 0 && (wid >> 2) == 0) Dc[(size_t)unit * 128 + dk] = __builtin_amdgcn_exp2f(rsum * 1.4426950408889634f);
    __syncthreads();
}
struct GlaSet { bf16x8 kv[4]; bf16x8 qf[4]; };
__device__ __forceinline__ void gla_ld(GlaSet& R, int c, int b, int h, int sl, int mt, const bf16_t* proj, const bf16_t* KV, int r, int q) {
    const bf16_t* kvp = KV + (size_t)((b * 4 + h) * 64 + c) * (128 * 256) + (size_t)(sl * 16 + r) * 128 + 8 * q;
    const bf16_t* qp = proj + ((size_t)b * SEQ + (size_t)c * 64 + 16 * mt + r) * NPROJ + C_QG + h * 128 + 8 * q;
#pragma unroll
    for (int ks = 0; ks < 4; ++ks) { R.qf[ks] = *(const bf16x8*)(qp + 32 * ks); R.kv[ks] = *(const bf16x8*)(kvp + 32 * ks); }
}
typedef _Float16 f16x4 __attribute__((ext_vector_type(4)));
typedef _Float16 f16x8 __attribute__((ext_vector_type(8)));
__device__ __forceinline__ void gla_step(const GlaSet& R, f32x4 (&S)[4][2], const LAS _Float16* dl, int c, int b, int h, int sl, int mt, float* GO, int r, int q) {
    f32x4 o = {0.f, 0.f, 0.f, 0.f};
#pragma unroll
    for (int ks = 0; ks < 4; ++ks) { const f16x8 dh = *(const LAS f16x8*)(dl + c * 128 + 32 * ks + 8 * q);
        const f32x4 d0 = {(float)dh[0], (float)dh[1], (float)dh[2], (float)dh[3]}, d1 = {(float)dh[4], (float)dh[5], (float)dh[6], (float)dh[7]};
        S[ks][0] = d0 * S[ks][0] + bf_up4(R.kv[ks], 0); S[ks][1] = d1 * S[ks][1] + bf_up4(R.kv[ks], 1);
        o = __builtin_amdgcn_mfma_f32_16x16x32_bf16(pack8(S[ks][0], S[ks][1]), R.qf[ks], o, 0, 0, 0); }
    u32x2 w; w.x = cvt_pk_bf16(o[0], o[1]); w.y = cvt_pk_bf16(o[2], o[3]);
    *(u32x2*)((bf16_t*)GO + ((size_t)b * SEQ + (size_t)c * 64 + 16 * mt + r) * 1024 + h * 256 + sl * 16 + 4 * q) = w;
}
__device__ __forceinline__ void gla_scan(int unit, const bf16_t* proj, const float* KVf, float* GO, const LAS _Float16* dl, int lane) {
    const bf16_t* KV = (const bf16_t*)KVf;
    const int mt = unit & 3, u2 = unit >> 2, b = u2 >> 6, h = (u2 >> 4) & 3, sl = u2 & 15, r = lane & 15, q = lane >> 4;
    f32x4 S[4][2];
#pragma unroll
    for (int ks = 0; ks < 4; ++ks) { S[ks][0] = (f32x4){0.f, 0.f, 0.f, 0.f}; S[ks][1] = S[ks][0]; }
    GlaSet R0, R1, R2, R3;
    gla_ld(R0, 0, b, h, sl, mt, proj, KV, r, q); gla_ld(R1, 1, b, h, sl, mt, proj, KV, r, q); gla_ld(R2, 2, b, h, sl, mt, proj, KV, r, q);
#pragma unroll 1
    for (int c = 0; c < 64; c += 4) {
        gla_ld(R3, c + 3, b, h, sl, mt, proj, KV, r, q);
        gla_step(R0, S, dl, c, b, h, sl, mt, GO, r, q);
        if (c + 4 < 64) gla_ld(R0, c + 4, b, h, sl, mt, proj, KV, r, q);
        gla_step(R1, S, dl, c + 1, b, h, sl, mt, GO, r, q);
        if (c + 4 < 64) gla_ld(R1, c + 5, b, h, sl, mt, proj, KV, r, q);
        gla_step(R2, S, dl, c + 2, b, h, sl, mt, GO, r, q);
        if (c + 4 < 64) gla_ld(R2, c + 6, b, h, sl, mt, proj, KV, r, q);
        gla_step(R3, S, dl, c + 3, b, h, sl, mt, GO, r, q);
    }
    LDS_WAIT(); asm volatile("" ::: "memory");
}
__device__ __forceinline__ void gla_finish8(int th0, const float* GO, const bf16_t* proj, const float* gain, bf16_t* mix, int lane) {
    f32x4 v[8]; u32x2 gw[8];
#pragma unroll
    for (int i = 0; i < 8; ++i) { const int th = th0 + i, tok = th >> 2, h = th & 3;
        { const u32x2 w = *(const u32x2*)((const bf16_t*)GO + (size_t)tok * 1024 + h * 256 + lane * 4); v[i] = (f32x4){__uint_as_float(w.x << 16), __uint_as_float(w.x & 0xffff0000u), __uint_as_float(w.y << 16), __uint_as_float(w.y & 0xffff0000u)}; } gw[i] = *(const u32x2*)(proj + (size_t)tok * NPROJ + C_GG + h * 256 + lane * 4); }
#pragma unroll
    for (int i = 0; i < 8; ++i) { const int th = th0 + i, tok = th >> 2, h = th & 3;
        const float ss = wave_sum((v[i][0] * v[i][0] + v[i][1] * v[i][1]) + (v[i][2] * v[i][2] + v[i][3] * v[i][3]));
        const float rs = 1.0f / sqrtf(ss * (1.0f / 256.0f) + EPS);
        const f32x4 g = *(const f32x4*)(gain + h * 256 + lane * 4);
        const float g0 = __uint_as_float(gw[i].x << 16), g1 = __uint_as_float(gw[i].x & 0xffff0000u), g2 = __uint_as_float(gw[i].y << 16), g3 = __uint_as_float(gw[i].y & 0xffff0000u);
        auto silu = [](float x) { return x * __builtin_amdgcn_rcpf(1.0f + __expf(-x)); };
        u32x2 w; w.x = cvt_pk_bf16(v[i][0] * rs * g[0] * silu(g0), v[i][1] * rs * g[1] * silu(g1)); w.y = cvt_pk_bf16(v[i][2] * rs * g[2] * silu(g2), v[i][3] * rs * g[3] * silu(g3));
        *(u32x2*)(mix + (size_t)tok * DM + h * 256 + lane * 4) = w; }
}

__device__ __forceinline__ void fox_combine8(int th0, const float* PO, const float* ML, const float* gain, bf16_t* mix, int lane) {
    const int l32 = lane & 31, sub = lane >> 5; constexpr float C2 = 1.4426950408889634f * 0.08838834764831845f;
    f32x4 o0[4], o1[4]; f32x2 ml0[4], ml1[4];
#pragma unroll
    for (int i = 0; i < 4; ++i) { const size_t th = (size_t)(th0 + 2 * i + sub);
        { const u32x2 w0 = *(const u32x2*)((const bf16_t*)PO + th * 128 + l32 * 4), w1 = *(const u32x2*)((const bf16_t*)PO + (size_t)NTOK * 512 + th * 128 + l32 * 4);
          o0[i] = (f32x4){__uint_as_float(w0.x << 16), __uint_as_float(w0.x & 0xffff0000u), __uint_as_float(w0.y << 16), __uint_as_float(w0.y & 0xffff0000u)};
          o1[i] = (f32x4){__uint_as_float(w1.x << 16), __uint_as_float(w1.x & 0xffff0000u), __uint_as_float(w1.y << 16), __uint_as_float(w1.y & 0xffff0000u)}; }
        ml0[i] = *(const f32x2*)(ML + th * 2); ml1[i] = *(const f32x2*)(ML + (size_t)NTOK * 8 + th * 2); }
#pragma unroll
    for (int i = 0; i < 4; ++i) { const int th = th0 + 2 * i + sub, tok = th >> 2, h = th & 3;
        const float m = fmaxf(ml0[i][0], ml1[i][0]), a0 = __builtin_amdgcn_exp2f((ml0[i][0] - m) * C2), a1 = __builtin_amdgcn_exp2f((ml1[i][0] - m) * C2);
        const float inv = 1.0f / (ml0[i][1] * a0 + ml1[i][1] * a1);
        const f32x4 v = (o0[i] * a0 + o1[i] * a1) * inv;
        float ss = (v[0] * v[0] + v[1] * v[1]) + (v[2] * v[2] + v[3] * v[3]);
        ss += __shfl_xor(ss, 1); ss += __shfl_xor(ss, 2); ss += __shfl_xor(ss, 4); ss += __shfl_xor(ss, 8); ss += __shfl_xor(ss, 16);
        const float rs = 1.0f / sqrtf(ss * (1.0f / 128.0f) + EPS);
        const float* g = gain + h * 128 + l32;
        u32x2 w; w.x = cvt_pk_bf16(v[0] * rs * g[0], v[1] * rs * g[32]); w.y = cvt_pk_bf16(v[2] * rs * g[64], v[3] * rs * g[96]);
        *(u32x2*)(mix + (size_t)tok * DM + 1024 + h * 128 + l32 * 4) = w; }
}

__device__ __forceinline__ void memkv_tile(int t, const bf16_t* memb, const bf16_t* WT, const float* rstd, bf16_t* KM, bf16_t* VT, int lane) {
    const int rt = t >> 5, ct = t & 31, r = lane & 15, q = lane >> 4;
    const bf16_t* ap = memb + (size_t)(rt * 32 + r) * DM + q * 16; const bf16_t* bp = WT + (size_t)(ct * 32 + r) * DM + q * 16;
    f32x4 acc[2][2] = {};
#pragma unroll 4
    for (int kb = 0; kb < 32; ++kb) {
        bf16x8 a[2][2], bb[2][2];
#pragma unroll
        for (int i = 0; i < 2; ++i)
#pragma unroll
            for (int s = 0; s < 2; ++s) { a[i][s] = *(const bf16x8*)(ap + (size_t)i * 16 * DM + kb * 64 + s * 8); bb[i][s] = *(const bf16x8*)(bp + (size_t)i * 16 * DM + kb * 64 + s * 8); }
#pragma unroll
        for (int i = 0; i < 2; ++i)
#pragma unroll
            for (int j = 0; j < 2; ++j)
#pragma unroll
                for (int s = 0; s < 2; ++s) acc[i][j] = __builtin_amdgcn_mfma_f32_16x16x32_bf16(a[i][s], bb[j][s], acc[i][j], 0, 0, 0);
    }
#pragma unroll
    for (int i = 0; i < 2; ++i) { const int row = rt * 32 + 16 * i + 4 * q;
        const f32x4 rs = *(const f32x4*)(rstd + row);
#pragma unroll
        for (int j = 0; j < 2; ++j) { const int col = ct * 32 + 16 * j + r; const f32x4 v = acc[i][j] * rs;
            if (col < 512) {
#pragma unroll
                for (int tt = 0; tt < 4; ++tt) KM[(size_t)(row + tt) * 512 + col] = (bf16_t)(cvt_pk_bf16(v[tt], 0.f) & 0xffffu); }
            else { const int hd = col - 512, bb2 = row >> 8, key = row & 255; u32x2 w; w.x = cvt_pk_bf16(v[0], v[1]); w.y = cvt_pk_bf16(v[2], v[3]);
                *(u32x2*)(VT + ((size_t)(bb2 * 4 + (hd >> 7)) * 128 + (hd & 127)) * 256 + key) = w; } } }
}
__device__ __forceinline__ void memattn_unit(int bh, int qt, const bf16_t* proj, const LAS unsigned char* kl, const LAS unsigned char* vl, const float* gain, bf16_t* mix, int lane) {
    const int b = bh >> 2, h = bh & 3, r32 = lane & 31, hi = lane >> 5;
    const size_t tok0 = (size_t)b * SEQ + (size_t)qt * 32;
    bf16x8 qr[8];
#pragma unroll
    for (int d0 = 0; d0 < 8; ++d0) qr[d0] = *(const bf16x8*)(proj + (tok0 + r32) * NPROJ + C_QM + h * 128 + d0 * 16 + hi * 8);
    const int sw = r32 & 15;
    const LAS unsigned char* ka[8];
#pragma unroll
    for (int d0 = 0; d0 < 8; ++d0) ka[d0] = kl + r32 * 256 + (((2 * d0 + hi) ^ sw) << 4);
    float mx = -3.0e38f;
#pragma unroll 1
    for (int j = 0; j < 8; ++j) { f32x16 p = {}; const int ko = j * 32 * 256;
#pragma unroll
        for (int d0 = 0; d0 < 8; ++d0) p = __builtin_amdgcn_mfma_f32_32x32x16_bf16(*(const LAS bf16x8*)(ka[d0] + ko), qr[d0], p, 0, 0, 0);
#pragma unroll
        for (int r = 0; r < 16; ++r) mx = fmaxf(mx, p[r]); }
    { auto rr = __builtin_amdgcn_permlane32_swap(__float_as_uint(mx), __float_as_uint(mx), false, false); mx = fmaxf(__uint_as_float(rr[0]), __uint_as_float(rr[1])); }
    constexpr float C2 = 1.4426950408889634f * 0.08838834764831845f; const float mL = -mx * C2;
    float ps = 0.f;
    f32x16 o[4] = {};
    const LAS unsigned char* va[4];
#pragma unroll
    for (int ks = 0; ks < 4; ++ks) va[ks] = vl + r32 * 512 + (((2 * ks + hi) ^ (sw & 7)) << 4);
#define PK4(P, B_, OUT) do { unsigned a0 = cvt_pk_bf16(P[B_+0], P[B_+1]), a1 = cvt_pk_bf16(P[B_+2], P[B_+3]), b0 = cvt_pk_bf16(P[B_+4], P[B_+5]), b1 = cvt_pk_bf16(P[B_+6], P[B_+7]); \
        auto r0 = __builtin_amdgcn_permlane32_swap(a0, b0, false, false); auto r1 = __builtin_amdgcn_permlane32_swap(a1, b1, false, false); \
        u32x4 w = {r0[0], r1[0], r0[1], r1[1]}; OUT = __builtin_bit_cast(bf16x8, w); } while (0)
#pragma unroll 1
    for (int jj = 0; jj < 4; ++jj) { f32x16 p0 = {}, p1 = {}; const int ko = jj * 64 * 256;
#pragma unroll
        for (int d0 = 0; d0 < 8; ++d0) { p0 = __builtin_amdgcn_mfma_f32_32x32x16_bf16(*(const LAS bf16x8*)(ka[d0] + ko), qr[d0], p0, 0, 0, 0);
                                         p1 = __builtin_amdgcn_mfma_f32_32x32x16_bf16(*(const LAS bf16x8*)(ka[d0] + ko + 32 * 256), qr[d0], p1, 0, 0, 0); }
#pragma unroll
        for (int r = 0; r < 16; ++r) { p0[r] = __builtin_amdgcn_exp2f(fmaf(p0[r], C2, mL)); p1[r] = __builtin_amdgcn_exp2f(fmaf(p1[r], C2, mL)); ps += p0[r] + p1[r]; }
        bf16x8 pa[4];
        PK4(p0, 0, pa[0]); PK4(p0, 8, pa[1]); PK4(p1, 0, pa[2]); PK4(p1, 8, pa[3]);
        const int vo = (jj >> 1) * 256 + ((((jj & 1) << 3) ^ (sw & 8)) << 4);
#pragma unroll
        for (int ks = 0; ks < 4; ++ks)
#pragma unroll
            for (int d0 = 0; d0 < 4; ++d0) o[d0] = __builtin_amdgcn_mfma_f32_32x32x16_bf16(pa[ks], *(const LAS bf16x8*)(va[ks] + vo + d0 * 32 * 512), o[d0], 0, 0, 0); }
#undef PK4
    { auto rr = __builtin_amdgcn_permlane32_swap(__float_as_uint(ps), __float_as_uint(ps), false, false); ps = __uint_as_float(rr[0]) + __uint_as_float(rr[1]); }
    const float rl = __builtin_amdgcn_rcpf(ps);
    const float g0 = gain[h * 128 + r32], g1 = gain[h * 128 + 32 + r32], g2 = gain[h * 128 + 64 + r32], g3 = gain[h * 128 + 96 + r32];
    bf16_t* out = mix + tok0 * DM + 1536 + h * 128;
#pragma unroll
    for (int r = 0; r < 16; ++r) { const int orow = fox::crow(r, hi); const float rlr = __shfl(rl, orow);
        const float v0 = o[0][r] * rlr, v1 = o[1][r] * rlr, v2 = o[2][r] * rlr, v3 = o[3][r] * rlr;
        float ss = (v0 * v0 + v1 * v1) + (v2 * v2 + v3 * v3);
        ss += __shfl_xor(ss, 1); ss += __shfl_xor(ss, 2); ss += __shfl_xor(ss, 4); ss += __shfl_xor(ss, 8); ss += __shfl_xor(ss, 16);
        const float rs = 1.0f / sqrtf(ss * (1.0f / 128.0f) + EPS);
        u32x2 w; w.x = cvt_pk_bf16(v0 * rs * g0, v1 * rs * g1); w.y = cvt_pk_bf16(v2 * rs * g2, v3 * rs * g3);
        *(u32x2*)(out + (size_t)orow * DM + r32 * 4) = w; }
}

constexpr int NWAVES = 8;
constexpr int CONV_ALL = 49152, CONV_P1 = 6144, CONV_P7 = 6144, CONV_P2 = CONV_ALL - CONV_P1 - CONV_P7;
#ifndef MK_N_LAUNCHES
#define MK_N_LAUNCHES 1
#endif
#ifndef REP_PHASE
#define REP_PHASE -1
#endif
#ifndef REP_EXTRA
#define REP_EXTRA 1
#endif
#define REP_SUB 0
constexpr int PER_PHASE = 11;
constexpr int N_LAUNCHES = MK_N_LAUNCHES;
struct Args {
    const float *x, *mem, *g_attn, *g_mem, *w_in, *w_a2, *b_a, *g_gla, *b_fox, *g_fox, *w_mkv, *g_memo, *w_out, *g_ffn, *w_router, *b_router, *w_up, *b_up, *w_down, *b_down, *g_final;
    float* out; unsigned char* ws; int ph_lo, ph_hi;
};
typedef const __attribute__((address_space(4))) Args* KArgs;
__device__ __forceinline__ KArgs kargs() { KArgs p = (KArgs)__builtin_amdgcn_kernarg_segment_ptr(); asm volatile("" : "+s"(p)); return p; }
__global__ void __launch_bounds__(NWAVES * 64, 2) fwd(Args a_unused) {
    extern __shared__ __attribute__((aligned(16))) unsigned char lds_raw[];
    LAS unsigned char* lds = (LAS unsigned char*)lds_raw;
    const int tid = threadIdx.x, lane = tid & 63, wave = __builtin_amdgcn_readfirstlane(tid >> 6);
    const int G = gridDim.x, bx = blockIdx.x;
    const int vcu = (G % 8 == 0) ? (bx % 8) * (G / 8) + bx / 8 : bx;
    const int gw = vcu * NWAVES + wave, NGW = G * NWAVES;
    unsigned char* ws = kargs()->ws;
    unsigned* ctl = (unsigned*)(ws + WS_CTL);
    volatile LAS unsigned* MISC = (volatile LAS unsigned*)(lds + MISC_OFF);
    for (int u = tid; u < (LDS_BYTES - MISC_OFF) / 4; u += NWAVES * 64) ((LAS unsigned*)(lds + MISC_OFF))[u] = 0u;
    __syncthreads();
    XcdBarrier bar; bar.bar = ctl + CW_BAR; bar.x = 0; bar.st = nullptr;
    if (N_LAUNCHES == 1) bar = xcd_barrier_post(ctl + CW_BAR, MISC + 8);
#define GRID_BAR() do { if (N_LAUNCHES == 1) xcd_barrier(bar); } while (0)
    const int lo = kargs()->ph_lo, hi_ph = kargs()->ph_hi & 0xff, sub = kargs()->ph_hi >> 8;
#define PART(i) (sub == 0 || ((sub >> (i)) & 1))
#ifndef PH_MASK
#define PH_MASK 0xFFFF
#endif
#define IN(k) (((PH_MASK >> (k)) & 1) && lo <= (k) && (k) < hi_ph)
#define BOTH(k) (IN(k) && IN((k) + 1))
    bf16_t* WsmT = (bf16_t*)(ws + WS_WSM); bf16_t* WrT = (bf16_t*)(ws + WS_WSM + 256 * 1024);
    float* rstd1 = (float*)(ws + WS_RSTD); float* rstdm = rstd1 + 16384; float* rstd2 = rstd1 + 32768;
    float* small = (float*)(ws + WS_SMALL); float* gate_a = (float*)(ws + WS_GATE); int* rowlist = (int*)(ws + WS_ROWLIST);
    bf16_t* WmkvT = (bf16_t*)(ws + WS_WMKV); bf16_t* WoutT = (bf16_t*)(ws + WS_WOUT); bf16_t* WinT = (bf16_t*)(ws + WS_WIN);
    bf16_t* memb = (bf16_t*)(ws + WS_MEMB); bf16_t* KM = (bf16_t*)(ws + WS_KVM); bf16_t* VT = (bf16_t*)(ws + WS_KVM + MiB);
    float* glaD = (float*)(ws + WS_GLAD); bf16_t* xb = (bf16_t*)(ws + WS_XB); bf16_t* proj = (bf16_t*)(ws + WS_PROJ); bf16_t* mix = (bf16_t*)(ws + WS_MIX);
    float* x1 = (float*)(ws + WS_X1); bf16_t* x1b = (bf16_t*)(ws + WS_X1B); float* glaKV = (float*)(ws + WS_GLAKV); float* glaO = (float*)(ws + WS_GLAO);
    bf16_t* WupT = (bf16_t*)(ws + WS_WUP); bf16_t* WdownT = (bf16_t*)(ws + WS_WDOWN); bf16_t* act = (bf16_t*)(ws + WS_ACT); bf16_t* ybuf = (bf16_t*)(ws + WS_Y);
    unsigned* cnt = ctl + CW_CNT; float* la = (float*)(ws + WS_LA); int* ident = (int*)(ws + WS_IDENT); float* rowgate = (float*)(ws + WS_ROWGATE); float* rowrstd = (float*)(ws + WS_ROWRSTD);

#if MOE_FP8
#define MOE_CONV_ITEM(r_) do { const int r = (int)(r_); KArgs kq = kargs(); LAS unsigned char* scr = lds + wave * 18432; \
        if (r < 32768) { const int e = r >> 10, q = r & 1023, kb = q >> 6, nb = q & 63, nt = nb >> 2, bj = (nb >> 1) & 1, j64 = nb & 1; \
            tr_item_fp8(kq->w_up + (size_t)e * DM * 4096, 4096, kb * 128, bj * 2048 + nt * 128 + j64 * 64, (unsigned char*)WupT + ((size_t)e * 4096 + nb * 64) * DM, DM, kq->g_ffn, 32.0f, scr, lane); } \
        else { const int r2 = r - 32768, e = r2 >> 9, q = r2 & 511, kb = q >> 5, nb = q & 31; \
            tr_item_fp8(kq->w_down + (size_t)e * DFF * DM, DM, kb * 128, nb * 64, (unsigned char*)WdownT + ((size_t)e * DM + nb * 64) * DFF, DFF, nullptr, 32.0f, scr, lane); } } while (0)
#else
#define MOE_CONV_ITEM(r_) do { const int r = (int)(r_); KArgs kq = kargs(); LAS unsigned char* scr = lds + wave * 18432; \
        if (r < 32768) { const int e = r >> 10, q = r & 1023, kb = q >> 5, nb = q & 31, nt = nb >> 1, bj = nb & 1; \
            tr_item<false>(kq->w_up + (size_t)e * DM * 4096, 4096, kb * 64, bj * 2048 + nt * 128, WupT + ((size_t)e * 4096 + nb * 128) * DM, DM, kq->g_ffn, 1.0f, scr, lane); } \
        else { const int r2 = r - 32768, e = r2 >> 9, q = r2 & 511, kb = q >> 4, nb = q & 15; \
            tr_item<false>(kq->w_down + (size_t)e * DFF * DM, DM, kb * 64, nb * 128, WdownT + ((size_t)e * DM + nb * 128) * DFF, DFF, nullptr, 1.0f, scr, lane); } } while (0)
#endif
    if (IN(0)) {
        KArgs ka = kargs();
        LAS unsigned char* scr = lds + wave * 18432; LAS float* scrf = (LAS float*)scr;
        constexpr int I_IN = 32 * 40, I_OUT = 32 * 16, I_MKV = 32 * 8, I_TH = 32;
        constexpr int NITEMS = I_IN + I_OUT + I_MKV + 2 * I_TH;
        for (int it = gw; it < NITEMS; it += NGW) {
            int r = it;
            if (r < I_IN) { const int kb = r / 40, nb = r % 40, n0 = nb * 128; const int sc0 = n0 < 3072 ? n0 : (n0 < 4608 ? n0 + 16 : n0 + 20);
                tr_item<false>(ka->w_in, 5140, kb * 64, sc0, WinT + (size_t)n0 * DM, DM, ka->g_attn, n0 < 512 ? 0.08838834764831845f : 1.0f, scr, lane); continue; } r -= I_IN;
            if (r < I_OUT) { const int kb = r >> 4, nb = r & 15;
                if (kb < 16) tr_item<false>(ka->w_out, DM, kb * 64, nb * 128, WoutT + (size_t)nb * 128 * DM, DM, nullptr, 1.0f, scr, lane);
                else tr_item<true>(ka->w_out, DM, kb * 64, nb * 128, WoutT + (size_t)nb * 128 * DM, DM, nullptr, 1.0f, scr, lane);
                continue; } r -= I_OUT;
            if (r < I_MKV) { const int kb = r >> 3, nb = r & 7;
                tr_item<false>(ka->w_mkv, 1024, kb * 64, nb * 128, WmkvT + (size_t)nb * 128 * DM, DM, ka->g_mem, 1.0f, scr, lane); continue; } r -= I_MKV;
            if (r < I_TH) { thin_item(0, ka->w_in, ka->g_attn, r * 64, WsmT, WsmT + 32 * 2048, scrf, lane); continue; } r -= I_TH;
            thin_item(1, ka->w_router, ka->g_ffn, r * 64, WrT, WrT + 32 * 2048, scrf, lane);
        }
        for (int i = gw * 64 + lane; i < MAXTILES * 256; i += NGW * 64) ident[i] = i << 2;
        for (int row = gw; row < NB * NMEM; row += NGW) {
            const float* xr = ka->mem + (size_t)row * DM + lane * 4; f32x4 v[8]; float ss = 0.f;
#pragma unroll
            for (int j = 0; j < 8; ++j) v[j] = *(const f32x4*)(xr + j * 256);
#pragma unroll
            for (int j = 0; j < 8; ++j) { ss += (v[j][0] * v[j][0] + v[j][1] * v[j][1]) + (v[j][2] * v[j][2] + v[j][3] * v[j][3]);
                u32x2 w; w.x = cvt_pk_bf16(v[j][0], v[j][1]); w.y = cvt_pk_bf16(v[j][2], v[j][3]); *(u32x2*)(memb + (size_t)row * DM + j * 256 + lane * 4) = w; }
            ss = wave_sum(ss); if (lane == 0) rstdm[row] = 1.0f / sqrtf(ss * (1.0f / DM) + EPS); }
        if (BOTH(0)) GRID_BAR();
    }
    if (IN(1)) {
        KArgs ka = kargs();
        LAS float* alw = (LAS float*)(lds + wave * 1024);
        LAS unsigned char* wl = lds + 8192;
        for (int gq8 = vcu; gq8 < NTOK / 128; gq8 += G) { const int gq = gq8 * 8 + wave; f32x4 acc2[2]; float rs;
            rowpass_wg<false>(ka->x, gq8 * 128, xb, WsmT, WsmT + 32 * 2048, acc2, rs, wl);
            int lane = tid & 63; asm volatile("" : "+v"(lane));
            if (lane < 16) rstd1[gq * 16 + lane] = rs;
            const int r = lane & 15, q = lane >> 4;
#pragma unroll
            for (int i = 0; i < 4; ++i) { const float rr = __shfl(rs, 4 * q + i);
                alw[(4 * q + i) * 16 + r] = acc2[0][i] * rr; small[(size_t)(gq * 16 + 4 * q + i) * 32 + 16 + r] = acc2[1][i] * rr; }
            LDS_WAIT(); asm volatile("" ::: "memory");
#pragma unroll 1
            for (int hb = 0; hb < 8; ++hb) { const int hd = hb * 64 + lane; float w[16];
#pragma unroll
                for (int k2 = 0; k2 < 16; ++k2) w[k2] = ka->w_a2[k2 * 512 + hd];
                const float ba = ka->b_a[hd];
#pragma unroll 4
                for (int rw = 0; rw < 16; ++rw) { const f32x4 a0 = *(const LAS f32x4*)(alw + rw * 16), a1 = *(const LAS f32x4*)(alw + rw * 16 + 4), a2 = *(const LAS f32x4*)(alw + rw * 16 + 8), a3 = *(const LAS f32x4*)(alw + rw * 16 + 12);
                    float z = ba;
                    z += a0[0] * w[0] + a0[1] * w[1] + a0[2] * w[2] + a0[3] * w[3]; z += a1[0] * w[4] + a1[1] * w[5] + a1[2] * w[6] + a1[3] * w[7];
                    z += a2[0] * w[8] + a2[1] * w[9] + a2[2] * w[10] + a2[3] * w[11]; z += a3[0] * w[12] + a3[1] * w[13] + a3[2] * w[14] + a3[3] * w[15];
                    const float ls = fminf(z, 0.f) - __logf(1.0f + __expf(-fabsf(z)));
                    la[(size_t)(gq * 16 + rw) * 512 + hd] = ls * (1.0f / 16.0f); } }
            LDS_WAIT(); asm volatile("" ::: "memory"); }
        for (int t = gw - NTOK / 16; t < 1024; t += NGW) if (t >= 0) memkv_tile(t, memb, WmkvT, rstdm, KM, VT, lane);
        if (NGW == 2048 && gw >= 1024) { for (int it = CONV_P2 + (gw - 1024); it < CONV_P2 + CONV_P1; it += 1024) MOE_CONV_ITEM(it); }
        else if (NGW != 2048) { for (int it = CONV_P2 + gw; it < CONV_P2 + CONV_P1; it += NGW) MOE_CONV_ITEM(it); }
        if (BOTH(1)) GRID_BAR();
    }
    if (IN(2)) {
        KArgs ka = kargs();
        pg8::StaticOrder S; S.init(xb, WinT, NTOK, NPROJ, DM, G, bx);
        pg8::EpiRowScaleBf16 E{proj, NPROJ, rstd1};
        const bool conv_first = (bx & 7) < 4;
        if (conv_first) { for (int it = gw; it < CONV_P2; it += NGW) MOE_CONV_ITEM(it); __syncthreads(); }
        pg8::gemm_phase<pg8::EpiRowScaleBf16, pg8::StaticOrder, false>(lds, DM, S, E);
        if (!conv_first) { __syncthreads(); for (int it = gw; it < CONV_P2; it += NGW) MOE_CONV_ITEM(it); }
        if (BOTH(2)) GRID_BAR();
    }
    if (IN(3)) {
        KArgs ka = kargs();
        if (G == 256) {
            const int j = bx >> 3, bh = 2 * (bx & 7) + (j >> 4), x = j & 7, sh = (j >> 3) & 1, b = bh >> 2, h = bh & 3;
            char* l = (char*)lds_raw; float* Fb = (float*)(l + fox::LDS_FB); float* wsum = (float*)(l + fox::LDS_WS);
            bf16_t* PO = (bf16_t*)(ws + WS_FOXO) + (size_t)sh * NTOK * 512; float* PML = (float*)(ws + WS_FOXML) + (size_t)sh * NTOK * 8;
            {
                const float bf = ka->b_fox[h]; float v[8]; float run = 0.f;
#pragma unroll
                for (int i = 0; i < 8; ++i) { const int k = tid * 8 + i; const float lf = log_sigmoid(small[((size_t)b * SEQ + k) * 32 + 16 + h] + bf); run += lf; v[i] = run; }
                float inc = run;
#pragma unroll
                for (int o = 1; o < 64; o <<= 1) { const float t2 = __shfl_up(inc, o); if (lane >= o) inc += t2; }
                if (lane == 63) wsum[wave] = inc;
                __syncthreads();
                float woff = 0.f; for (int w2 = 0; w2 < wave; ++w2) woff += wsum[w2];
                const float base = woff + inc - run;
#pragma unroll
                for (int i = 0; i < 8; ++i) Fb[tid * 8 + i] = -(base + v[i]) * (1.0f / fox::SCALE);
                __syncthreads(); }
#pragma unroll 1
            for (int pass = 0; pass < 2; ++pass) { const int qb = pass ? 15 - x : x, n = 4 * (qb + 1);
                fox::BlockRef cur; cur.Q = proj + (size_t)(b * SEQ + qb * 256) * NPROJ + C_QF + h * 128; cur.K = proj + (size_t)b * SEQ * NPROJ + C_KF + h * 128; cur.V = proj + (size_t)b * SEQ * NPROJ + C_VF + h * 128;
                cur.P0 = qb * 256; cur.j_lo = sh ? n / 2 : 0; cur.j_hi = sh ? n : n / 2;
                fox::Seam Sm; fox::prime(cur, l, Sm);
                fox::EpiPartial E{(float*)(PO + ((size_t)b * SEQ * 4 + h) * 128), PML + ((size_t)b * SEQ * 4 + h) * 2};
                fox::block<fox::EpiPartial>(cur, cur, l, Sm, E); }
        }
        for (int u = bx; u < 1024; u += G) gla_chunk_kv(u, proj, la, glaKV, glaD, (char*)lds_raw);
        if (BOTH(3)) GRID_BAR();
    }
    if (IN(4)) {
        KArgs ka = kargs();
#pragma unroll 1
        for (int g = vcu; g < 256; g += G) {
            const int bh = g >> 4; int tl = tid, ll = lane; asm volatile("" : "+v"(tl), "+v"(ll));
            { const float* dsrc = glaD + (size_t)bh * 8192; const bf16_t* ksrc = KM + (size_t)((bh >> 2) * 256) * 512 + (bh & 3) * 128; const bf16_t* vsrc = VT + (size_t)bh * 128 * 256;
              f32x4 t[4]; bf16x8 kk[8], vv[8];
#pragma unroll
              for (int i = 0; i < 4; ++i) t[i] = *(const f32x4*)(dsrc + (i * 512 + tl) * 4);
#pragma unroll
              for (int i = 0; i < 8; ++i) { const int idx = i * 512 + tl; kk[i] = *(const bf16x8*)(ksrc + (size_t)(idx >> 4) * 512 + (idx & 15) * 8); }
#pragma unroll
              for (int i = 0; i < 8; ++i) vv[i] = *(const bf16x8*)(vsrc + (size_t)(i * 512 + tl) * 8);
#pragma unroll
              for (int i = 0; i < 4; ++i) { const f16x4 hv = {(_Float16)t[i][0], (_Float16)t[i][1], (_Float16)t[i][2], (_Float16)t[i][3]}; *(LAS f16x4*)(lds + (i * 512 + tl) * 8) = hv; }
#pragma unroll
              for (int i = 0; i < 8; ++i) { const int idx = i * 512 + tl, row = idx >> 4, ch = idx & 15; *(LAS bf16x8*)(lds + 16384 + row * 256 + ((ch ^ (row & 15)) << 4)) = kk[i]; }
#pragma unroll
              for (int i = 0; i < 8; ++i) { const int idx = i * 512 + tl, row = idx >> 5, ch = idx & 31; *(LAS bf16x8*)(lds + 81920 + row * 512 + ((ch ^ (row & 15)) << 4)) = vv[i]; }
              __syncthreads(); }
            if (wave < 4) { if (PART(0)) gla_scan(g * 4 + wave, proj, glaKV, glaO, (const LAS _Float16*)lds, ll); }
            else if (PART(1)) { for (int i = 0; i < 2; ++i) memattn_unit(bh, (g & 15) * 8 + i * 4 + (wave - 4), proj, lds + 16384, lds + 81920, ka->g_memo, mix, ll); }
            __syncthreads();
        }
        if (BOTH(4)) GRID_BAR();
    }
    if (IN(5)) {
        KArgs ka = kargs();
        for (int th = gw * 8; th < NTOK * 4; th += NGW * 8) gla_finish8(th, glaO, proj, ka->g_gla, mix, lane);
        for (int th = gw * 8; th < NTOK * 4; th += NGW * 8) fox_combine8(th, (const float*)(ws + WS_FOXO), (const float*)(ws + WS_FOXML), ka->g_fox, mix, lane);
        if (BOTH(5)) GRID_BAR();
    }
    if (IN(6)) {
        KArgs ka = kargs();
        pg8::StaticOrder S; S.init(mix, WoutT, NTOK, DM, DM, G, bx);
        pg8::EpiResF32 E{ka->x, x1, DM};
        pg8::gemm_phase<pg8::EpiResF32, pg8::StaticOrder, false>(lds, DM, S, E);
        if (BOTH(6)) GRID_BAR();
    }
    if (IN(7)) {
        KArgs ka = kargs();
        LAS float* lg = (LAS float*)(lds + wave * 2048);
        LAS unsigned char* wl = lds + 16384;
        for (int gq8 = vcu; gq8 < NTOK / 128; gq8 += G) { const int gq = gq8 * 8 + wave; f32x4 acc2[2]; float rs;
            rowpass_wg<MOE_FP8 != 0>(x1, gq8 * 128, x1b, WrT, WrT + 32 * 2048, acc2, rs, wl);
            int lane = tid & 63; asm volatile("" : "+v"(lane));
            if (lane < 16) rstd2[gq * 16 + lane] = rs;
            const int r = lane & 15, q = lane >> 4;
#pragma unroll
            for (int i = 0; i < 4; ++i) { const float rr = __shfl(rs, 4 * q + i);
                lg[(4 * q + i) * 32 + r] = acc2[0][i] * rr + ka->b_router[r]; lg[(4 * q + i) * 32 + 16 + r] = acc2[1][i] * rr + ka->b_router[16 + r]; }
            LDS_WAIT(); asm volatile("" ::: "memory");
            if (lane < 16) { const int tok = gq * 16 + lane; const float rsrow = rs; float v[32];
#pragma unroll
                for (int e = 0; e < 32; ++e) v[e] = lg[lane * 32 + e];
                int idx[4]; float val[4];
#pragma unroll
                for (int k = 0; k < 4; ++k) { float best = -3.0e38f; int bi = 0;
#pragma unroll
                    for (int e = 0; e < 32; ++e) { const bool better = v[e] > best; best = better ? v[e] : best; bi = better ? e : bi; }
                    idx[k] = bi; val[k] = best;
#pragma unroll
                    for (int e = 0; e < 32; ++e) v[e] = (e == bi) ? -3.0e38f : v[e]; }
                const float e0 = 1.0f, e1 = __expf(val[1] - val[0]), e2 = __expf(val[2] - val[0]), e3 = __expf(val[3] - val[0]); const float inv = 1.0f / (e0 + e1 + e2 + e3);
                const float gt[4] = {e0 * inv, e1 * inv, e2 * inv, e3 * inv};
#pragma unroll
                for (int k = 0; k < 4; ++k) { const int asg = tok * 4 + k; const unsigned pos = atomicAdd(&cnt[idx[k]], 1u); const size_t rp = (size_t)idx[k] * NTOK + pos; rowlist[rp] = asg; rowgate[rp] = gt[k]; rowrstd[rp] = rsrow; } }
            LDS_WAIT(); asm volatile("" ::: "memory");
        }
        if (NGW == 2048 && gw >= 1024) { for (int it = CONV_P2 + CONV_P1 + (gw - 1024); it < CONV_ALL; it += 1024) MOE_CONV_ITEM(it); }
        else if (NGW != 2048) { for (int it = CONV_P2 + CONV_P1 + gw; it < CONV_ALL; it += NGW) MOE_CONV_ITEM(it); }
        if (BOTH(7)) GRID_BAR();
    }
    if (IN(8)) {
        KArgs ka = kargs();
        LAS int* tab = (LAS int*)(lds + TAB_OFF);
        moe_build_table(tab, cnt, 16);
#if MOE_FP8
        pg8::MoeOrder S{(const char*)x1b, (const char*)WupT, rowlist, nullptr, tab, 16, DM / 2, (size_t)4096 * DM, G, bx};
        pg8::EpiMoeUpQ E{(unsigned char*)act, rstd2, ka->b_up};
        pg8::gemm_phase<pg8::EpiMoeUpQ, pg8::MoeOrder, true, true, 127, 122>(lds, DM / 2, S, E);
#else
        pg8::MoeOrder S{(const char*)x1b, (const char*)WupT, rowlist, nullptr, tab, 16, DM, (size_t)4096 * DM * 2, G, bx};
        pg8::EpiMoeUp E{act, rstd2, ka->b_up};
        pg8::gemm_phase<pg8::EpiMoeUp, pg8::MoeOrder, true>(lds, DM, S, E);
#endif
        if (BOTH(8)) GRID_BAR();
    }
    if (IN(9)) {
        KArgs ka = kargs();
        LAS int* tab = (LAS int*)(lds + TAB_OFF);
        __syncthreads();
        moe_build_table(tab, cnt, 8);
#if MOE_FP8
        pg8::MoeOrder S{(const char*)act, (const char*)WdownT, rowlist, ident, tab, 8, DFF / 2, (size_t)DM * DFF, G, bx};
        pg8::EpiMoeDown E{ybuf, gate_a, ka->b_down};
        pg8::gemm_phase<pg8::EpiMoeDown, pg8::MoeOrder, true, true, 125, 122>(lds, DFF / 2, S, E);
#else
        pg8::MoeOrder S{(const char*)act, (const char*)WdownT, rowlist, ident, tab, 8, DFF, (size_t)DM * DFF * 2, G, bx};
        pg8::EpiMoeDown E{ybuf, gate_a, ka->b_down};
        pg8::gemm_phase<pg8::EpiMoeDown, pg8::MoeOrder, true>(lds, DFF, S, E);
#endif
        if (BOTH(9)) GRID_BAR();
    }
    if (IN(10)) {
        KArgs ka = kargs();
        const int lane = (int)__builtin_amdgcn_mbcnt_hi(~0u, __builtin_amdgcn_mbcnt_lo(~0u, 0u));
        for (int tok = gw; tok < NTOK; tok += NGW) {
            f32x4 v[8]; float ss = 0.f;
#if Y_FP8
            unsigned yw[4][8];
#pragma unroll
            for (int j = 0; j < 8; ++j) { v[j] = __builtin_nontemporal_load((const f32x4*)(x1 + (size_t)tok * DM + j * 256 + lane * 4));
#pragma unroll
                for (int k = 0; k < 4; ++k) yw[k][j] = __builtin_nontemporal_load((const unsigned*)((const unsigned char*)ybuf + ((size_t)tok * 4 + k) * DM + j * 256 + lane * 4)); }
#pragma unroll
            for (int j = 0; j < 8; ++j) {
#pragma unroll
                for (int k = 0; k < 4; ++k) { const f32x2 lo = __builtin_amdgcn_cvt_pk_f32_fp8((int)yw[k][j], false), hi2 = __builtin_amdgcn_cvt_pk_f32_fp8((int)yw[k][j], true);
                    v[j][0] += lo[0] * 0.0625f; v[j][1] += lo[1] * 0.0625f; v[j][2] += hi2[0] * 0.0625f; v[j][3] += hi2[1] * 0.0625f; }
#else
            u32x2 yw[4][8];
#pragma unroll
            for (int j = 0; j < 8; ++j) { v[j] = __builtin_nontemporal_load((const f32x4*)(x1 + (size_t)tok * DM + j * 256 + lane * 4));
#pragma unroll
                for (int k = 0; k < 4; ++k) yw[k][j] = __builtin_nontemporal_load((const u32x2*)(ybuf + ((size_t)tok * 4 + k) * DM + j * 256 + lane * 4)); }
#pragma unroll
            for (int j = 0; j < 8; ++j) {
#pragma unroll
                for (int k = 0; k < 4; ++k) { const u32x2 w = yw[k][j];
                    v[j][0] += __uint_as_float(w.x << 16); v[j][1] += __uint_as_float(w.x & 0xffff0000u); v[j][2] += __uint_as_float(w.y << 16); v[j][3] += __uint_as_float(w.y & 0xffff0000u); }
#endif
                ss += (v[j][0] * v[j][0] + v[j][1] * v[j][1]) + (v[j][2] * v[j][2] + v[j][3] * v[j][3]); }
            const float rs = 1.0f / sqrtf(wave_sum(ss) * (1.0f / DM) + EPS);
#pragma unroll
            for (int j = 0; j < 8; ++j) { const f32x4 g = *(const f32x4*)(ka->g_final + j * 256 + lane * 4); __builtin_nontemporal_store(v[j] * rs * g, (f32x4*)(ka->out + (size_t)tok * DM + j * 256 + lane * 4)); }
        }
    }
#undef IN
#undef BOTH
#undef GRID_BAR
}

extern "C" void kernel_launch(void* const* d_in, const int* in_sizes, int n_in, void* d_out, int out_size, void* d_ws, size_t ws_size, hipStream_t stream) {
    static int grid = 0;
    if (grid == 0) {
        if (n_in != 21 || in_sizes[0] != NTOK * DM || out_size != NTOK * DM || ws_size < WS_END) { fprintf(stderr, "kernel_launch: unexpected shapes (n_in %d, in0 %d, out %d, ws %zu)\n", n_in, n_in > 0 ? in_sizes[0] : -1, out_size, ws_size); grid = -1; return; }
        int dev = 0, cus = 0;
        if (hipGetDevice(&dev) != hipSuccess || hipDeviceGetAttribute(&cus, hipDeviceAttributeMultiprocessorCount, dev) != hipSuccess) { grid = -1; return; }
        if (hipFuncSetAttribute((const void*)fwd, hipFuncAttributeMaxDynamicSharedMemorySize, LDS_BYTES) != hipSuccess) { fprintf(stderr, "kernel_launch: hipFuncSetAttribute failed\n"); grid = -1; return; }
        int per_cu = 0; (void)hipOccupancyMaxActiveBlocksPerMultiprocessor(&per_cu, (const void*)fwd, NWAVES * 64, LDS_BYTES); (void)hipGetLastError();
        if (per_cu < 1) fprintf(stderr, "kernel_launch: occupancy query says %d\n", per_cu);
        grid = cus;
    }
    if (grid < 0) return;
    (void)hipMemsetAsync((char*)d_ws + WS_CTL, 0, CTL_ZERO_BYTES, stream);
    Args a{};
    const float** fp = (const float**)&a.x;
    for (int i = 0; i < 21; ++i) fp[i] = (const float*)d_in[i];
    a.out = (float*)d_out; a.ws = (unsigned char*)d_ws;
    if (N_LAUNCHES == 1) { a.ph_lo = 0; a.ph_hi = PER_PHASE; hipLaunchKernelGGL(fwd, dim3(grid), dim3(NWAVES * 64), LDS_BYTES, stream, a); }
    else for (int p = 0; p < PER_PHASE; ++p) { a.ph_lo = p; a.ph_hi = p + 1;
        for (int rep = 0; rep < ((p == REP_PHASE) ? 1 + REP_EXTRA : 1); ++rep) { a.ph_hi = (p + 1) | ((rep > 0 ? REP_SUB : 0) << 8); hipLaunchKernelGGL(fwd, dim3(grid), dim3(NWAVES * 64), LDS_BYTES, stream, a); } }
}
```

```cpp
#include <hip/hip_runtime.h>
#include <cstdio>
#include <cstdint>

#define GAS __attribute__((address_space(1)))
#define LAS __attribute__((address_space(3)))
typedef unsigned short bf16_t;
typedef short bf16x8 __attribute__((ext_vector_type(8)));
typedef short s16x4 __attribute__((ext_vector_type(4)));
typedef float f32x2 __attribute__((ext_vector_type(2)));
typedef float f32x4 __attribute__((ext_vector_type(4)));
typedef float f32x16 __attribute__((ext_vector_type(16)));
typedef unsigned u32x2 __attribute__((ext_vector_type(2)));
typedef unsigned u32x4 __attribute__((ext_vector_type(4)));
typedef GAS unsigned gu32;
#define RLX_AGENT __ATOMIC_RELAXED, __HIP_MEMORY_SCOPE_AGENT
#define LDS_WAIT() asm volatile("s_waitcnt lgkmcnt(0)" ::: "memory")
#define VM_WAIT() asm volatile("s_waitcnt vmcnt(0)" ::: "memory")
#define SBAR() __builtin_amdgcn_sched_barrier(0)

#ifndef Y_FP8
#define Y_FP8 1
#endif
#ifndef MOE_FP8
#define MOE_FP8 1
#endif
constexpr int DM = 2048, NB = 4, SEQ = 4096, NTOK = NB * SEQ, NMEM = 256;
constexpr int NPROJ = 5120;
constexpr int C_QG = 0, C_KG = 512, C_VG = 1024, C_GG = 2048, C_QF = 3072, C_KF = 3584, C_VF = 4096, C_QM = 4608;
constexpr int NEXP = 32, TOPK = 4, DFF = 2048, NASSIGN = NTOK * TOPK, MAXTILES = NASSIGN / 256 + NEXP;
constexpr float EPS = 1e-5f;

typedef __bf16 bf16v2_t __attribute__((ext_vector_type(2)));
__device__ __forceinline__ unsigned cvt_pk_bf16(float lo, float hi) { const f32x2 v = {lo, hi}; return __builtin_bit_cast(unsigned, __builtin_convertvector(v, bf16v2_t)); }
__device__ __forceinline__ unsigned pk_fp8x4(float a, float b, float c, float d) { int w = 0; w = __builtin_amdgcn_cvt_pk_fp8_f32(a, b, w, false); w = __builtin_amdgcn_cvt_pk_fp8_f32(c, d, w, true); return (unsigned)w; }
__device__ __forceinline__ float bf2f(unsigned short b) { return __uint_as_float(((unsigned)b) << 16); }
__device__ __forceinline__ bf16x8 pack8(f32x4 a, f32x4 b) { u32x4 w = {cvt_pk_bf16(a[0], a[1]), cvt_pk_bf16(a[2], a[3]), cvt_pk_bf16(b[0], b[1]), cvt_pk_bf16(b[2], b[3])}; return __builtin_bit_cast(bf16x8, w); }
__device__ __forceinline__ unsigned cvt_pk_bf16_raw(float lo, float hi) { unsigned r; asm volatile("v_cvt_pk_bf16_f32 %0, %1, %2" : "=v"(r) : "v"(lo), "v"(hi)); return r; }
__device__ __forceinline__ bf16x8 pack8_raw(f32x4 a, f32x4 b) { u32x4 w = {cvt_pk_bf16_raw(a[0], a[1]), cvt_pk_bf16_raw(a[2], a[3]), cvt_pk_bf16_raw(b[0], b[1]), cvt_pk_bf16_raw(b[2], b[3])}; return __builtin_bit_cast(bf16x8, w); }
__device__ __forceinline__ float wave_sum(float v) {
#pragma unroll
    for (int o = 1; o < 64; o <<= 1) v += __shfl_xor(v, o);
    return v;
}
__device__ __forceinline__ float log_sigmoid(float z) { return fminf(z, 0.f) - log1pf(__expf(-fabsf(z))); }

namespace pg8 {
constexpr int META_OFF = 148480, META_BYTES = 4096;
constexpr int GSLOT_OFF = 131072 + 8192;
constexpr int BM = 256, BK = 64, HALF = 128, HTB = HALF * BK * 2, STAGE_BYTES = 8 * HTB, NXCD = 8, WGM = 8;
__host__ __device__ __forceinline__ int lds_byte(int r, int c) { const int st = (r >> 4) * 2 + (c >> 5), rr = r & 15, cc = c & 31, ob = rr * 64 + cc * 2; return st * 1024 + (ob ^ (((ob >> 9) & 1) << 5)); }
__host__ __device__ __forceinline__ void stage_rc(int b, int& R, int& C) { const int st = b / 1024, sb = b % 1024, swz = sb ^ (((sb >> 9) & 1) << 5); R = (st >> 1) * 16 + swz / 64; C = (st & 1) * 32 + (swz % 64) / 2; }
__host__ __device__ __forceinline__ int perm32(int rho) { const int n = rho >> 4, i = rho & 15; return 8 * (i >> 2) + 4 * n + (i & 3); }

struct Unit { const char* A; const char* B; const int* rowidx; const int* gidx; int pm, pn, e, rows, grows; };

struct StaticOrder {
    const char* A; const char* B; int K; int nM, nN, nwg, G, c;
    __device__ void init(const void* A_, const void* B_, int M, int N, int K_, int G_, int c_) { A = (const char*)A_; B = (const char*)B_; K = K_; nM = M / BM; nN = N / BM; nwg = nM * nN; G = G_; c = c_; }
    __device__ __forceinline__ bool next(int i, Unit& u) const {
        const long L = (long)i * G + c; if (L >= nwg) return false;
        int wgid = (int)L; { const int q = nwg / NXCD, r = nwg % NXCD, xcd = wgid % NXCD, off = wgid / NXCD; wgid = (xcd < r ? xcd * (q + 1) : r * (q + 1) + (xcd - r) * q) + off; }
        const int nig = WGM * nN, gid = wgid / nig, fm = gid * WGM, gsz = (nM - fm) < WGM ? (nM - fm) : WGM;
        u.pm = fm + ((wgid % nig) % gsz); u.pn = (wgid % nig) / gsz; u.e = 0; u.rows = BM; u.rowidx = nullptr; u.gidx = nullptr; u.grows = BM;
        u.A = A + (size_t)u.pm * BM * K * 2; u.B = B + (size_t)u.pn * BM * K * 2; return true;
    }
};

typedef int v4i_t __attribute__((ext_vector_type(4)));
typedef int v8i_t __attribute__((ext_vector_type(8)));
template <class Epi, class Sched, bool GATHER, bool FP8 = false, int SCA = 127, int SCB = 127>
__device__ __forceinline__ void gemm_phase(LAS unsigned char* lds, const int K, const Sched& S, const Epi& E) {
    const int tid = threadIdx.x, wid = __builtin_amdgcn_readfirstlane(tid >> 6), lane = tid & 63, wr = wid >> 2, wc = wid & 3, fr = lane & 15, fq = lane >> 4;
    const int nt = K / BK;
    unsigned voffA[2], voffB[2]; int RA[2], CA[2];
#pragma unroll
    for (int i = 0; i < 2; ++i) { int R, C; stage_rc(tid * 16 + i * 8192, R, C); const int Rb = Epi::PERM ? ((R & ~31) + perm32(R & 31)) : R;
        RA[i] = R; CA[i] = C; voffA[i] = (unsigned)(R * K + C) * 2u; voffB[i] = (unsigned)(Rb * K + C) * 2u; }
    const size_t kstep = (size_t)(BK * 2);
    const size_t hstep = (size_t)HALF * K * 2;
    const unsigned ldsw = (unsigned)wid * 1024u;
    const int aoff = lds_byte(wr * 64 + fr, fq * 8), boff = lds_byte(wc * 32 + fr, fq * 8);
    unsigned gcur[2][2];
#define PG8_SA(b, h) (((b) * 2 + (h)) * HTB)
#define PG8_SB(b, h) ((4 + (b) * 2 + (h)) * HTB)
#define PG8_STAGE(bufoff, gbase, voff) do { _Pragma("unroll") for (int _i = 0; _i < 2; ++_i) \
        __builtin_amdgcn_global_load_lds((const unsigned*)((const char*)(gbase) + (voff)[_i]), (LAS unsigned*)(lds + (bufoff) + ldsw + _i * 8192), 16, 0, 0); } while (0)
#define PG8_STAGE_A(bufoff, base, kb, h, NX) do { if constexpr (GATHER) { PG8_STAGE(bufoff, (base) + (kb), gcur[h]); } \
        else PG8_STAGE(bufoff, (base) + (kb) + (h) * hstep, voffA); } while (0)
#define PG8_LDA(dst, b, h) do { _Pragma("unroll") for (int m = 0; m < 4; ++m) { dst[m].lo = *(const LAS v4i_t*)(lds + PG8_SA(b, h) + aoff + m * 2048); dst[m].hi = *(const LAS v4i_t*)(lds + PG8_SA(b, h) + aoff + m * 2048 + 1024); } } while (0)
#define PG8_LDB(dst, b, h) do { _Pragma("unroll") for (int n = 0; n < 2; ++n) { dst[n].lo = *(const LAS v4i_t*)(lds + PG8_SB(b, h) + boff + n * 2048); dst[n].hi = *(const LAS v4i_t*)(lds + PG8_SB(b, h) + boff + n * 2048 + 1024); } } while (0)
#define PG8_BF(x) __builtin_bit_cast(bf16x8, (v4i_t)(x))
#define PG8_MMA(ai, bj, At, Bt) do { __builtin_amdgcn_s_setprio(1); _Pragma("unroll") for (int m = 0; m < 4; ++m) _Pragma("unroll") for (int n = 0; n < 2; ++n) { \
        if constexpr (FP8) acc[ai][bj][m][n] = __builtin_amdgcn_mfma_scale_f32_16x16x128_f8f6f4(Bt[n], At[m], acc[ai][bj][m][n], 0, 0, 0, SCB * 0x01010101, 0, SCA * 0x01010101); \
        else { acc[ai][bj][m][n] = __builtin_amdgcn_mfma_f32_16x16x32_bf16(PG8_BF(Bt[n].lo), PG8_BF(At[m].lo), acc[ai][bj][m][n], 0, 0, 0); \
               acc[ai][bj][m][n] = __builtin_amdgcn_mfma_f32_16x16x32_bf16(PG8_BF(Bt[n].hi), PG8_BF(At[m].hi), acc[ai][bj][m][n], 0, 0, 0); } } \
        __builtin_amdgcn_s_setprio(0); } while (0)
#define PG8_WAIT_V(n) asm volatile("s_waitcnt vmcnt(" #n ")" ::: "memory")
#define PG8_WAIT_L(n) asm volatile("s_waitcnt lgkmcnt(" #n ")" ::: "memory")
#define PG8_BAR __builtin_amdgcn_s_barrier()
#define PG8_SCHED __builtin_amdgcn_sched_barrier(0)
#define PG8_GIDX(dst, u) do { _Pragma("unroll") for (int _h = 0; _h < 2; ++_h) _Pragma("unroll") for (int _i = 0; _i < 2; ++_i) { \
        const int _r = _h * HALF + RA[_i]; const int _t = (u).gidx[_r < (u).grows ? _r : 0] >> 2; dst[_h][_i] = (unsigned)(_t * K + CA[_i]) * 2u; } } while (0)
#define PG8_GPOST(u) do { _Pragma("unroll") for (int _h = 0; _h < 2; ++_h) _Pragma("unroll") for (int _i = 0; _i < 2; ++_i) { const int _r = _h * HALF + RA[_i]; \
        __builtin_amdgcn_global_load_lds((const unsigned*)((u).gidx + (_r < (u).grows ? _r : 0)), (LAS unsigned*)(lds + GSLOT_OFF + (_h * 2 + _i) * 2048 + wid * 256), 4, 0, 0); } } while (0)
#define PG8_GTAKE() do { _Pragma("unroll") for (int _h = 0; _h < 2; ++_h) _Pragma("unroll") for (int _i = 0; _i < 2; ++_i) { \
        const int _t = *(const LAS int*)(lds + GSLOT_OFF + (_h * 2 + _i) * 2048 + wid * 256 + lane * 4) >> 2; gcur[_h][_i] = (unsigned)(_t * K + CA[_i]) * 2u; } } while (0)
    Unit cur, nxt; int ui = 0;
    if (!S.next(0, cur)) return;
    f32x4 acc[2][2][4][2];
#pragma unroll
    for (int a = 0; a < 2; ++a)
#pragma unroll
        for (int b = 0; b < 2; ++b)
#pragma unroll
            for (int m = 0; m < 4; ++m)
#pragma unroll
                for (int n = 0; n < 2; ++n) acc[a][b][m][n] = (f32x4){0.f, 0.f, 0.f, 0.f};
    v8i_t At[4], B0[2], B1[2];
    const char* cA = cur.A; const char* cB = cur.B;
    if constexpr (GATHER) { PG8_GIDX(gcur, cur); }
    PG8_STAGE(PG8_SB(0, 0), cB, voffB); PG8_STAGE(PG8_SB(0, 1), cB + hstep, voffB); PG8_STAGE_A(PG8_SA(0, 0), cA, 0, 0, false); PG8_STAGE_A(PG8_SA(0, 1), cA, 0, 1, false);
    if (wr == 1) PG8_BAR;
    PG8_WAIT_V(2); PG8_BAR;
    PG8_STAGE(PG8_SB(1, 0), cB + kstep, voffB); PG8_STAGE_A(PG8_SA(1, 0), cA, kstep, 0, false); PG8_STAGE(PG8_SB(1, 1), cB + hstep + kstep, voffB);
    PG8_WAIT_V(6); PG8_BAR;
    for (;;) {
        const bool has_next = S.next(ui + 1, nxt);
        const char* nA = has_next ? nxt.A : cA; const char* nB = has_next ? nxt.B : cB;
        if constexpr (GATHER) { if (has_next) { PG8_GPOST(nxt); } else { PG8_GPOST(cur); } }
        if constexpr (Epi::META) E.post(cur, lds + META_OFF + (ui & 1) * META_BYTES, wid, lane);
        for (int t = 0; t < nt; t += 2) {
            const bool last = (t == nt - 2);
            const size_t k1 = (size_t)(t + 1) * kstep;
            const char* a2 = last ? nA : cA; const char* b2 = last ? nB : cB + (size_t)(t + 2) * kstep;
            const size_t ka2 = last ? 0 : (size_t)(t + 2) * kstep, ka3 = ka2 + kstep; const char* b3 = b2 + kstep;
            PG8_LDB(B0, 0, 0); PG8_LDB(B1, 0, 1); PG8_SCHED; PG8_LDA(At, 0, 0); PG8_STAGE_A(PG8_SA(1, 1), cA, k1, 1, false);
            if constexpr (GATHER) { if (last) { PG8_GTAKE(); } }
            PG8_WAIT_V(8); PG8_WAIT_L(0); PG8_BAR; PG8_MMA(0, 0, At, B0); PG8_MMA(0, 1, At, B1); PG8_BAR; PG8_SCHED;
            PG8_LDA(At, 0, 1); PG8_STAGE(PG8_SB(0, 0), b2, voffB); PG8_STAGE(PG8_SB(0, 1), b2 + hstep, voffB); PG8_STAGE_A(PG8_SA(0, 0), a2, ka2, 0, last);
            PG8_WAIT_V(8); PG8_WAIT_L(0); PG8_BAR; PG8_MMA(1, 0, At, B0); PG8_MMA(1, 1, At, B1); PG8_BAR; PG8_SCHED;
            PG8_LDB(B0, 1, 0); PG8_LDB(B1, 1, 1); PG8_SCHED; PG8_LDA(At, 1, 0); PG8_STAGE_A(PG8_SA(0, 1), a2, ka2, 1, last);
            PG8_WAIT_V(8); PG8_WAIT_L(0); PG8_BAR; PG8_MMA(0, 0, At, B0); PG8_MMA(0, 1, At, B1); PG8_BAR; PG8_SCHED;
            PG8_LDA(At, 1, 1); PG8_STAGE(PG8_SB(1, 0), b3, voffB); PG8_STAGE(PG8_SB(1, 1), b3 + hstep, voffB); PG8_STAGE_A(PG8_SA(1, 0), a2, ka3, 0, last);
            PG8_WAIT_V(8); PG8_WAIT_L(0); PG8_BAR; PG8_MMA(1, 0, At, B0); PG8_MMA(1, 1, At, B1); PG8_BAR; PG8_SCHED;
        }
        if (wr == 0) PG8_BAR;
        if constexpr (Epi::META) E(acc, cur, wr, wc, fr, fq, lds + META_OFF + (ui & 1) * META_BYTES); else E(acc, cur, wr, wc, fr, fq);
        if (!has_next) break;
#pragma unroll
        for (int a = 0; a < 2; ++a)
#pragma unroll
            for (int b = 0; b < 2; ++b)
#pragma unroll
                for (int m = 0; m < 4; ++m)
#pragma unroll
                    for (int n = 0; n < 2; ++n) acc[a][b][m][n] = (f32x4){0.f, 0.f, 0.f, 0.f};
        cur = nxt; cA = nA; cB = nB; ++ui;
        if (wr == 1) PG8_BAR;
    }
    PG8_WAIT_V(0);
    PG8_BAR;
#undef PG8_SA
#undef PG8_SB
#undef PG8_STAGE
#undef PG8_STAGE_A
#undef PG8_LDA
#undef PG8_LDB
#undef PG8_MMA
#undef PG8_BF
#undef PG8_WAIT_V
#undef PG8_WAIT_L
#undef PG8_BAR
#undef PG8_SCHED
#undef PG8_GIDX
#undef PG8_GPOST
#undef PG8_GTAKE
}
}

namespace fox {
constexpr int D = 128, NW = 8, QBLK = 32, KVBLK = 64, QB = NW * QBLK;
constexpr int SHM_V = KVBLK * D * 2, SHM_K = KVBLK * D * 2;
constexpr int LDS_WS = 2 * SHM_V + 2 * SHM_K, LDS_FB = LDS_WS + NW * 64 * 4, LDS_BYTES = LDS_FB + 4096 * 4 + 64;
constexpr float SCALE = 0.08838834764831845f;
constexpr float THR = 8.f;
constexpr int LDQ = NPROJ;
#define KSWZ(row, colB) ((row) * 256 + ((colB) ^ (((row) & 7) << 4)))
__device__ __forceinline__ int v_st(int k, int c) { const int kk = (k & ~0xC) | ((k & 4) << 1) | ((k & 8) >> 1); return ((kk >> 3) * 4 + (c >> 5)) * 512 + ((kk & 7) * 32 + (c & 31)) * 2; }
__device__ __forceinline__ int v_rd_base(int lane) { return ((lane & 3) << 3) | (((lane >> 2) & 3) << 6) | (((lane >> 4) & 1) << 5) | (((lane >> 5) & 1) << 8); }
constexpr int v_rd_off(int d0, int ks, int half) { return d0 * 512 + ks * 4096 + half * 2048; }
__device__ __forceinline__ int crow(int r, int hi) { return (r & 3) + 8 * (r >> 2) + 4 * hi; }
__device__ __forceinline__ unsigned cvtpk(float lo, float hi) { return cvt_pk_bf16(lo, hi); }
__device__ __forceinline__ bf16x8 load8(const bf16_t* p) { return *reinterpret_cast<const bf16x8*>(p); }
__device__ __forceinline__ void mask_tile(f32x16& p0, f32x16& p1, int dq) {
    const float NEG = -__builtin_inff();
#pragma unroll
    for (int r = 0; r < 16; ++r) {
        const int c = (r & 3) + 8 * (r >> 2);
        if (dq - c < 0) p0[r] = NEG;
        if (dq - c - 32 < 0) p1[r] = NEG;
    }
}
__device__ __forceinline__ void partialSM(f32x16& p0, f32x16& p1, float& m_reg, float& mn, float& alpha) {
    float pmax = p0[0]; for (int r = 1; r < 16; ++r) pmax = fmaxf(pmax, p0[r]); for (int r = 0; r < 16; ++r) pmax = fmaxf(pmax, p1[r]);
    { auto rr = __builtin_amdgcn_permlane32_swap(__float_as_uint(pmax), __float_as_uint(pmax), false, false);
      pmax = fmaxf(__uint_as_float(rr[0]), __uint_as_float(rr[1])); }
    constexpr float C2 = 1.4426950408889634f * SCALE;
    if (__builtin_expect(__all((pmax - m_reg) * SCALE <= THR), 1)) { mn = m_reg; alpha = 1.f; }
    else { mn = fmaxf(m_reg, pmax); alpha = __builtin_amdgcn_exp2f((m_reg - mn) * C2); m_reg = mn; }
    const float mnL = -mn * C2;
    for (int r = 0; r < 16; ++r) p0[r] = fmaf(p0[r], C2, mnL); for (int r = 0; r < 16; ++r) p1[r] = fmaf(p1[r], C2, mnL);
    for (int r = 0; r < 16; ++r) p0[r] = __builtin_amdgcn_exp2f(p0[r]);
}
__device__ __forceinline__ void finishSM(f32x16& p0, f32x16& p1, float alpha, float& l_reg, bf16x8& pa0, bf16x8& pa1, bf16x8& pa2, bf16x8& pa3) {
    for (int r = 0; r < 16; ++r) p1[r] = __builtin_amdgcn_exp2f(p1[r]);
    float ps = 0; for (int r = 0; r < 16; ++r) ps += p0[r]; for (int r = 0; r < 16; ++r) ps += p1[r];
    { auto rr = __builtin_amdgcn_permlane32_swap(__float_as_uint(ps), __float_as_uint(ps), false, false);
      ps = __uint_as_float(rr[0]) + __uint_as_float(rr[1]); }
    l_reg = l_reg * alpha + ps;
#define PK4(P, B_, OUT) do { unsigned a0 = cvtpk(P[B_+0], P[B_+1]), a1 = cvtpk(P[B_+2], P[B_+3]);                          \
        unsigned b0 = cvtpk(P[B_+4], P[B_+5]), b1 = cvtpk(P[B_+6], P[B_+7]);                                             \
        auto r0 = __builtin_amdgcn_permlane32_swap(a0, b0, false, false); auto r1 = __builtin_amdgcn_permlane32_swap(a1, b1, false, false); \
        u32x4 w = {r0[0], r1[0], r0[1], r1[1]}; OUT = *reinterpret_cast<bf16x8*>(&w); } while (0)
    PK4(p0, 0, pa0); PK4(p0, 8, pa1); PK4(p1, 0, pa2); PK4(p1, 8, pa3);
#undef PK4
}
template <int KB>
__device__ __forceinline__ void qkt(f32x16& p0, f32x16& p1, const char* K_lds, const float* fb, int r32, int hi, const bf16x8* qr) {
#pragma unroll
    for (int g = 0; g < 4; ++g) { const f32x4 a = *(const f32x4*)(fb + 8 * g), b = *(const f32x4*)(fb + 32 + 8 * g);
        p0[4 * g] = a[0]; p0[4 * g + 1] = a[1]; p0[4 * g + 2] = a[2]; p0[4 * g + 3] = a[3];
        p1[4 * g] = b[0]; p1[4 * g + 1] = b[1]; p1[4 * g + 2] = b[2]; p1[4 * g + 3] = b[3]; }
    const char* kb[4];
#pragma unroll
    for (int dd = 0; dd < 4; ++dd) kb[dd] = K_lds + KB * SHM_K + KSWZ(r32, (dd * 16 + hi * 8) * 2);
#pragma unroll
    for (int d0 = 0; d0 < 8; ++d0) { const char* a = kb[d0 & 3] + (d0 >> 2) * 128;
        bf16x8 b0 = *reinterpret_cast<const bf16x8*>(a);
        bf16x8 b1 = *reinterpret_cast<const bf16x8*>(a + 32 * 256);
        p0 = __builtin_amdgcn_mfma_f32_32x32x16_bf16(b0, qr[d0], p0, 0, 0, 0);
        p1 = __builtin_amdgcn_mfma_f32_32x32x16_bf16(b1, qr[d0], p1, 0, 0, 0); }
}
template <int VB>
__device__ __forceinline__ void pv_tile(f32x16* o, int vb0, bf16x8 pa0, bf16x8 pa1, bf16x8 pa2, bf16x8 pa3) {
#define TRRD(dst, off) asm volatile("ds_read_b64_tr_b16 %0, %1 offset:%2" : "=&v"(dst) : "v"(vb0), "i"(off) : "memory")
#define PV_D0(d0) do { s16x4 l0, l1, l2, l3, h0, h1, h2, h3; constexpr int b_ = VB * SHM_V + v_rd_off(d0, 0, 0); \
        TRRD(l0, b_); TRRD(h0, b_ + 2048); TRRD(l1, b_ + 4096); TRRD(h1, b_ + 6144); TRRD(l2, b_ + 8192); TRRD(h2, b_ + 10240); TRRD(l3, b_ + 12288); TRRD(h3, b_ + 14336); \
        asm volatile("s_waitcnt lgkmcnt(0)" ::: "memory"); SBAR();   \
        o[d0] = __builtin_amdgcn_mfma_f32_32x32x16_bf16(pa0, (bf16x8){l0[0], l0[1], l0[2], l0[3], h0[0], h0[1], h0[2], h0[3]}, o[d0], 0, 0, 0);   \
        o[d0] = __builtin_amdgcn_mfma_f32_32x32x16_bf16(pa1, (bf16x8){l1[0], l1[1], l1[2], l1[3], h1[0], h1[1], h1[2], h1[3]}, o[d0], 0, 0, 0);   \
        o[d0] = __builtin_amdgcn_mfma_f32_32x32x16_bf16(pa2, (bf16x8){l2[0], l2[1], l2[2], l2[3], h2[0], h2[1], h2[2], h2[3]}, o[d0], 0, 0, 0);   \
        o[d0] = __builtin_amdgcn_mfma_f32_32x32x16_bf16(pa3, (bf16x8){l3[0], l3[1], l3[2], l3[3], h3[0], h3[1], h3[2], h3[3]}, o[d0], 0, 0, 0); } while (0)
    PV_D0(0); PV_D0(1); PV_D0(2); PV_D0(3);
#undef PV_D0
#undef TRRD
}
struct BlockRef { const bf16_t* Q; const bf16_t* K; const bf16_t* V; int P0, j_lo, j_hi; };
struct Seam { bf16x8 qr[8]; bf16x8 st_v0, st_v1, st_k0, st_k1; };
#define ROW(p, k0, rr) ((p) + (size_t)((k0) + (rr)) * LDQ + sc)
#define VMWN(n) asm volatile("s_waitcnt vmcnt(%0)" :: "i"(n) : "memory")
#define SLOAD_H(Kp, Vp, k0) do { S.st_v0 = load8(ROW(Vp, k0, sr)); S.st_v1 = load8(ROW(Vp, k0, 32 + sr)); S.st_k0 = load8(ROW(Kp, k0, sr)); S.st_k1 = load8(ROW(Kp, k0, 32 + sr)); } while (0)
#define SWRITE_HK(bf) do { *(bf16x8*)(K_lds + (bf) * SHM_K + kws) = S.st_k0; *(bf16x8*)(K_lds + (bf) * SHM_K + kws + 32 * 256) = S.st_k1; } while (0)
#define SWRITE_HV(bf) do { *(bf16x8*)(V_lds + (bf) * SHM_V + vst0) = S.st_v0; *(bf16x8*)(V_lds + (bf) * SHM_V + vst1) = S.st_v1; } while (0)
#define SWRITE_H(bf) do { SWRITE_HV(bf); SWRITE_HK(bf); } while (0)
__device__ __forceinline__ void prime(const BlockRef& cur, char* lds, Seam& S) {
    const int tid = threadIdx.x, wid = __builtin_amdgcn_readfirstlane(tid >> 6), lane = tid & 63, r32 = lane & 31, hi = lane >> 5;
    const int sr = tid >> 4, sc = (tid & 15) * 8, kws = KSWZ(sr, sc * 2); char* K_lds = lds + 2 * SHM_V;
    const int kb0 = cur.j_lo * KVBLK;
    for (int d0 = 0; d0 < 8; ++d0) S.qr[d0] = load8(cur.Q + (size_t)(wid * QBLK + r32) * LDQ + d0 * 16 + hi * 8);
    SLOAD_H(cur.K, cur.V, kb0); VM_WAIT(); SWRITE_HK(0);
    __syncthreads();
}
template <class Epi>
__device__ __forceinline__ void block(const BlockRef& cur, const BlockRef& nxt, char* lds, Seam& S, const Epi& E) {
    const int tid = threadIdx.x, wid = __builtin_amdgcn_readfirstlane(tid >> 6), lane = tid & 63, r32 = lane & 31, hi = lane >> 5;
    const int j_lo = cur.j_lo, j_hi = cur.j_hi;
    const int NT = j_hi - j_lo;
    const int kbn = nxt.j_lo * KVBLK;
    const int qlo = cur.P0 + wid * QBLK, qm = qlo + r32 - 4 * hi;
    char* V_lds = lds; char* K_lds = lds + 2 * SHM_V;
    float* ws = (float*)(lds + LDS_WS) + wid * 64; float* li_l = ws, * al_l = ws + 32;
    const float* FB = (const float*)(lds + LDS_FB) + 4 * hi;
    float m_reg = -1e30f, l_reg = 0; f32x16 o[4] = {};
    const int sr = tid >> 4, sc = (tid & 15) * 8, vst0 = v_st(sr, sc), vst1 = v_st(32 + sr, sc), kws = KSWZ(sr, sc * 2);
    const int vb0 = (int)(uintptr_t)V_lds + v_rd_base(lane);
    const bf16_t* Kh = cur.K; const bf16_t* Vh = cur.V;
#define RESC(a) do { if (__any((a) < 1.f)) { if (hi == 0) al_l[r32] = (a); asm volatile("s_waitcnt lgkmcnt(0)" ::: "memory");              \
                     for (int d_ = 0; d_ < 4; ++d_) for (int r = 0; r < 16; ++r) o[d_][r] *= al_l[crow(r, hi)]; } } while (0)
#define KBASE(t) ((j_lo + (t)) * KVBLK)
#define MASKT(P0_, P1_, t) do { const int kb_ = KBASE(t); if (kb_ + KVBLK - 1 > qlo) mask_tile(P0_, P1_, qm - kb_); } while (0)
    constexpr int NQL = 8;
#define SEAM_K0() do { VMWN(NQL); SWRITE_HK(0); SBAR(); } while (0)
    f32x16 pA0, pA1, pB0, pB1; float mnA, mnB, alA, alB; bf16x8 pa0, pa1, pa2, pa3;
    SWRITE_HV(0); SBAR();
    if (NT > 1) { SLOAD_H(Kh, Vh, KBASE(1)); }
    SBAR(); qkt<0>(pA0, pA1, K_lds, FB + KBASE(0), r32, hi, S.qr);
    MASKT(pA0, pA1, 0); partialSM(pA0, pA1, m_reg, mnA, alA);
    if (NT > 1) { VM_WAIT(); SWRITE_H(1); }
    __syncthreads();
#define HALF_STEP(PX0, PX1, mnX, alX, PY0, PY1, alY, t, KB, VB, SB) do {                                                      \
        SBAR(); qkt<KB>(PX0, PX1, K_lds, FB + KBASE(t), r32, hi, S.qr);                                                      \
        finishSM(PY0, PY1, alY, l_reg, pa0, pa1, pa2, pa3); SBAR();                                                           \
        if ((t) + 1 < NT) { SLOAD_H(Kh, Vh, KBASE((t) + 1)); SBAR(); }                                                       \
        pv_tile<VB>(o, vb0, pa0, pa1, pa2, pa3); MASKT(PX0, PX1, (t)); partialSM(PX0, PX1, m_reg, mnX, alX);                  \
        __syncthreads();                                                                                                      \
        if ((t) + 1 < NT) { VM_WAIT(); SWRITE_H(SB); }                                                                        \
        RESC(alX); __syncthreads(); } while (0)
    for (int t = 1; t + 1 < NT; t += 2) {
        HALF_STEP(pB0, pB1, mnB, alB, pA0, pA1, alA, t, 1, 0, 0);
        HALF_STEP(pA0, pA1, mnA, alA, pB0, pB1, alB, t + 1, 0, 1, 1);
    }
    const bool even = (NT & 1) == 0;
    if (even) { SBAR(); qkt<1>(pB0, pB1, K_lds, FB + KBASE(NT - 1), r32, hi, S.qr); SBAR(); }
    SLOAD_H(nxt.K, nxt.V, kbn); SBAR();
#pragma unroll
    for (int d0 = 0; d0 < 8; ++d0) S.qr[d0] = load8(nxt.Q + (size_t)(wid * QBLK + r32) * LDQ + d0 * 16 + hi * 8);
    SBAR();
    finishSM(pA0, pA1, alA, l_reg, pa0, pa1, pa2, pa3); SBAR();
    pv_tile<0>(o, vb0, pa0, pa1, pa2, pa3);
    if (even) { MASKT(pB0, pB1, NT - 1); partialSM(pB0, pB1, m_reg, mnB, alB); __syncthreads(); RESC(alB);
        finishSM(pB0, pB1, alB, l_reg, pa0, pa1, pa2, pa3); SBAR(); pv_tile<1>(o, vb0, pa0, pa1, pa2, pa3); }
    SBAR(); SEAM_K0();
    if (hi == 0) li_l[r32] = l_reg; asm volatile("s_waitcnt lgkmcnt(0)" ::: "memory");
    E(o, li_l, m_reg, cur.P0 + wid * QBLK, r32, hi);
    __syncthreads();
#undef RESC
#undef KBASE
#undef MASKT
#undef SEAM_K0
#undef HALF_STEP
}
#undef ROW
#undef VMWN
#undef SLOAD_H
#undef SWRITE_HK
#undef SWRITE_HV
#undef SWRITE_H
struct EpiNormBf16 {
    bf16_t* out; int ldo; const float* gain;
    __device__ __forceinline__ void operator()(const f32x16* o, const float* li_l, float  , int row0, int r32, int hi) const {
        const float g0 = gain[r32], g1 = gain[32 + r32], g2 = gain[64 + r32], g3 = gain[96 + r32];
#pragma unroll
        for (int r = 0; r < 16; ++r) { const int orow = crow(r, hi); const float rl = __builtin_amdgcn_rcpf(li_l[orow]);
            const float v0 = o[0][r] * rl, v1 = o[1][r] * rl, v2 = o[2][r] * rl, v3 = o[3][r] * rl;
            float ss = (v0 * v0 + v1 * v1) + (v2 * v2 + v3 * v3);
            ss += __shfl_xor(ss, 1); ss += __shfl_xor(ss, 2); ss += __shfl_xor(ss, 4); ss += __shfl_xor(ss, 8); ss += __shfl_xor(ss, 16);
            const float rs = 1.0f / sqrtf(ss * (1.0f / 128.0f) + EPS);
            u32x2 w; w.x = cvtpk(v0 * rs * g0, v1 * rs * g1); w.y = cvtpk(v2 * rs * g2, v3 * rs * g3);
            *(u32x2*)(out + (size_t)(row0 + orow) * ldo + r32 * 4) = w; }
    }
};
struct EpiPartial {
    float* O; float* ML;
    __device__ __forceinline__ void operator()(const f32x16* o, const float* li_l, float m, int row0, int r32, int hi) const {
#pragma unroll
        for (int r = 0; r < 16; ++r) { const int orow = crow(r, hi); u32x2 w; w.x = cvtpk(o[0][r], o[1][r]); w.y = cvtpk(o[2][r], o[3][r]); *(u32x2*)((bf16_t*)O + (size_t)(row0 + orow) * 512 + r32 * 4) = w; }
        if (hi == 0) *(f32x2*)(ML + (size_t)(row0 + r32) * 8) = (f32x2){m, li_l[r32]};
    }
};
}

constexpr size_t MiB = 1u << 20;
constexpr size_t WS_CTL = 0, CTL_ZERO_BYTES = 65536;
constexpr size_t WS_WSM = 1 * MiB;
constexpr size_t WS_RSTD = 2 * MiB;
constexpr size_t WS_SMALL = 3 * MiB;
constexpr size_t WS_GATE = 5 * MiB;
constexpr size_t WS_ROWLIST = 6 * MiB;
constexpr size_t WS_WMKV = 8 * MiB, WS_WOUT = 12 * MiB, WS_WIN = 20 * MiB;
constexpr size_t WS_MEMB = 40 * MiB;
constexpr size_t WS_KVM = 44 * MiB;
constexpr size_t WS_GLAD = 46 * MiB;
constexpr size_t WS_XB = 48 * MiB;
constexpr size_t WS_PROJ = 112 * MiB;
constexpr size_t WS_MIX = 272 * MiB;
constexpr size_t WS_X1 = 336 * MiB;
constexpr size_t WS_X1B = 464 * MiB;
constexpr size_t WS_GLAKV = 528 * MiB;
constexpr size_t WS_GLAO = 656 * MiB;
constexpr size_t WS_WUP = 720 * MiB;
constexpr size_t WS_WDOWN = 1232 * MiB;
constexpr size_t WS_ACT = 1488 * MiB;
constexpr size_t WS_Y = 1776 * MiB;
constexpr size_t WS_IDENT = 5 * MiB + 512 * 1024;
constexpr size_t WS_LA = 2032 * MiB;
constexpr size_t WS_FOXO = 2064 * MiB;
constexpr size_t WS_FOXML = 2192 * MiB;
constexpr size_t WS_ROWGATE = 2194 * MiB, WS_ROWRSTD = 2196 * MiB;
constexpr size_t WS_END = 2198 * MiB;
constexpr int CW_BAR = 4096;
constexpr int CW_CNT = 8192;

constexpr int RING_BYTES = 131072;
constexpr int TAB_OFF = RING_BYTES;
constexpr int MISC_OFF = 147456;
constexpr int LDS_BYTES = 147456 + 1024 + 8192;

#define XB_TMO      128
#define XB_XCNT(j)  (256  + 64 * (j))
#define XB_XSUB(j)  (1280 + 64 * (j))
#define XB_XGEN(j)  (2304 + 64 * (j))
#define XB_TOP      3328
#define XB_TOPGEN   3392
#define XCD_BAR_WORDS 3456
#define XB_SPIN_CAP (1u << 18)
__device__ __forceinline__ unsigned xb_ld(unsigned* p)              { return __hip_atomic_load(p, __ATOMIC_RELAXED, __HIP_MEMORY_SCOPE_AGENT); }
__device__ __forceinline__ unsigned xb_add(unsigned* p, unsigned v) { return __hip_atomic_fetch_add(p, v, __ATOMIC_RELAXED, __HIP_MEMORY_SCOPE_AGENT); }
__device__ __forceinline__ unsigned xb_xcc_id() { return (unsigned)__builtin_amdgcn_s_getreg((3 << 11) | 20) & 0xFu; }
#define XB_SPIN(cond, bar) do { unsigned _sp = 0; while (cond) { __builtin_amdgcn_s_sleep(1); \
    if ((++_sp & 255u) == 0u) { if (xb_ld(&(bar)[XB_TMO])) break; if (_sp > XB_SPIN_CAP) { atomicAdd(&(bar)[XB_TMO], 1u); break; } } } } while (0)
struct XcdBarrier { unsigned* bar; unsigned x; volatile LAS unsigned* st; };
__device__ __forceinline__ XcdBarrier xcd_barrier_post(unsigned* bar, volatile LAS unsigned* st) {
    XcdBarrier b; b.bar = bar; b.x = xb_xcc_id(); b.st = st;
    if (threadIdx.x == 0) (void)xb_add(&bar[XB_XCNT(b.x)], 1u);
    return b;
}
__device__ __forceinline__ void xcd_barrier_complete(unsigned* bar, unsigned x, unsigned& nloc, unsigned& nx) {
    const unsigned G = gridDim.x * gridDim.y * gridDim.z;
    unsigned sum, cnt, mine, sp = 0u;
    for (;;) {
        sum = 0u; cnt = 0u; mine = 0u;
#pragma unroll
        for (unsigned j = 0; j < 16; ++j) { const unsigned c = xb_ld(&bar[XB_XCNT(j)]); sum += c; cnt += (c > 0u) ? 1u : 0u; mine = (j == x) ? c : mine; }
        if (sum == G) break;
        __builtin_amdgcn_s_sleep(1);
        if ((++sp & 255u) == 0u) { if (xb_ld(&bar[XB_TMO])) break; if (sp > XB_SPIN_CAP) { atomicAdd(&bar[XB_TMO], 1u); break; } }
    }
    nloc = mine > 0u ? mine : 1u; nx = cnt > 0u ? cnt : 1u;
}
__device__ __forceinline__ void xcd_barrier(const XcdBarrier& b) {
    asm volatile("s_waitcnt vmcnt(0)" ::: "memory");
    __syncthreads();
    if (threadIdx.x == 0) {
        unsigned* bar = b.bar;
        __builtin_amdgcn_s_waitcnt(0);
        unsigned nloc = b.st[0], nx = b.st[1];
        if (nloc == 0u) { xcd_barrier_complete(bar, b.x, nloc, nx); b.st[0] = nloc; b.st[1] = nx; }
        const unsigned old = xb_add(&bar[XB_XSUB(b.x)], 1u);
        const unsigned gen = old / nloc;
        if (old + 1u == (gen + 1u) * nloc) {
            __builtin_amdgcn_fence(__ATOMIC_RELEASE, "agent");
            asm volatile("s_waitcnt vmcnt(0)" ::: "memory");
            const unsigned og = xb_add(&bar[XB_TOP], 1u);
            const unsigned tg = og / nx;
            if (og + 1u == (tg + 1u) * nx) xb_add(&bar[XB_TOPGEN], 1u);
            else XB_SPIN(xb_ld(&bar[XB_TOPGEN]) == tg, bar);
            __builtin_amdgcn_fence(__ATOMIC_ACQUIRE, "agent");
            xb_add(&bar[XB_XGEN(b.x)], 1u);
            asm volatile("s_waitcnt vmcnt(0)" ::: "memory");
        } else {
            XB_SPIN(xb_ld(&bar[XB_XGEN(b.x)]) == gen, bar);
            __builtin_amdgcn_fence(__ATOMIC_ACQUIRE, "agent");
            asm volatile("s_waitcnt vmcnt(0)" ::: "memory");
        }
    }
    __syncthreads();
}

__device__ __forceinline__ unsigned f2bf(float f) { unsigned u = __builtin_bit_cast(unsigned, f); return (u + 0x7fffu + ((u >> 16) & 1u)) >> 16; }
__device__ __forceinline__ unsigned pk2(float lo, float hi) { return f2bf(lo) | (f2bf(hi) << 16); }
__device__ __forceinline__ int head_perm(int x) { return (x & 3) * 32 + (x >> 2); }
template <bool KPERM>
__device__ __forceinline__ void transpose_item(const float* W, size_t ldw, int k0, int scol0, bf16_t* WT, int K, const float* g, float cs, LAS float* scr, int lane) {
#pragma unroll 16
    for (int i = 0; i < 32; ++i) { const int kk = 2 * i + (lane >> 5); int sk = k0 + kk; if (KPERM) sk = (sk & ~127) + head_perm(sk & 127);
        float v = W[(size_t)sk * ldw + scol0 + (lane & 31)]; if (g) v *= g[sk]; scr[kk * 33 + (lane & 31)] = v * cs; }
    LDS_WAIT(); asm volatile("" ::: "memory");
    const int c = lane & 7;
#pragma unroll
    for (int j = 0; j < 4; ++j) { const int n = (lane >> 3) + 8 * j; const LAS float* s = scr + (8 * c) * 33 + n;
        u32x4 o; o.x = pk2(s[0 * 33], s[1 * 33]); o.y = pk2(s[2 * 33], s[3 * 33]); o.z = pk2(s[4 * 33], s[5 * 33]); o.w = pk2(s[6 * 33], s[7 * 33]);
        *(GAS u32x4*)(WT + (size_t)n * K + k0 + 8 * c) = o; }
    LDS_WAIT(); asm volatile("" ::: "memory");
}
template <bool KPERM>
__device__ __forceinline__ void tr_item(const float* W, size_t ldw, int k0, int scol0, bf16_t* WT, int K, const float* g, float cs, LAS unsigned char* scr, int lane) {
    const int kr = lane >> 5, c4 = lane & 31;
    f32x4 a[16], b[16]; float ga[16], gb[16];
#pragma unroll
    for (int i = 0; i < 16; ++i) { int sa = k0 + 4 * i + 2 * kr, sb = sa + 1; if (KPERM) { sa = (sa & ~127) + head_perm(sa & 127); sb = (sb & ~127) + head_perm(sb & 127); }
        a[i] = *(const f32x4*)(W + (size_t)sa * ldw + scol0 + c4 * 4); b[i] = *(const f32x4*)(W + (size_t)sb * ldw + scol0 + c4 * 4);
        ga[i] = g ? g[sa] * cs : cs; gb[i] = g ? g[sb] * cs : cs; }
#pragma unroll
    for (int i = 0; i < 16; ++i) {
#pragma unroll
        for (int j = 0; j < 4; ++j) *(LAS unsigned*)(scr + (4 * c4 + j) * 144 + (2 * i + kr) * 4) = cvt_pk_bf16(a[i][j] * ga[i], b[i][j] * gb[i]); }
    LDS_WAIT(); asm volatile("" ::: "memory");
    const int q = lane & 7;
#pragma unroll
    for (int t = 0; t < 16; ++t) { const int n = 8 * t + (lane >> 3); const u32x4 v = *(const LAS u32x4*)(scr + n * 144 + q * 16);
        *(GAS u32x4*)(WT + (size_t)n * K + k0 + 8 * q) = v; }
    LDS_WAIT(); asm volatile("" ::: "memory");
}
__device__ __forceinline__ void tr_item_fp8(const float* W, size_t ldw, int k0, int scol0, unsigned char* WT, int K, const float* g, float cs, LAS unsigned char* scr, int lane) {
    const int kr = lane >> 4, c4 = lane & 15;
    const float* wl = W + (size_t)(4 * kr) * ldw + scol0 + c4 * 4;
    f32x4 a[8][4]; f32x4 gs[8];
#pragma unroll
    for (int i = 0; i < 8; ++i) {
#pragma unroll
        for (int t = 0; t < 4; ++t) a[i][t] = __builtin_nontemporal_load((const f32x4*)(wl + (size_t)(k0 + 16 * i + t) * ldw));
        gs[i] = g ? *(const f32x4*)(g + k0 + 16 * i + 4 * kr) * cs : (f32x4){cs, cs, cs, cs}; }
#pragma unroll
    for (int i = 0; i < 8; ++i)
#pragma unroll
        for (int j = 0; j < 4; ++j) *(LAS unsigned*)(scr + (4 * c4 + j) * 144 + (4 * i + kr) * 4) = pk_fp8x4(a[i][0][j] * gs[i][0], a[i][1][j] * gs[i][1], a[i][2][j] * gs[i][2], a[i][3][j] * gs[i][3]);
    LDS_WAIT(); asm volatile("" ::: "memory");
    const int q = lane & 7;
#pragma unroll
    for (int t = 0; t < 8; ++t) { const int n = 8 * t + (lane >> 3); const u32x4 v = *(const LAS u32x4*)(scr + n * 144 + q * 16);
        __builtin_nontemporal_store(v, (u32x4*)(WT + (size_t)n * K + k0 + 16 * q)); }
    LDS_WAIT(); asm volatile("" ::: "memory");
}
__device__ __forceinline__ void thin_item(int which, const float* W, const float* g, int k0, bf16_t* hi, bf16_t* lo, LAS float* scr, int lane) {
#pragma unroll 8
    for (int i = 0; i < 32; ++i) { const int kk = 2 * i + (lane >> 5), n = lane & 31, sk = k0 + kk; float v = 0.f;
        if (which == 0) { if (n < 16) v = W[(size_t)sk * 5140 + 3072 + n]; else if (n < 20) v = W[(size_t)sk * 5140 + 4624 + (n - 16)]; }
        else v = W[(size_t)sk * 32 + n];
        scr[kk * 33 + n] = v * g[sk]; }
    LDS_WAIT(); asm volatile("" ::: "memory");
    const int c = lane & 7;
#pragma unroll
    for (int j = 0; j < 4; ++j) { const int n = (lane >> 3) + 8 * j; const LAS float* s = scr + (8 * c) * 33 + n; float v[8], l[8];
#pragma unroll
        for (int t = 0; t < 8; ++t) { v[t] = s[t * 33]; l[t] = v[t] - __uint_as_float(f2bf(v[t]) << 16); }
        u32x4 o; o.x = pk2(v[0], v[1]); o.y = pk2(v[2], v[3]); o.z = pk2(v[4], v[5]); o.w = pk2(v[6], v[7]);
        *(GAS u32x4*)(hi + (size_t)n * 2048 + k0 + 8 * c) = o;
        o.x = pk2(l[0], l[1]); o.y = pk2(l[2], l[3]); o.z = pk2(l[4], l[5]); o.w = pk2(l[6], l[7]);
        *(GAS u32x4*)(lo + (size_t)n * 2048 + k0 + 8 * c) = o; }
    LDS_WAIT(); asm volatile("" ::: "memory");
}
__device__ __forceinline__ f32x4 bf_up4(bf16x8 h, int half) {
    f32x4 r;
#pragma unroll
    for (int j = 0; j < 4; ++j) r[j] = __uint_as_float(((unsigned)(unsigned short)h[4 * half + j]) << 16);
    return r;
}
template <int NT, bool Q8 = false>
__device__ __forceinline__ void rowpass16(const float* X, int row0, bf16_t* XB, const bf16_t* WT_hi, const bf16_t* WT_lo, f32x4 (&acc)[2], float& rstd_r, int lane) {
    const int r = lane & 15, q = lane >> 4;
    const float* xp = X + (size_t)(row0 + r) * DM + q * 16;
    bf16_t* xo = XB + (size_t)(row0 + r) * DM + q * 16;
    float ss = 0.f; acc[0] = (f32x4){0.f, 0.f, 0.f, 0.f}; acc[1] = acc[0];
#pragma unroll 2
    for (int kb = 0; kb < 32; ++kb) {
        const f32x4 v0 = *(const f32x4*)(xp + kb * 64), v1 = *(const f32x4*)(xp + kb * 64 + 4), v2 = *(const f32x4*)(xp + kb * 64 + 8), v3 = *(const f32x4*)(xp + kb * 64 + 12);
        ss += (v0[0] * v0[0] + v0[1] * v0[1]) + (v0[2] * v0[2] + v0[3] * v0[3]) + (v1[0] * v1[0] + v1[1] * v1[1]) + (v1[2] * v1[2] + v1[3] * v1[3]);
        ss += (v2[0] * v2[0] + v2[1] * v2[1]) + (v2[2] * v2[2] + v2[3] * v2[3]) + (v3[0] * v3[0] + v3[1] * v3[1]) + (v3[2] * v3[2] + v3[3] * v3[3]);
        const bf16x8 h0 = pack8(v0, v1), h1 = pack8(v2, v3);
        if constexpr (Q8) { u32x4 w8 = {pk_fp8x4(v0[0], v0[1], v0[2], v0[3]), pk_fp8x4(v1[0], v1[1], v1[2], v1[3]), pk_fp8x4(v2[0], v2[1], v2[2], v2[3]), pk_fp8x4(v3[0], v3[1], v3[2], v3[3])};
            *(u32x4*)((unsigned char*)XB + (size_t)(row0 + r) * DM + q * 16 + kb * 64) = w8; }
        else { *(bf16x8*)(xo + kb * 64) = h0; *(bf16x8*)(xo + kb * 64 + 8) = h1; }
        if constexpr (NT > 0) {
            const bf16x8 l0 = pack8(v0 - bf_up4(h0, 0), v1 - bf_up4(h0, 1)), l1 = pack8(v2 - bf_up4(h1, 0), v3 - bf_up4(h1, 1));
#pragma unroll
            for (int nt = 0; nt < NT; ++nt) {
                const bf16_t* wh = WT_hi + (size_t)(nt * 16 + r) * DM + kb * 64 + q * 16; const bf16_t* wl = WT_lo + (size_t)(nt * 16 + r) * DM + kb * 64 + q * 16;
                const bf16x8 bh0 = *(const bf16x8*)wh, bh1 = *(const bf16x8*)(wh + 8), bl0 = *(const bf16x8*)wl, bl1 = *(const bf16x8*)(wl + 8);
                acc[nt] = __builtin_amdgcn_mfma_f32_16x16x32_bf16(h0, bh0, acc[nt], 0, 0, 0); acc[nt] = __builtin_amdgcn_mfma_f32_16x16x32_bf16(l0, bh0, acc[nt], 0, 0, 0);
                acc[nt] = __builtin_amdgcn_mfma_f32_16x16x32_bf16(h0, bl0, acc[nt], 0, 0, 0);
                acc[nt] = __builtin_amdgcn_mfma_f32_16x16x32_bf16(h1, bh1, acc[nt], 0, 0, 0); acc[nt] = __builtin_amdgcn_mfma_f32_16x16x32_bf16(l1, bh1, acc[nt], 0, 0, 0);
                acc[nt] = __builtin_amdgcn_mfma_f32_16x16x32_bf16(h1, bl1, acc[nt], 0, 0, 0);
            }
        }
    }
    ss += __shfl_xor(ss, 16); ss += __shfl_xor(ss, 32);
    rstd_r = 1.0f / sqrtf(ss * (1.0f / DM) + EPS);
}

template <bool Q8>
__device__ __forceinline__ void rowpass_wg(const float* X, int row0, bf16_t* XB, const bf16_t* WT_hi, const bf16_t* WT_lo, f32x4 (&acc)[2], float& rstd_r, LAS unsigned char* wlds) {
    const int tid = threadIdx.x, lane = tid & 63, wave = __builtin_amdgcn_readfirstlane(tid >> 6), r = lane & 15, q = lane >> 4;
    const int rw = row0 + 16 * wave;
    const float* xp = X + (size_t)(rw + r) * DM + q * 16;
    bf16_t* xo = XB + (size_t)(rw + r) * DM + q * 16;
    float ss = 0.f; acc[0] = (f32x4){0.f, 0.f, 0.f, 0.f}; acc[1] = acc[0];
    f32x4 xa[4][4], xbuf[4][4]; u32x4 wst[4];
#define RW_LOADX(dst, c) do { _Pragma("unroll") for (int k4 = 0; k4 < 4; ++k4) _Pragma("unroll") for (int j = 0; j < 4; ++j) dst[k4][j] = *(const f32x4*)(xp + ((c) * 4 + k4) * 64 + 4 * j); } while (0)
#define RW_LOADW(c) do { _Pragma("unroll") for (int i = 0; i < 4; ++i) { const int p = tid + 512 * i, pp = p & 1023; const bf16_t* src = ((p >> 10) ? WT_lo : WT_hi) + (size_t)(pp >> 5) * DM + (c) * 256 + (pp & 31) * 8; \
        wst[i] = *(const u32x4*)src; } } while (0)
#define RW_STOREW() do { _Pragma("unroll") for (int i = 0; i < 4; ++i) { const int p = tid + 512 * i, pp = p & 1023; *(LAS u32x4*)(wlds + (p >> 10) * 16896 + (pp >> 5) * 528 + (pp & 31) * 16) = wst[i]; } } while (0)
#define RW_USE(src, c) do { _Pragma("unroll") for (int k4 = 0; k4 < 4; ++k4) { asm volatile("" ::: "memory"); const int kb = (c) * 4 + k4; const f32x4 v0 = src[k4][0], v1 = src[k4][1], v2 = src[k4][2], v3 = src[k4][3]; \
        ss += (v0[0] * v0[0] + v0[1] * v0[1]) + (v0[2] * v0[2] + v0[3] * v0[3]) + (v1[0] * v1[0] + v1[1] * v1[1]) + (v1[2] * v1[2] + v1[3] * v1[3]); \
        ss += (v2[0] * v2[0] + v2[1] * v2[1]) + (v2[2] * v2[2] + v2[3] * v2[3]) + (v3[0] * v3[0] + v3[1] * v3[1]) + (v3[2] * v3[2] + v3[3] * v3[3]); \
        const bf16x8 h0 = pack8_raw(v0, v1), h1 = pack8_raw(v2, v3); \
        if constexpr (Q8) { u32x4 w8 = {pk_fp8x4(v0[0], v0[1], v0[2], v0[3]), pk_fp8x4(v1[0], v1[1], v1[2], v1[3]), pk_fp8x4(v2[0], v2[1], v2[2], v2[3]), pk_fp8x4(v3[0], v3[1], v3[2], v3[3])}; \
            *(u32x4*)((unsigned char*)XB + (size_t)(rw + r) * DM + q * 16 + kb * 64) = w8; } \
        else { *(bf16x8*)(xo + kb * 64) = h0; *(bf16x8*)(xo + kb * 64 + 8) = h1; } \
        const bf16x8 l0 = pack8_raw(v0 - bf_up4(h0, 0), v1 - bf_up4(h0, 1)), l1 = pack8_raw(v2 - bf_up4(h1, 0), v3 - bf_up4(h1, 1)); \
        _Pragma("unroll") for (int nt = 0; nt < 2; ++nt) { const LAS unsigned char* wp = wlds + (nt * 16 + r) * 528 + (k4 * 64 + q * 16) * 2; \
            const bf16x8 bh0 = *(const LAS bf16x8*)wp, bh1 = *(const LAS bf16x8*)(wp + 16), bl0 = *(const LAS bf16x8*)(wp + 16896), bl1 = *(const LAS bf16x8*)(wp + 16896 + 16); \
            acc[nt] = __builtin_amdgcn_mfma_f32_16x16x32_bf16(h0, bh0, acc[nt], 0, 0, 0); acc[nt] = __builtin_amdgcn_mfma_f32_16x16x32_bf16(l0, bh0, acc[nt], 0, 0, 0); \
            acc[nt] = __builtin_amdgcn_mfma_f32_16x16x32_bf16(h0, bl0, acc[nt], 0, 0, 0); \
            acc[nt] = __builtin_amdgcn_mfma_f32_16x16x32_bf16(h1, bh1, acc[nt], 0, 0, 0); acc[nt] = __builtin_amdgcn_mfma_f32_16x16x32_bf16(l1, bh1, acc[nt], 0, 0, 0); \
            acc[nt] = __builtin_amdgcn_mfma_f32_16x16x32_bf16(h1, bl1, acc[nt], 0, 0, 0); } } } while (0)
    RW_LOADX(xa, 0);
#pragma unroll 1
    for (int c = 0; c < 8; c += 2) {
        RW_LOADW(c); RW_LOADX(xbuf, c + 1);
        __syncthreads(); RW_STOREW(); LDS_WAIT(); __syncthreads();
        RW_USE(xa, c);
        RW_LOADW(c + 1); if (c + 2 < 8) RW_LOADX(xa, c + 2);
        __syncthreads(); RW_STOREW(); LDS_WAIT(); __syncthreads();
        RW_USE(xbuf, c + 1);
    }
#undef RW_LOADX
#undef RW_LOADW
#undef RW_STOREW
#undef RW_USE
    ss += __shfl_xor(ss, 16); ss += __shfl_xor(ss, 32);
    rstd_r = 1.0f / sqrtf(ss * (1.0f / DM) + EPS);
    __syncthreads();
}

namespace pg8 {
struct EpiRowScaleBf16 {
    static constexpr bool PERM = true, META = false;
    bf16_t* O; int ldc; const float* rowscale;
    __device__ __forceinline__ void operator()(const f32x4 (&acc)[2][2][4][2], const Unit& u, int wr, int wc, int fr, int fq) const {
        const int row0 = u.pm * BM + wr * 64 + fr, col0 = u.pn * BM + wc * 32 + 8 * fq;
        float sc[2][4];
#pragma unroll
        for (int ai = 0; ai < 2; ++ai)
#pragma unroll
            for (int m = 0; m < 4; ++m) sc[ai][m] = rowscale[row0 + ai * HALF + m * 16];
        asm volatile("" : "+v"(sc[0][0]), "+v"(sc[0][1]), "+v"(sc[0][2]), "+v"(sc[0][3]), "+v"(sc[1][0]), "+v"(sc[1][1]), "+v"(sc[1][2]), "+v"(sc[1][3]));
#pragma unroll
        for (int ai = 0; ai < 2; ++ai)
#pragma unroll
            for (int m = 0; m < 4; ++m) { const int row = row0 + ai * HALF + m * 16; const float s = sc[ai][m]; bf16_t* rowp = O + (size_t)row * ldc + col0;
#pragma unroll
                for (int bj = 0; bj < 2; ++bj) { const f32x4 v0 = acc[ai][bj][m][0] * s, v1 = acc[ai][bj][m][1] * s;
                    u32x4 w; w.x = cvt_pk_bf16(v0[0], v0[1]); w.y = cvt_pk_bf16(v0[2], v0[3]); w.z = cvt_pk_bf16(v1[0], v1[1]); w.w = cvt_pk_bf16(v1[2], v1[3]);
                    *(u32x4*)(rowp + bj * HALF) = w; } }
    }
};
struct EpiResF32 {
    static constexpr bool PERM = false, META = false;
    const float* base; float* C; int ldc;
    __device__ __forceinline__ void operator()(const f32x4 (&acc)[2][2][4][2], const Unit& u, int wr, int wc, int fr, int fq) const {
        const int row0 = u.pm * BM + wr * 64 + fr, col0 = u.pn * BM + wc * 32 + 4 * fq;
#pragma unroll
        for (int ai = 0; ai < 2; ++ai) { f32x4 bs[4][2][2];
#pragma unroll
            for (int m = 0; m < 4; ++m)
#pragma unroll
                for (int bj = 0; bj < 2; ++bj)
#pragma unroll
                    for (int n = 0; n < 2; ++n) bs[m][bj][n] = *(const f32x4*)(base + (size_t)(row0 + ai * HALF + m * 16) * ldc + col0 + bj * HALF + n * 16);
#pragma unroll
            for (int m = 0; m < 4; ++m) asm volatile("" : "+v"(bs[m][0][0]), "+v"(bs[m][0][1]), "+v"(bs[m][1][0]), "+v"(bs[m][1][1]));
#pragma unroll
            for (int m = 0; m < 4; ++m)
#pragma unroll
                for (int bj = 0; bj < 2; ++bj)
#pragma unroll
                    for (int n = 0; n < 2; ++n) *(f32x4*)(C + (size_t)(row0 + ai * HALF + m * 16) * ldc + col0 + bj * HALF + n * 16) = bs[m][bj][n] + acc[ai][bj][m][n]; }
    }
};
struct EpiMoeUp {
    static constexpr bool PERM = true, META = false;
    bf16_t* ACT; const float* rstd; const float* bias;
    __device__ __forceinline__ void operator()(const f32x4 (&acc)[2][2][4][2], const Unit& u, int wr, int wc, int fr, int fq) const {
        asm volatile("" : "+v"(fr), "+v"(fq));
        const int j0 = u.pn * HALF + wc * 32 + 8 * fq; const float* bg = bias + (size_t)u.e * 4096 + j0; const float* bu = bg + 2048;
        int tk[2][4];
#pragma unroll
        for (int ai = 0; ai < 2; ++ai)
#pragma unroll
            for (int m = 0; m < 4; ++m) { const int r = ai * HALF + wr * 64 + m * 16 + fr; tk[ai][m] = u.rowidx[r < u.rows ? r : 0]; }
        f32x4 bg0 = *(const f32x4*)bg, bg1 = *(const f32x4*)(bg + 4), bu0 = *(const f32x4*)bu, bu1 = *(const f32x4*)(bu + 4);
        asm volatile("" : "+v"(tk[0][0]), "+v"(tk[0][1]), "+v"(tk[0][2]), "+v"(tk[0][3]), "+v"(tk[1][0]), "+v"(tk[1][1]), "+v"(tk[1][2]), "+v"(tk[1][3]), "+v"(bg0), "+v"(bg1), "+v"(bu0), "+v"(bu1));
        float sc[2][4];
#pragma unroll
        for (int ai = 0; ai < 2; ++ai)
#pragma unroll
            for (int m = 0; m < 4; ++m) sc[ai][m] = rstd[tk[ai][m] >> 2];
        asm volatile("" : "+v"(sc[0][0]), "+v"(sc[0][1]), "+v"(sc[0][2]), "+v"(sc[0][3]), "+v"(sc[1][0]), "+v"(sc[1][1]), "+v"(sc[1][2]), "+v"(sc[1][3]));
#pragma unroll
        for (int ai = 0; ai < 2; ++ai)
#pragma unroll
            for (int m = 0; m < 4; ++m) { const int r = ai * HALF + wr * 64 + m * 16 + fr; const float s = sc[ai][m];
                f32x4 o[2];
#pragma unroll
                for (int n = 0; n < 2; ++n) { const f32x4 g = acc[ai][0][m][n] * s + (n ? bg1 : bg0), up = acc[ai][1][m][n] * s + (n ? bu1 : bu0);
#pragma unroll
                    for (int i = 0; i < 4; ++i) { const float gg = fminf(g[i], 7.0f), uu = fminf(fmaxf(up[i], -7.0f), 7.0f);
                        const float sg = __builtin_amdgcn_rcpf(1.0f + __builtin_amdgcn_exp2f(-1.702f * 1.4426950408889634f * gg)); o[n][i] = gg * sg * (uu + 1.0f); } }
                u32x4 w; w.x = cvt_pk_bf16(o[0][0], o[0][1]); w.y = cvt_pk_bf16(o[0][2], o[0][3]); w.z = cvt_pk_bf16(o[1][0], o[1][1]); w.w = cvt_pk_bf16(o[1][2], o[1][3]);
                *(u32x4*)(ACT + ((size_t)u.pm * BM + r) * DFF + j0) = w; }
    }
};
struct EpiMoeDown {
    static constexpr bool PERM = true, META = true;
    bf16_t* Y; const float* gate; const float* bias;
    __device__ __forceinline__ void post(const Unit& u, LAS unsigned char* mb, int wid, int lane) const {
        const int r = (wid & 3) * 64 + lane, rc = r < u.rows ? r : 0;
        if (wid < 4) { __builtin_amdgcn_global_load_lds((const unsigned*)(u.rowidx + rc), (LAS unsigned*)(mb + wid * 256), 4, 0, 0);
                       __builtin_amdgcn_global_load_lds((const unsigned*)((const char*)(u.rowidx + rc) + (WS_ROWGATE - WS_ROWLIST)), (LAS unsigned*)(mb + 1024 + wid * 256), 4, 0, 0); }
        else __builtin_amdgcn_global_load_lds((const unsigned*)(bias + (size_t)u.e * DM + u.pn * BM + (wid - 4) * 64 + lane), (LAS unsigned*)(mb + 2048 + (wid - 4) * 256), 4, 0, 0);
    }
    __device__ __forceinline__ void operator()(const f32x4 (&acc)[2][2][4][2], const Unit& u, int wr, int wc, int fr, int fq, const LAS unsigned char* mb) const {
        asm volatile("" : "+v"(fr), "+v"(fq));
        const int col0 = u.pn * BM + wc * 32 + 8 * fq;
        f32x4 bv[2][2];
#pragma unroll
        for (int bj = 0; bj < 2; ++bj)
#pragma unroll
            for (int n = 0; n < 2; ++n) bv[bj][n] = *(const LAS f32x4*)(mb + 2048 + (bj * HALF + wc * 32 + 8 * fq + 4 * n) * 4);
#pragma unroll
        for (int ai = 0; ai < 2; ++ai)
#pragma unroll
            for (int m = 0; m < 4; ++m) { const int r = ai * HALF + wr * 64 + m * 16 + fr;
                const int a = (r < u.rows) ? *(const LAS int*)(mb + r * 4) : NASSIGN;
                const float g = *(const LAS float*)(mb + 1024 + r * 4);
#if Y_FP8
                unsigned char* rowp = (unsigned char*)Y + (size_t)a * DM + col0; const float g16 = g * 16.0f;
#pragma unroll
                for (int bj = 0; bj < 2; ++bj) { const f32x4 v0 = (acc[ai][bj][m][0] + bv[bj][0]) * g16, v1 = (acc[ai][bj][m][1] + bv[bj][1]) * g16;
                    u32x2 w; w.x = pk_fp8x4(v0[0], v0[1], v0[2], v0[3]); w.y = pk_fp8x4(v1[0], v1[1], v1[2], v1[3]);
                    *(u32x2*)(rowp + bj * HALF) = w; } }
#else
                bf16_t* rowp = Y + (size_t)a * DM + col0;
#pragma unroll
                for (int bj = 0; bj < 2; ++bj) { const f32x4 v0 = (acc[ai][bj][m][0] + bv[bj][0]) * g, v1 = (acc[ai][bj][m][1] + bv[bj][1]) * g;
                    u32x4 w; w.x = cvt_pk_bf16(v0[0], v0[1]); w.y = cvt_pk_bf16(v0[2], v0[3]); w.z = cvt_pk_bf16(v1[0], v1[1]); w.w = cvt_pk_bf16(v1[2], v1[3]);
                    *(u32x4*)(rowp + bj * HALF) = w; } }
#endif
    }
};
struct EpiMoeUpQ {
    static constexpr bool PERM = true, META = true;
    unsigned char* ACT; const float* rstd; const float* bias;
    __device__ __forceinline__ void post(const Unit& u, LAS unsigned char* mb, int wid, int lane) const {
        const int r = (wid & 3) * 64 + lane, rc = r < u.rows ? r : 0;
        if (wid < 4) __builtin_amdgcn_global_load_lds((const unsigned*)((const char*)(u.rowidx + rc) + (WS_ROWRSTD - WS_ROWLIST)), (LAS unsigned*)(mb + wid * 256), 4, 0, 0);
        else __builtin_amdgcn_global_load_lds((const unsigned*)(bias + (size_t)u.e * 4096 + ((wid - 4) >> 1) * 2048 + u.pn * HALF + ((wid - 4) & 1) * 64 + lane), (LAS unsigned*)(mb + 1024 + (wid - 4) * 256), 4, 0, 0);
    }
    __device__ __forceinline__ void operator()(const f32x4 (&acc)[2][2][4][2], const Unit& u, int wr, int wc, int fr, int fq, const LAS unsigned char* mb) const {
        asm volatile("" : "+v"(fr), "+v"(fq));
        const int j0 = u.pn * HALF + wc * 32 + 8 * fq, jl = wc * 32 + 8 * fq;
        const f32x4 bg0 = *(const LAS f32x4*)(mb + 1024 + jl * 4), bg1 = *(const LAS f32x4*)(mb + 1024 + jl * 4 + 16), bu0 = *(const LAS f32x4*)(mb + 1536 + jl * 4), bu1 = *(const LAS f32x4*)(mb + 1536 + jl * 4 + 16);
#pragma unroll
        for (int ai = 0; ai < 2; ++ai)
#pragma unroll
            for (int m = 0; m < 4; ++m) { const int r = ai * HALF + wr * 64 + m * 16 + fr; const float s = *(const LAS float*)(mb + r * 4);
                f32x4 o[2];
#pragma unroll
                for (int n = 0; n < 2; ++n) { const f32x4 g4 = acc[ai][0][m][n] * s + (n ? bg1 : bg0), u4 = acc[ai][1][m][n] * s + (n ? bu1 : bu0);
#pragma unroll
                    for (int hh = 0; hh < 2; ++hh) { f32x2 g = {g4[2 * hh], g4[2 * hh + 1]}, up = {u4[2 * hh], u4[2 * hh + 1]};
                        g = __builtin_elementwise_min(g, (f32x2){7.0f, 7.0f}); up = __builtin_elementwise_min(__builtin_elementwise_max(up, (f32x2){-7.0f, -7.0f}), (f32x2){7.0f, 7.0f});
                        const f32x2 ea = g * (-1.702f * 1.4426950408889634f); f32x2 e; e.x = __builtin_amdgcn_exp2f(ea.x); e.y = __builtin_amdgcn_exp2f(ea.y);
                        const f32x2 d = e + 1.0f; f32x2 sg; sg.x = __builtin_amdgcn_rcpf(d.x); sg.y = __builtin_amdgcn_rcpf(d.y);
                        const f32x2 t = g * 4.0f, r2 = (t * up + t) * sg; o[n][2 * hh] = r2.x; o[n][2 * hh + 1] = r2.y; } }
                u32x2 w; w.x = pk_fp8x4(o[0][0], o[0][1], o[0][2], o[0][3]); w.y = pk_fp8x4(o[1][0], o[1][1], o[1][2], o[1][3]);
                *(u32x2*)(ACT + ((size_t)u.pm * BM + r) * DFF + j0) = w; }
    }
};
struct MoeOrder {
    const char* A; const char* B; const int* rowlist; const int* ident; const LAS int* tab; int NT, K; size_t bexp; int G, c;
    __device__ __forceinline__ bool next(int i, Unit& u) const {
        if (i >= 32) return false;
        const LAS int* en = tab + 1024 + 8 * i;
        const int valid = __builtin_amdgcn_readfirstlane(en[0]); if (!valid) return false;
        const int e = __builtin_amdgcn_readfirstlane(en[1]), ntile = __builtin_amdgcn_readfirstlane(en[2]), pm = __builtin_amdgcn_readfirstlane(en[3]), rows = __builtin_amdgcn_readfirstlane(en[4]),
                  mrow = __builtin_amdgcn_readfirstlane(en[5]);
        u.e = e; u.pn = ntile; u.pm = pm; u.rows = rows;
        u.rowidx = rowlist + (size_t)e * NTOK + (size_t)mrow * BM;
        u.B = B + (size_t)e * bexp + (size_t)ntile * BM * K * 2;
        u.A = A;
        if (ident) { u.gidx = ident + (size_t)u.pm * BM; u.grows = BM; } else { u.gidx = u.rowidx; u.grows = u.rows; }
        return true;
    }
};
}
__device__ __forceinline__ void moe_build_table(LAS int* tab, const unsigned* cnt, int NT) {
    if (threadIdx.x == 0) { int ng = 0, start = 0, slot = 0;
        for (int e = 0; e < NEXP; ++e) { const int c = (int)cnt[e]; const int tiles = (c + 255) >> 8;
            for (int mt0 = 0; mt0 < tiles; mt0 += 8) { const int gsz = (tiles - mt0) < 8 ? (tiles - mt0) : 8; LAS int* en = tab + 8 + 8 * ng;
                en[0] = start; en[1] = e; en[2] = mt0; en[3] = gsz; en[4] = slot + mt0; en[5] = c - mt0 * 256; ++ng; start += gsz * NT; }
            slot += tiles; }
        tab[0] = ng; tab[1] = start; }
    __syncthreads();
    if (threadIdx.x < 32) { const int i = threadIdx.x, G = gridDim.x, c = blockIdx.x; const int total = tab[1], ng = tab[0]; LAS int* en = tab + 1024 + 8 * i;
        const long L = (long)i * G + c;
        if (L >= total) { en[0] = 0; }
        else { int p = (int)L; { const int q = total / pg8::NXCD, r = total % pg8::NXCD, xcd = p % pg8::NXCD, off = p / pg8::NXCD; p = (xcd < r ? xcd * (q + 1) : r * (q + 1) + (xcd - r) * q) + off; }
            int g = 0; while (g + 1 < ng && tab[8 + 8 * (g + 1)] <= p) ++g;
            const LAS int* ge = tab + 8 + 8 * g; const int qn = p - ge[0], gsz = ge[3], ntile = qn / gsz, mi = qn - ntile * gsz, rl = ge[5] - mi * 256;
            en[0] = 1; en[1] = ge[1]; en[2] = ntile; en[3] = ge[4] + mi; en[4] = rl < 256 ? rl : 256; en[5] = ge[2] + mi; } }
    __syncthreads();
}
__device__ __forceinline__ void gla_chunk_kv(int unit, const bf16_t* proj, const float* la, float* KV, float* Dc, char* lds) {
    const int tid = threadIdx.x, wid = __builtin_amdgcn_readfirstlane(tid >> 6), lane = tid & 63, r32 = lane & 31, hi = lane >> 5;
    const int b = unit >> 8, h = (unit >> 6) & 3, c = unit & 63; const size_t tok0 = (size_t)b * SEQ + (size_t)c * 64;
    char* V_lds = lds;
    const int dk = 32 * (wid & 3) + r32, hd = h * 128 + dk;
    float lav[64];
#pragma unroll
    for (int s = 0; s < 64; ++s) lav[s] = la[(tok0 + s) * 512 + hd];
    float kv[4][8];
#pragma unroll
    for (int ks = 0; ks < 4; ++ks)
#pragma unroll
        for (int j = 0; j < 8; ++j) kv[ks][j] = bf2f(proj[(tok0 + 16 * ks + 8 * hi + j) * NPROJ + C_KG + hd]);
    { const int sr = tid >> 4, sc = (tid & 15) * 8;
#pragma unroll
      for (int hf = 0; hf < 2; ++hf) { const bf16_t* vp = proj + (tok0 + sr) * NPROJ + C_VG + h * 256 + hf * 128 + sc;
          const bf16x8 a = *(const bf16x8*)vp, bb = *(const bf16x8*)(vp + (size_t)32 * NPROJ);
          *(bf16x8*)(V_lds + hf * fox::SHM_V + fox::v_st(sr, sc)) = a; *(bf16x8*)(V_lds + hf * fox::SHM_V + fox::v_st(32 + sr, sc)) = bb; } }
    float rsum = 0.f; float fr[4][8];
#pragma unroll
    for (int ks = 3; ks >= 0; --ks)
#pragma unroll
        for (int h2 = 1; h2 >= 0; --h2)
#pragma unroll
            for (int j = 7; j >= 0; --j) { const int s = 16 * ks + 8 * h2 + j;
                const float dec = __builtin_amdgcn_exp2f(rsum * 1.4426950408889634f);
                if (h2 == hi) fr[ks][j] = kv[ks][j] * dec;
                rsum += lav[s]; }
    bf16x8 pa[4];
#pragma unroll
    for (int ks = 0; ks < 4; ++ks) pa[ks] = pack8((f32x4){fr[ks][0], fr[ks][1], fr[ks][2], fr[ks][3]}, (f32x4){fr[ks][4], fr[ks][5], fr[ks][6], fr[ks][7]});
    __syncthreads();
    f32x16 o[4] = {};
    const int vb0 = (int)(uintptr_t)V_lds + fox::v_rd_base(lane);
    if ((wid >> 2) == 0) fox::pv_tile<0>(o, vb0, pa[0], pa[1], pa[2], pa[3]); else fox::pv_tile<1>(o, vb0, pa[0], pa[1], pa[2], pa[3]);
    bf16_t* kvo = (bf16_t*)KV + (size_t)unit * (128 * 256) + (size_t)((wid >> 2) * 128 + r32) * 128 + 32 * (wid & 3) + 4 * hi;
#pragma unroll
    for (int d0 = 0; d0 < 4; ++d0)
#pragma unroll
        for (int g = 0; g < 4; ++g) { u32x2 w; w.x = cvt_pk_bf16(o[d0][4 * g], o[d0][4 * g + 1]); w.y = cvt_pk_bf16(o[d0][4 * g + 2], o[d0][4 * g + 3]); *(u32x2*)(kvo + (size_t)d0 * 32 * 128 + 8 * g) = w; }
    if (hi == 0 && (wid >> 2) == 0) Dc[(size_t)unit * 128 + dk] = __builtin_amdgcn_exp2f(rsum * 1.4426950408889634f);
    __syncthreads();
}
struct GlaSet { bf16x8 kv[4]; bf16x8 qf[4]; };
__device__ __forceinline__ void gla_ld(GlaSet& R, int c, int b, int h, int sl, int mt, const bf16_t* proj, const bf16_t* KV, int r, int q) {
    const bf16_t* kvp = KV + (size_t)((b * 4 + h) * 64 + c) * (128 * 256) + (size_t)(sl * 16 + r) * 128 + 8 * q;
    const bf16_t* qp = proj + ((size_t)b * SEQ + (size_t)c * 64 + 16 * mt + r) * NPROJ + C_QG + h * 128 + 8 * q;
#pragma unroll
    for (int ks = 0; ks < 4; ++ks) { R.qf[ks] = *(const bf16x8*)(qp + 32 * ks); R.kv[ks] = *(const bf16x8*)(kvp + 32 * ks); }
}
typedef _Float16 f16x4 __attribute__((ext_vector_type(4)));
typedef _Float16 f16x8 __attribute__((ext_vector_type(8)));
__device__ __forceinline__ void gla_step(const GlaSet& R, f32x4 (&S)[4][2], const LAS _Float16* dl, int c, int b, int h, int sl, int mt, float* GO, int r, int q) {
    f32x4 o = {0.f, 0.f, 0.f, 0.f};
#pragma unroll
    for (int ks = 0; ks < 4; ++ks) { const f16x8 dh = *(const LAS f16x8*)(dl + c * 128 + 32 * ks + 8 * q);
        const f32x4 d0 = {(float)dh[0], (float)dh[1], (float)dh[2], (float)dh[3]}, d1 = {(float)dh[4], (float)dh[5], (float)dh[6], (float)dh[7]};
        S[ks][0] = d0 * S[ks][0] + bf_up4(R.kv[ks], 0); S[ks][1] = d1 * S[ks][1] + bf_up4(R.kv[ks], 1);
        o = __builtin_amdgcn_mfma_f32_16x16x32_bf16(pack8(S[ks][0], S[ks][1]), R.qf[ks], o, 0, 0, 0); }
    u32x2 w; w.x = cvt_pk_bf16(o[0], o[1]); w.y = cvt_pk_bf16(o[2], o[3]);
    *(u32x2*)((bf16_t*)GO + ((size_t)b * SEQ + (size_t)c * 64 + 16 * mt + r) * 1024 + h * 256 + sl * 16 + 4 * q) = w;
}
__device__ __forceinline__ void gla_scan(int unit, const bf16_t* proj, const float* KVf, float* GO, const LAS _Float16* dl, int lane) {
    const bf16_t* KV = (const bf16_t*)KVf;
    const int mt = unit & 3, u2 = unit >> 2, b = u2 >> 6, h = (u2 >> 4) & 3, sl = u2 & 15, r = lane & 15, q = lane >> 4;
    f32x4 S[4][2];
#pragma unroll
    for (int ks = 0; ks < 4; ++ks) { S[ks][0] = (f32x4){0.f, 0.f, 0.f, 0.f}; S[ks][1] = S[ks][0]; }
    GlaSet R0, R1, R2, R3;
    gla_ld(R0, 0, b, h, sl, mt, proj, KV, r, q); gla_ld(R1, 1, b, h, sl, mt, proj, KV, r, q); gla_ld(R2, 2, b, h, sl, mt, proj, KV, r, q);
#pragma unroll 1
    for (int c = 0; c < 64; c += 4) {
        gla_ld(R3, c + 3, b, h, sl, mt, proj, KV, r, q);
        gla_step(R0, S, dl, c, b, h, sl, mt, GO, r, q);
        if (c + 4 < 64) gla_ld(R0, c + 4, b, h, sl, mt, proj, KV, r, q);
        gla_step(R1, S, dl, c + 1, b, h, sl, mt, GO, r, q);
        if (c + 4 < 64) gla_ld(R1, c + 5, b, h, sl, mt, proj, KV, r, q);
        gla_step(R2, S, dl, c + 2, b, h, sl, mt, GO, r, q);
        if (c + 4 < 64) gla_ld(R2, c + 6, b, h, sl, mt, proj, KV, r, q);
        gla_step(R3, S, dl, c + 3, b, h, sl, mt, GO, r, q);
    }
    LDS_WAIT(); asm volatile("" ::: "memory");
}
__device__ __forceinline__ f32x4 bf_lo4(u32x4 w) { return (f32x4){__uint_as_float(w[0] << 16), __uint_as_float(w[0] & 0xffff0000u), __uint_as_float(w[1] << 16), __uint_as_float(w[1] & 0xffff0000u)}; }
__device__ __forceinline__ f32x4 bf_hi4(u32x4 w) { return (f32x4){__uint_as_float(w[2] << 16), __uint_as_float(w[2] & 0xffff0000u), __uint_as_float(w[3] << 16), __uint_as_float(w[3] & 0xffff0000u)}; }
__device__ __forceinline__ void gla_finish16(int th0, const float* GO, const bf16_t* proj, const float* gain, bf16_t* mix, int lane) {
    const int l32 = lane & 31, sub = lane >> 5;
    u32x4 go[8], gt[8];
#pragma unroll
    for (int i = 0; i < 8; ++i) { const int th = th0 + 2 * i + sub, tok = th >> 2, h = th & 3;
        go[i] = *(const u32x4*)((const bf16_t*)GO + (size_t)tok * 1024 + h * 256 + l32 * 8); gt[i] = *(const u32x4*)(proj + (size_t)tok * NPROJ + C_GG + h * 256 + l32 * 8); }
#pragma unroll
    for (int i = 0; i < 8; ++i) { const int th = th0 + 2 * i + sub, tok = th >> 2, h = th & 3;
        const f32x4 v0 = bf_lo4(go[i]), v1 = bf_hi4(go[i]), q0 = bf_lo4(gt[i]), q1 = bf_hi4(gt[i]);
        float ss = ((v0[0] * v0[0] + v0[1] * v0[1]) + (v0[2] * v0[2] + v0[3] * v0[3])) + ((v1[0] * v1[0] + v1[1] * v1[1]) + (v1[2] * v1[2] + v1[3] * v1[3]));
        ss += __shfl_xor(ss, 1); ss += __shfl_xor(ss, 2); ss += __shfl_xor(ss, 4); ss += __shfl_xor(ss, 8); ss += __shfl_xor(ss, 16);
        const float rs = 1.0f / sqrtf(ss * (1.0f / 256.0f) + EPS);
        const f32x4 g0 = *(const f32x4*)(gain + h * 256 + l32 * 8), g1 = *(const f32x4*)(gain + h * 256 + l32 * 8 + 4);
        auto silu = [](float x) { return x * __builtin_amdgcn_rcpf(1.0f + __expf(-x)); };
        u32x4 w; w[0] = cvt_pk_bf16(v0[0] * rs * g0[0] * silu(q0[0]), v0[1] * rs * g0[1] * silu(q0[1])); w[1] = cvt_pk_bf16(v0[2] * rs * g0[2] * silu(q0[2]), v0[3] * rs * g0[3] * silu(q0[3]));
        w[2] = cvt_pk_bf16(v1[0] * rs * g1[0] * silu(q1[0]), v1[1] * rs * g1[1] * silu(q1[1])); w[3] = cvt_pk_bf16(v1[2] * rs * g1[2] * silu(q1[2]), v1[3] * rs * g1[3] * silu(q1[3]));
        *(u32x4*)(mix + (size_t)tok * DM + h * 256 + l32 * 8) = w; }
}

__device__ __forceinline__ void fox_combine16(int th0, const float* PO, const float* ML, const float* gain, bf16_t* mix, int lane) {
    const int l16 = lane & 15, sub = lane >> 4, h = sub & 3; constexpr float C2 = 1.4426950408889634f * 0.08838834764831845f;
    u32x4 o0[4], o1[4]; f32x2 ml0[4], ml1[4];
#pragma unroll
    for (int i = 0; i < 4; ++i) { const size_t th = (size_t)(th0 + 4 * i + sub);
        o0[i] = *(const u32x4*)((const bf16_t*)PO + th * 128 + l16 * 8); o1[i] = *(const u32x4*)((const bf16_t*)PO + (size_t)NTOK * 512 + th * 128 + l16 * 8);
        ml0[i] = *(const f32x2*)(ML + th * 2); ml1[i] = *(const f32x2*)(ML + (size_t)NTOK * 8 + th * 2); }
    float g[8];
#pragma unroll
    for (int t = 0; t < 8; ++t) g[t] = gain[h * 128 + (t & 3) * 32 + l16 * 2 + (t >> 2)];
#pragma unroll
    for (int i = 0; i < 4; ++i) { const int th = th0 + 4 * i + sub, tok = th >> 2;
        const float m = fmaxf(ml0[i][0], ml1[i][0]), a0 = __builtin_amdgcn_exp2f((ml0[i][0] - m) * C2), a1 = __builtin_amdgcn_exp2f((ml1[i][0] - m) * C2);
        const float inv = 1.0f / (ml0[i][1] * a0 + ml1[i][1] * a1);
        const f32x4 v0 = (bf_lo4(o0[i]) * a0 + bf_lo4(o1[i]) * a1) * inv, v1 = (bf_hi4(o0[i]) * a0 + bf_hi4(o1[i]) * a1) * inv;
        float ss = ((v0[0] * v0[0] + v0[1] * v0[1]) + (v0[2] * v0[2] + v0[3] * v0[3])) + ((v1[0] * v1[0] + v1[1] * v1[1]) + (v1[2] * v1[2] + v1[3] * v1[3]));
        ss += __shfl_xor(ss, 1); ss += __shfl_xor(ss, 2); ss += __shfl_xor(ss, 4); ss += __shfl_xor(ss, 8);
        const float rs = 1.0f / sqrtf(ss * (1.0f / 128.0f) + EPS);
        u32x4 w; w[0] = cvt_pk_bf16(v0[0] * rs * g[0], v0[1] * rs * g[1]); w[1] = cvt_pk_bf16(v0[2] * rs * g[2], v0[3] * rs * g[3]);
        w[2] = cvt_pk_bf16(v1[0] * rs * g[4], v1[1] * rs * g[5]); w[3] = cvt_pk_bf16(v1[2] * rs * g[6], v1[3] * rs * g[7]);
        *(u32x4*)(mix + (size_t)tok * DM + 1024 + h * 128 + l16 * 8) = w; }
}

__device__ __forceinline__ void memkv_tile(int t, const bf16_t* memb, const bf16_t* WT, const float* rstd, bf16_t* KM, bf16_t* VT, int lane) {
    const int rt = t >> 5, ct = t & 31, r = lane & 15, q = lane >> 4;
    const bf16_t* ap = memb + (size_t)(rt * 32 + r) * DM + q * 16; const bf16_t* bp = WT + (size_t)(ct * 32 + r) * DM + q * 16;
    f32x4 acc[2][2] = {};
#pragma unroll 4
    for (int kb = 0; kb < 32; ++kb) {
        bf16x8 a[2][2], bb[2][2];
#pragma unroll
        for (int i = 0; i < 2; ++i)
#pragma unroll
            for (int s = 0; s < 2; ++s) { a[i][s] = *(const bf16x8*)(ap + (size_t)i * 16 * DM + kb * 64 + s * 8); bb[i][s] = *(const bf16x8*)(bp + (size_t)i * 16 * DM + kb * 64 + s * 8); }
#pragma unroll
        for (int i = 0; i < 2; ++i)
#pragma unroll
            for (int j = 0; j < 2; ++j)
#pragma unroll
                for (int s = 0; s < 2; ++s) acc[i][j] = __builtin_amdgcn_mfma_f32_16x16x32_bf16(a[i][s], bb[j][s], acc[i][j], 0, 0, 0);
    }
#pragma unroll
    for (int i = 0; i < 2; ++i) { const int row = rt * 32 + 16 * i + 4 * q;
        const f32x4 rs = *(const f32x4*)(rstd + row);
#pragma unroll
        for (int j = 0; j < 2; ++j) { const int col = ct * 32 + 16 * j + r; const f32x4 v = acc[i][j] * rs;
            if (col < 512) {
#pragma unroll
                for (int tt = 0; tt < 4; ++tt) KM[(size_t)(row + tt) * 512 + col] = (bf16_t)(cvt_pk_bf16(v[tt], 0.f) & 0xffffu); }
            else { const int hd = col - 512, bb2 = row >> 8, key = row & 255; u32x2 w; w.x = cvt_pk_bf16(v[0], v[1]); w.y = cvt_pk_bf16(v[2], v[3]);
                *(u32x2*)(VT + ((size_t)(bb2 * 4 + (hd >> 7)) * 128 + (hd & 127)) * 256 + key) = w; } } }
}
__device__ __forceinline__ void memattn_unit(int bh, int qt, const bf16_t* proj, const LAS unsigned char* kl, const LAS unsigned char* vl, const float* gain, bf16_t* mix, int lane) {
    const int b = bh >> 2, h = bh & 3, r32 = lane & 31, hi = lane >> 5;
    const size_t tok0 = (size_t)b * SEQ + (size_t)qt * 32;
    bf16x8 qr[8];
#pragma unroll
    for (int d0 = 0; d0 < 8; ++d0) qr[d0] = *(const bf16x8*)(proj + (tok0 + r32) * NPROJ + C_QM + h * 128 + d0 * 16 + hi * 8);
    const int sw = r32 & 15;
    const LAS unsigned char* ka[8];
#pragma unroll
    for (int d0 = 0; d0 < 8; ++d0) ka[d0] = kl + r32 * 256 + (((2 * d0 + hi) ^ sw) << 4);
    float mx = -3.0e38f;
#pragma unroll 1
    for (int j = 0; j < 8; ++j) { f32x16 p = {}; const int ko = j * 32 * 256;
#pragma unroll
        for (int d0 = 0; d0 < 8; ++d0) p = __builtin_amdgcn_mfma_f32_32x32x16_bf16(*(const LAS bf16x8*)(ka[d0] + ko), qr[d0], p, 0, 0, 0);
#pragma unroll
        for (int r = 0; r < 16; ++r) mx = fmaxf(mx, p[r]); }
    { auto rr = __builtin_amdgcn_permlane32_swap(__float_as_uint(mx), __float_as_uint(mx), false, false); mx = fmaxf(__uint_as_float(rr[0]), __uint_as_float(rr[1])); }
    constexpr float C2 = 1.4426950408889634f * 0.08838834764831845f; const float mL = -mx * C2;
    float ps = 0.f;
    f32x16 o[4] = {};
    const LAS unsigned char* va[4];
#pragma unroll
    for (int ks = 0; ks < 4; ++ks) va[ks] = vl + r32 * 512 + (((2 * ks + hi) ^ (sw & 7)) << 4);
#define PK4(P, B_, OUT) do { unsigned a0 = cvt_pk_bf16(P[B_+0], P[B_+1]), a1 = cvt_pk_bf16(P[B_+2], P[B_+3]), b0 = cvt_pk_bf16(P[B_+4], P[B_+5]), b1 = cvt_pk_bf16(P[B_+6], P[B_+7]); \
        auto r0 = __builtin_amdgcn_permlane32_swap(a0, b0, false, false); auto r1 = __builtin_amdgcn_permlane32_swap(a1, b1, false, false); \
        u32x4 w = {r0[0], r1[0], r0[1], r1[1]}; OUT = __builtin_bit_cast(bf16x8, w); } while (0)
#pragma unroll 1
    for (int jj = 0; jj < 4; ++jj) { f32x16 p0 = {}, p1 = {}; const int ko = jj * 64 * 256;
#pragma unroll
        for (int d0 = 0; d0 < 8; ++d0) { p0 = __builtin_amdgcn_mfma_f32_32x32x16_bf16(*(const LAS bf16x8*)(ka[d0] + ko), qr[d0], p0, 0, 0, 0);
                                         p1 = __builtin_amdgcn_mfma_f32_32x32x16_bf16(*(const LAS bf16x8*)(ka[d0] + ko + 32 * 256), qr[d0], p1, 0, 0, 0); }
#pragma unroll
        for (int r = 0; r < 16; ++r) { p0[r] = __builtin_amdgcn_exp2f(fmaf(p0[r], C2, mL)); p1[r] = __builtin_amdgcn_exp2f(fmaf(p1[r], C2, mL)); ps += p0[r] + p1[r]; }
        bf16x8 pa[4];
        PK4(p0, 0, pa[0]); PK4(p0, 8, pa[1]); PK4(p1, 0, pa[2]); PK4(p1, 8, pa[3]);
        const int vo = (jj >> 1) * 256 + ((((jj & 1) << 3) ^ (sw & 8)) << 4);
#pragma unroll
        for (int ks = 0; ks < 4; ++ks)
#pragma unroll
            for (int d0 = 0; d0 < 4; ++d0) o[d0] = __builtin_amdgcn_mfma_f32_32x32x16_bf16(pa[ks], *(const LAS bf16x8*)(va[ks] + vo + d0 * 32 * 512), o[d0], 0, 0, 0); }
#undef PK4
    { auto rr = __builtin_amdgcn_permlane32_swap(__float_as_uint(ps), __float_as_uint(ps), false, false); ps = __uint_as_float(rr[0]) + __uint_as_float(rr[1]); }
    const float rl = __builtin_amdgcn_rcpf(ps);
    const float g0 = gain[h * 128 + r32], g1 = gain[h * 128 + 32 + r32], g2 = gain[h * 128 + 64 + r32], g3 = gain[h * 128 + 96 + r32];
    bf16_t* out = mix + tok0 * DM + 1536 + h * 128;
#pragma unroll
    for (int r = 0; r < 16; ++r) { const int orow = fox::crow(r, hi); const float rlr = __shfl(rl, orow);
        const float v0 = o[0][r] * rlr, v1 = o[1][r] * rlr, v2 = o[2][r] * rlr, v3 = o[3][r] * rlr;
        float ss = (v0 * v0 + v1 * v1) + (v2 * v2 + v3 * v3);
        ss += __shfl_xor(ss, 1); ss += __shfl_xor(ss, 2); ss += __shfl_xor(ss, 4); ss += __shfl_xor(ss, 8); ss += __shfl_xor(ss, 16);
        const float rs = 1.0f / sqrtf(ss * (1.0f / 128.0f) + EPS);
        u32x2 w; w.x = cvt_pk_bf16(v0 * rs * g0, v1 * rs * g1); w.y = cvt_pk_bf16(v2 * rs * g2, v3 * rs * g3);
        *(u32x2*)(out + (size_t)orow * DM + r32 * 4) = w; }
}

constexpr int NWAVES = 8;
constexpr int CONV_ALL = 49152, CONV_P1 = 6144, CONV_P7 = 6144, CONV_P2 = CONV_ALL - CONV_P1 - CONV_P7;
#ifndef MK_N_LAUNCHES
#define MK_N_LAUNCHES 1
#endif
#ifndef REP_PHASE
#define REP_PHASE -1
#endif
#ifndef REP_EXTRA
#define REP_EXTRA 1
#endif
#define REP_SUB 0
constexpr int PER_PHASE = 11;
constexpr int N_LAUNCHES = MK_N_LAUNCHES;
struct Args {
    const float *x, *mem, *g_attn, *g_mem, *w_in, *w_a2, *b_a, *g_gla, *b_fox, *g_fox, *w_mkv, *g_memo, *w_out, *g_ffn, *w_router, *b_router, *w_up, *b_up, *w_down, *b_down, *g_final;
    float* out; unsigned char* ws; int ph_lo, ph_hi;
};
typedef const __attribute__((address_space(4))) Args* KArgs;
__device__ __forceinline__ KArgs kargs() { KArgs p = (KArgs)__builtin_amdgcn_kernarg_segment_ptr(); asm volatile("" : "+s"(p)); return p; }
__global__ void __launch_bounds__(NWAVES * 64, 2) fwd(Args a_unused) {
    extern __shared__ __attribute__((aligned(16))) unsigned char lds_raw[];
    LAS unsigned char* lds = (LAS unsigned char*)lds_raw;
    const int tid = threadIdx.x, lane = tid & 63, wave = __builtin_amdgcn_readfirstlane(tid >> 6);
    const int G = gridDim.x, bx = blockIdx.x;
    const int vcu = (G % 8 == 0) ? (bx % 8) * (G / 8) + bx / 8 : bx;
    const int gw = vcu * NWAVES + wave, NGW = G * NWAVES;
    unsigned char* ws = kargs()->ws;
    unsigned* ctl = (unsigned*)(ws + WS_CTL);
    volatile LAS unsigned* MISC = (volatile LAS unsigned*)(lds + MISC_OFF);
    for (int u = tid; u < (LDS_BYTES - MISC_OFF) / 4; u += NWAVES * 64) ((LAS unsigned*)(lds + MISC_OFF))[u] = 0u;
    __syncthreads();
    XcdBarrier bar; bar.bar = ctl + CW_BAR; bar.x = 0; bar.st = nullptr;
    if (N_LAUNCHES == 1) bar = xcd_barrier_post(ctl + CW_BAR, MISC + 8);
#define GRID_BAR() do { if (N_LAUNCHES == 1) xcd_barrier(bar); } while (0)
    const int lo = kargs()->ph_lo, hi_ph = kargs()->ph_hi & 0xff, sub = kargs()->ph_hi >> 8;
#define PART(i) (sub == 0 || ((sub >> (i)) & 1))
#ifndef PH_MASK
#define PH_MASK 0xFFFF
#endif
#define IN(k) (((PH_MASK >> (k)) & 1) && lo <= (k) && (k) < hi_ph)
#define BOTH(k) (IN(k) && IN((k) + 1))
    bf16_t* WsmT = (bf16_t*)(ws + WS_WSM); bf16_t* WrT = (bf16_t*)(ws + WS_WSM + 256 * 1024);
    float* rstd1 = (float*)(ws + WS_RSTD); float* rstdm = rstd1 + 16384; float* rstd2 = rstd1 + 32768;
    float* small = (float*)(ws + WS_SMALL); float* gate_a = (float*)(ws + WS_GATE); int* rowlist = (int*)(ws + WS_ROWLIST);
    bf16_t* WmkvT = (bf16_t*)(ws + WS_WMKV); bf16_t* WoutT = (bf16_t*)(ws + WS_WOUT); bf16_t* WinT = (bf16_t*)(ws + WS_WIN);
    bf16_t* memb = (bf16_t*)(ws + WS_MEMB); bf16_t* KM = (bf16_t*)(ws + WS_KVM); bf16_t* VT = (bf16_t*)(ws + WS_KVM + MiB);
    float* glaD = (float*)(ws + WS_GLAD); bf16_t* xb = (bf16_t*)(ws + WS_XB); bf16_t* proj = (bf16_t*)(ws + WS_PROJ); bf16_t* mix = (bf16_t*)(ws + WS_MIX);
    float* x1 = (float*)(ws + WS_X1); bf16_t* x1b = (bf16_t*)(ws + WS_X1B); float* glaKV = (float*)(ws + WS_GLAKV); float* glaO = (float*)(ws + WS_GLAO);
    bf16_t* WupT = (bf16_t*)(ws + WS_WUP); bf16_t* WdownT = (bf16_t*)(ws + WS_WDOWN); bf16_t* act = (bf16_t*)(ws + WS_ACT); bf16_t* ybuf = (bf16_t*)(ws + WS_Y);
    unsigned* cnt = ctl + CW_CNT; float* la = (float*)(ws + WS_LA); int* ident = (int*)(ws + WS_IDENT); float* rowgate = (float*)(ws + WS_ROWGATE); float* rowrstd = (float*)(ws + WS_ROWRSTD);

#if MOE_FP8
#define MOE_CONV_ITEM(r_) do { const int r = (int)(r_); KArgs kq = kargs(); LAS unsigned char* scr = lds + wave * 18432; \
        if (r < 32768) { const int e = r >> 10, q = r & 1023, kb = q >> 6, nb = q & 63, nt = nb >> 2, bj = (nb >> 1) & 1, j64 = nb & 1; \
            tr_item_fp8(kq->w_up + (size_t)e * DM * 4096, 4096, kb * 128, bj * 2048 + nt * 128 + j64 * 64, (unsigned char*)WupT + ((size_t)e * 4096 + nb * 64) * DM, DM, kq->g_ffn, 32.0f, scr, lane); } \
        else { const int r2 = r - 32768, e = r2 >> 9, q = r2 & 511, kb = q >> 5, nb = q & 31; \
            tr_item_fp8(kq->w_down + (size_t)e * DFF * DM, DM, kb * 128, nb * 64, (unsigned char*)WdownT + ((size_t)e * DM + nb * 64) * DFF, DFF, nullptr, 32.0f, scr, lane); } } while (0)
#else
#define MOE_CONV_ITEM(r_) do { const int r = (int)(r_); KArgs kq = kargs(); LAS unsigned char* scr = lds + wave * 18432; \
        if (r < 32768) { const int e = r >> 10, q = r & 1023, kb = q >> 5, nb = q & 31, nt = nb >> 1, bj = nb & 1; \
            tr_item<false>(kq->w_up + (size_t)e * DM * 4096, 4096, kb * 64, bj * 2048 + nt * 128, WupT + ((size_t)e * 4096 + nb * 128) * DM, DM, kq->g_ffn, 1.0f, scr, lane); } \
        else { const int r2 = r - 32768, e = r2 >> 9, q = r2 & 511, kb = q >> 4, nb = q & 15; \
            tr_item<false>(kq->w_down + (size_t)e * DFF * DM, DM, kb * 64, nb * 128, WdownT + ((size_t)e * DM + nb * 128) * DFF, DFF, nullptr, 1.0f, scr, lane); } } while (0)
#endif
    if (IN(0)) {
        KArgs ka = kargs();
        LAS unsigned char* scr = lds + wave * 18432; LAS float* scrf = (LAS float*)scr;
        constexpr int I_IN = 32 * 40, I_OUT = 32 * 16, I_MKV = 32 * 8, I_TH = 32;
        constexpr int NITEMS = I_IN + I_OUT + I_MKV + 2 * I_TH;
        for (int it = gw; it < NITEMS; it += NGW) {
            int r = it;
            if (r < I_IN) { const int kb = r / 40, nb = r % 40, n0 = nb * 128; const int sc0 = n0 < 3072 ? n0 : (n0 < 4608 ? n0 + 16 : n0 + 20);
                tr_item<false>(ka->w_in, 5140, kb * 64, sc0, WinT + (size_t)n0 * DM, DM, ka->g_attn, n0 < 512 ? 0.08838834764831845f : 1.0f, scr, lane); continue; } r -= I_IN;
            if (r < I_OUT) { const int kb = r >> 4, nb = r & 15;
                if (kb < 16) tr_item<false>(ka->w_out, DM, kb * 64, nb * 128, WoutT + (size_t)nb * 128 * DM, DM, nullptr, 1.0f, scr, lane);
                else tr_item<true>(ka->w_out, DM, kb * 64, nb * 128, WoutT + (size_t)nb * 128 * DM, DM, nullptr, 1.0f, scr, lane);
                continue; } r -= I_OUT;
            if (r < I_MKV) { const int kb = r >> 3, nb = r & 7;
                tr_item<false>(ka->w_mkv, 1024, kb * 64, nb * 128, WmkvT + (size_t)nb * 128 * DM, DM, ka->g_mem, 1.0f, scr, lane); continue; } r -= I_MKV;
            if (r < I_TH) { thin_item(0, ka->w_in, ka->g_attn, r * 64, WsmT, WsmT + 32 * 2048, scrf, lane); continue; } r -= I_TH;
            thin_item(1, ka->w_router, ka->g_ffn, r * 64, WrT, WrT + 32 * 2048, scrf, lane);
        }
        for (int i = gw * 64 + lane; i < MAXTILES * 256; i += NGW * 64) ident[i] = i << 2;
        for (int row = gw; row < NB * NMEM; row += NGW) {
            const float* xr = ka->mem + (size_t)row * DM + lane * 4; f32x4 v[8]; float ss = 0.f;
#pragma unroll
            for (int j = 0; j < 8; ++j) v[j] = *(const f32x4*)(xr + j * 256);
#pragma unroll
            for (int j = 0; j < 8; ++j) { ss += (v[j][0] * v[j][0] + v[j][1] * v[j][1]) + (v[j][2] * v[j][2] + v[j][3] * v[j][3]);
                u32x2 w; w.x = cvt_pk_bf16(v[j][0], v[j][1]); w.y = cvt_pk_bf16(v[j][2], v[j][3]); *(u32x2*)(memb + (size_t)row * DM + j * 256 + lane * 4) = w; }
            ss = wave_sum(ss); if (lane == 0) rstdm[row] = 1.0f / sqrtf(ss * (1.0f / DM) + EPS); }
        if (BOTH(0)) GRID_BAR();
    }
    if (IN(1)) {
        KArgs ka = kargs();
        LAS float* alw = (LAS float*)(lds + wave * 1024);
        LAS unsigned char* wl = lds + 8192;
        for (int gq8 = vcu; gq8 < NTOK / 128; gq8 += G) { const int gq = gq8 * 8 + wave; f32x4 acc2[2]; float rs;
            rowpass_wg<false>(ka->x, gq8 * 128, xb, WsmT, WsmT + 32 * 2048, acc2, rs, wl);
            int lane = tid & 63; asm volatile("" : "+v"(lane));
            if (lane < 16) rstd1[gq * 16 + lane] = rs;
            const int r = lane & 15, q = lane >> 4;
#pragma unroll
            for (int i = 0; i < 4; ++i) { const float rr = __shfl(rs, 4 * q + i);
                alw[(4 * q + i) * 16 + r] = acc2[0][i] * rr; small[(size_t)(gq * 16 + 4 * q + i) * 32 + 16 + r] = acc2[1][i] * rr; }
            LDS_WAIT(); asm volatile("" ::: "memory");
#pragma unroll 1
            for (int hb = 0; hb < 8; ++hb) { const int hd = hb * 64 + lane; float w[16];
#pragma unroll
                for (int k2 = 0; k2 < 16; ++k2) w[k2] = ka->w_a2[k2 * 512 + hd];
                const float ba = ka->b_a[hd];
#pragma unroll 4
                for (int rw = 0; rw < 16; ++rw) { const f32x4 a0 = *(const LAS f32x4*)(alw + rw * 16), a1 = *(const LAS f32x4*)(alw + rw * 16 + 4), a2 = *(const LAS f32x4*)(alw + rw * 16 + 8), a3 = *(const LAS f32x4*)(alw + rw * 16 + 12);
                    float z = ba;
                    z += a0[0] * w[0] + a0[1] * w[1] + a0[2] * w[2] + a0[3] * w[3]; z += a1[0] * w[4] + a1[1] * w[5] + a1[2] * w[6] + a1[3] * w[7];
                    z += a2[0] * w[8] + a2[1] * w[9] + a2[2] * w[10] + a2[3] * w[11]; z += a3[0] * w[12] + a3[1] * w[13] + a3[2] * w[14] + a3[3] * w[15];
                    const float ls = fminf(z, 0.f) - __logf(1.0f + __expf(-fabsf(z)));
                    la[(size_t)(gq * 16 + rw) * 512 + hd] = ls * (1.0f / 16.0f); } }
            LDS_WAIT(); asm volatile("" ::: "memory"); }
        for (int t = gw - NTOK / 16; t < 1024; t += NGW) if (t >= 0) memkv_tile(t, memb, WmkvT, rstdm, KM, VT, lane);
        if (NGW == 2048 && gw >= 1024) { for (int it = CONV_P2 + (gw - 1024); it < CONV_P2 + CONV_P1; it += 1024) MOE_CONV_ITEM(it); }
        else if (NGW != 2048) { for (int it = CONV_P2 + gw; it < CONV_P2 + CONV_P1; it += NGW) MOE_CONV_ITEM(it); }
        if (BOTH(1)) GRID_BAR();
    }
    if (IN(2)) {
        KArgs ka = kargs();
        pg8::StaticOrder S; S.init(xb, WinT, NTOK, NPROJ, DM, G, bx);
        pg8::EpiRowScaleBf16 E{proj, NPROJ, rstd1};
        const bool conv_first = (bx & 7) < 4;
        if (conv_first) { for (int it = gw; it < CONV_P2; it += NGW) MOE_CONV_ITEM(it); __syncthreads(); }
        pg8::gemm_phase<pg8::EpiRowScaleBf16, pg8::StaticOrder, false>(lds, DM, S, E);
        if (!conv_first) { __syncthreads(); for (int it = gw; it < CONV_P2; it += NGW) MOE_CONV_ITEM(it); }
        if (BOTH(2)) GRID_BAR();
    }
    if (IN(3)) {
        KArgs ka = kargs();
        if (G == 256) {
            const int j = bx >> 3, bh = 2 * (bx & 7) + (j >> 4), x = j & 7, sh = (j >> 3) & 1, b = bh >> 2, h = bh & 3;
            char* l = (char*)lds_raw; float* Fb = (float*)(l + fox::LDS_FB); float* wsum = (float*)(l + fox::LDS_WS);
            bf16_t* PO = (bf16_t*)(ws + WS_FOXO) + (size_t)sh * NTOK * 512; float* PML = (float*)(ws + WS_FOXML) + (size_t)sh * NTOK * 8;
            {
                const float bf = ka->b_fox[h]; float v[8]; float run = 0.f;
#pragma unroll
                for (int i = 0; i < 8; ++i) { const int k = tid * 8 + i; const float lf = log_sigmoid(small[((size_t)b * SEQ + k) * 32 + 16 + h] + bf); run += lf; v[i] = run; }
                float inc = run;
#pragma unroll
                for (int o = 1; o < 64; o <<= 1) { const float t2 = __shfl_up(inc, o); if (lane >= o) inc += t2; }
                if (lane == 63) wsum[wave] = inc;
                __syncthreads();
                float woff = 0.f; for (int w2 = 0; w2 < wave; ++w2) woff += wsum[w2];
                const float base = woff + inc - run;
#pragma unroll
                for (int i = 0; i < 8; ++i) Fb[tid * 8 + i] = -(base + v[i]) * (1.0f / fox::SCALE);
                __syncthreads(); }
#pragma unroll 1
            for (int pass = 0; pass < 2; ++pass) { const int qb = pass ? 15 - x : x, n = 4 * (qb + 1);
                fox::BlockRef cur; cur.Q = proj + (size_t)(b * SEQ + qb * 256) * NPROJ + C_QF + h * 128; cur.K = proj + (size_t)b * SEQ * NPROJ + C_KF + h * 128; cur.V = proj + (size_t)b * SEQ * NPROJ + C_VF + h * 128;
                cur.P0 = qb * 256; cur.j_lo = sh ? n / 2 : 0; cur.j_hi = sh ? n : n / 2;
                fox::Seam Sm; fox::prime(cur, l, Sm);
                fox::EpiPartial E{(float*)(PO + ((size_t)b * SEQ * 4 + h) * 128), PML + ((size_t)b * SEQ * 4 + h) * 2};
                fox::block<fox::EpiPartial>(cur, cur, l, Sm, E); }
        }
        for (int u = bx; u < 1024; u += G) gla_chunk_kv(u, proj, la, glaKV, glaD, (char*)lds_raw);
        if (BOTH(3)) GRID_BAR();
    }
    if (IN(4)) {
        KArgs ka = kargs();
#pragma unroll 1
        for (int g = vcu; g < 256; g += G) {
            const int bh = g >> 4; int tl = tid, ll = lane; asm volatile("" : "+v"(tl), "+v"(ll));
            { const float* dsrc = glaD + (size_t)bh * 8192; const bf16_t* ksrc = KM + (size_t)((bh >> 2) * 256) * 512 + (bh & 3) * 128; const bf16_t* vsrc = VT + (size_t)bh * 128 * 256;
              f32x4 t[4]; bf16x8 kk[8], vv[8];
#pragma unroll
              for (int i = 0; i < 4; ++i) t[i] = *(const f32x4*)(dsrc + (i * 512 + tl) * 4);
#pragma unroll
              for (int i = 0; i < 8; ++i) { const int idx = i * 512 + tl; kk[i] = *(const bf16x8*)(ksrc + (size_t)(idx >> 4) * 512 + (idx & 15) * 8); }
#pragma unroll
              for (int i = 0; i < 8; ++i) vv[i] = *(const bf16x8*)(vsrc + (size_t)(i * 512 + tl) * 8);
#pragma unroll
              for (int i = 0; i < 4; ++i) { const f16x4 hv = {(_Float16)t[i][0], (_Float16)t[i][1], (_Float16)t[i][2], (_Float16)t[i][3]}; *(LAS f16x4*)(lds + (i * 512 + tl) * 8) = hv; }
#pragma unroll
              for (int i = 0; i < 8; ++i) { const int idx = i * 512 + tl, row = idx >> 4, ch = idx & 15; *(LAS bf16x8*)(lds + 16384 + row * 256 + ((ch ^ (row & 15)) << 4)) = kk[i]; }
#pragma unroll
              for (int i = 0; i < 8; ++i) { const int idx = i * 512 + tl, row = idx >> 5, ch = idx & 31; *(LAS bf16x8*)(lds + 81920 + row * 512 + ((ch ^ (row & 15)) << 4)) = vv[i]; }
              __syncthreads(); }
            if (wave < 4) { if (PART(0)) gla_scan(g * 4 + wave, proj, glaKV, glaO, (const LAS _Float16*)lds, ll); }
            else if (PART(1)) { for (int i = 0; i < 2; ++i) memattn_unit(bh, (g & 15) * 8 + i * 4 + (wave - 4), proj, lds + 16384, lds + 81920, ka->g_memo, mix, ll); }
            __syncthreads();
        }
        if (BOTH(4)) GRID_BAR();
    }
    if (IN(5)) {
        KArgs ka = kargs();
        int l5 = (int)__builtin_amdgcn_mbcnt_hi(~0u, __builtin_amdgcn_mbcnt_lo(~0u, 0u)); asm volatile("" : "+v"(l5));
        for (int th = gw * 16; th < NTOK * 4; th += NGW * 16) gla_finish16(th, glaO, proj, ka->g_gla, mix, l5);
        for (int th = gw * 16; th < NTOK * 4; th += NGW * 16) fox_combine16(th, (const float*)(ws + WS_FOXO), (const float*)(ws + WS_FOXML), ka->g_fox, mix, l5);
        if (BOTH(5)) GRID_BAR();
    }
    if (IN(6)) {
        KArgs ka = kargs();
        pg8::StaticOrder S; S.init(mix, WoutT, NTOK, DM, DM, G, bx);
        pg8::EpiResF32 E{ka->x, x1, DM};
        pg8::gemm_phase<pg8::EpiResF32, pg8::StaticOrder, false>(lds, DM, S, E);
        if (BOTH(6)) GRID_BAR();
    }
    if (IN(7)) {
        KArgs ka = kargs();
        LAS float* lg = (LAS float*)(lds + wave * 2048);
        LAS unsigned char* wl = lds + 16384;
        for (int gq8 = vcu; gq8 < NTOK / 128; gq8 += G) { const int gq = gq8 * 8 + wave; f32x4 acc2[2]; float rs;
            rowpass_wg<MOE_FP8 != 0>(x1, gq8 * 128, x1b, WrT, WrT + 32 * 2048, acc2, rs, wl);
            int lane = tid & 63; asm volatile("" : "+v"(lane));
            if (lane < 16) rstd2[gq * 16 + lane] = rs;
            const int r = lane & 15, q = lane >> 4;
#pragma unroll
            for (int i = 0; i < 4; ++i) { const float rr = __shfl(rs, 4 * q + i);
                lg[(4 * q + i) * 32 + r] = acc2[0][i] * rr + ka->b_router[r]; lg[(4 * q + i) * 32 + 16 + r] = acc2[1][i] * rr + ka->b_router[16 + r]; }
            LDS_WAIT(); asm volatile("" ::: "memory");
            if (lane < 16) { const int tok = gq * 16 + lane; const float rsrow = rs; float v[32];
#pragma unroll
                for (int e = 0; e < 32; ++e) v[e] = lg[lane * 32 + e];
                int idx[4]; float val[4];
#pragma unroll
                for (int k = 0; k < 4; ++k) { float best = -3.0e38f; int bi = 0;
#pragma unroll
                    for (int e = 0; e < 32; ++e) { const bool better = v[e] > best; best = better ? v[e] : best; bi = better ? e : bi; }
                    idx[k] = bi; val[k] = best;
#pragma unroll
                    for (int e = 0; e < 32; ++e) v[e] = (e == bi) ? -3.0e38f : v[e]; }
                const float e0 = 1.0f, e1 = __expf(val[1] - val[0]), e2 = __expf(val[2] - val[0]), e3 = __expf(val[3] - val[0]); const float inv = 1.0f / (e0 + e1 + e2 + e3);
                const float gt[4] = {e0 * inv, e1 * inv, e2 * inv, e3 * inv};
#pragma unroll
                for (int k = 0; k < 4; ++k) { const int asg = tok * 4 + k; const unsigned pos = atomicAdd(&cnt[idx[k]], 1u); const size_t rp = (size_t)idx[k] * NTOK + pos; rowlist[rp] = asg; rowgate[rp] = gt[k]; rowrstd[rp] = rsrow; } }
            LDS_WAIT(); asm volatile("" ::: "memory");
        }
        if (NGW == 2048 && gw >= 1024) { for (int it = CONV_P2 + CONV_P1 + (gw - 1024); it < CONV_ALL; it += 1024) MOE_CONV_ITEM(it); }
        else if (NGW != 2048) { for (int it = CONV_P2 + CONV_P1 + gw; it < CONV_ALL; it += NGW) MOE_CONV_ITEM(it); }
        if (BOTH(7)) GRID_BAR();
    }
    if (IN(8)) {
        KArgs ka = kargs();
        LAS int* tab = (LAS int*)(lds + TAB_OFF);
        moe_build_table(tab, cnt, 16);
#if MOE_FP8
        pg8::MoeOrder S{(const char*)x1b, (const char*)WupT, rowlist, nullptr, tab, 16, DM / 2, (size_t)4096 * DM, G, bx};
        pg8::EpiMoeUpQ E{(unsigned char*)act, rstd2, ka->b_up};
        pg8::gemm_phase<pg8::EpiMoeUpQ, pg8::MoeOrder, true, true, 127, 122>(lds, DM / 2, S, E);
#else
        pg8::MoeOrder S{(const char*)x1b, (const char*)WupT, rowlist, nullptr, tab, 16, DM, (size_t)4096 * DM * 2, G, bx};
        pg8::EpiMoeUp E{act, rstd2, ka->b_up};
        pg8::gemm_phase<pg8::EpiMoeUp, pg8::MoeOrder, true>(lds, DM, S, E);
#endif
        if (BOTH(8)) GRID_BAR();
    }
    if (IN(9)) {
        KArgs ka = kargs();
        LAS int* tab = (LAS int*)(lds + TAB_OFF);
        __syncthreads();
        moe_build_table(tab, cnt, 8);
#if MOE_FP8
        pg8::MoeOrder S{(const char*)act, (const char*)WdownT, rowlist, ident, tab, 8, DFF / 2, (size_t)DM * DFF, G, bx};
        pg8::EpiMoeDown E{ybuf, gate_a, ka->b_down};
        pg8::gemm_phase<pg8::EpiMoeDown, pg8::MoeOrder, true, true, 125, 122>(lds, DFF / 2, S, E);
#else
        pg8::MoeOrder S{(const char*)act, (const char*)WdownT, rowlist, ident, tab, 8, DFF, (size_t)DM * DFF * 2, G, bx};
        pg8::EpiMoeDown E{ybuf, gate_a, ka->b_down};
        pg8::gemm_phase<pg8::EpiMoeDown, pg8::MoeOrder, true>(lds, DFF, S, E);
#endif
        if (BOTH(9)) GRID_BAR();
    }
    if (IN(10)) {
        KArgs ka = kargs();
        const int lane = (int)__builtin_amdgcn_mbcnt_hi(~0u, __builtin_amdgcn_mbcnt_lo(~0u, 0u));
        for (int tok = gw; tok < NTOK; tok += NGW) {
            f32x4 v[8]; float ss = 0.f;
#if Y_FP8
            unsigned yw[4][8];
#pragma unroll
            for (int j = 0; j < 8; ++j) { v[j] = __builtin_nontemporal_load((const f32x4*)(x1 + (size_t)tok * DM + j * 256 + lane * 4));
#pragma unroll
                for (int k = 0; k < 4; ++k) yw[k][j] = __builtin_nontemporal_load((const unsigned*)((const unsigned char*)ybuf + ((size_t)tok * 4 + k) * DM + j * 256 + lane * 4)); }
#pragma unroll
            for (int j = 0; j < 8; ++j) {
#pragma unroll
                for (int k = 0; k < 4; ++k) { const f32x2 lo = __builtin_amdgcn_cvt_pk_f32_fp8((int)yw[k][j], false), hi2 = __builtin_amdgcn_cvt_pk_f32_fp8((int)yw[k][j], true);
                    v[j][0] += lo[0] * 0.0625f; v[j][1] += lo[1] * 0.0625f; v[j][2] += hi2[0] * 0.0625f; v[j][3] += hi2[1] * 0.0625f; }
#else
            u32x2 yw[4][8];
#pragma unroll
            for (int j = 0; j < 8; ++j) { v[j] = __builtin_nontemporal_load((const f32x4*)(x1 + (size_t)tok * DM + j * 256 + lane * 4));
#pragma unroll
                for (int k = 0; k < 4; ++k) yw[k][j] = __builtin_nontemporal_load((const u32x2*)(ybuf + ((size_t)tok * 4 + k) * DM + j * 256 + lane * 4)); }
#pragma unroll
            for (int j = 0; j < 8; ++j) {
#pragma unroll
                for (int k = 0; k < 4; ++k) { const u32x2 w = yw[k][j];
                    v[j][0] += __uint_as_float(w.x << 16); v[j][1] += __uint_as_float(w.x & 0xffff0000u); v[j][2] += __uint_as_float(w.y << 16); v[j][3] += __uint_as_float(w.y & 0xffff0000u); }
#endif
                ss += (v[j][0] * v[j][0] + v[j][1] * v[j][1]) + (v[j][2] * v[j][2] + v[j][3] * v[j][3]); }
            const float rs = 1.0f / sqrtf(wave_sum(ss) * (1.0f / DM) + EPS);
#pragma unroll
            for (int j = 0; j < 8; ++j) { const f32x4 g = *(const f32x4*)(ka->g_final + j * 256 + lane * 4); __builtin_nontemporal_store(v[j] * rs * g, (f32x4*)(ka->out + (size_t)tok * DM + j * 256 + lane * 4)); }
        }
    }
#undef IN
#undef BOTH
#undef GRID_BAR
}

extern "C" void kernel_launch(void* const* d_in, const int* in_sizes, int n_in, void* d_out, int out_size, void* d_ws, size_t ws_size, hipStream_t stream) {
    static int grid = 0;
    if (grid == 0) {
        if (n_in != 21 || in_sizes[0] != NTOK * DM || out_size != NTOK * DM || ws_size < WS_END) { fprintf(stderr, "kernel_launch: unexpected shapes (n_in %d, in0 %d, out %d, ws %zu)\n", n_in, n_in > 0 ? in_sizes[0] : -1, out_size, ws_size); grid = -1; return; }
        int dev = 0, cus = 0;
        if (hipGetDevice(&dev) != hipSuccess || hipDeviceGetAttribute(&cus, hipDeviceAttributeMultiprocessorCount, dev) != hipSuccess) { grid = -1; return; }
        if (hipFuncSetAttribute((const void*)fwd, hipFuncAttributeMaxDynamicSharedMemorySize, LDS_BYTES) != hipSuccess) { fprintf(stderr, "kernel_launch: hipFuncSetAttribute failed\n"); grid = -1; return; }
        int per_cu = 0; (void)hipOccupancyMaxActiveBlocksPerMultiprocessor(&per_cu, (const void*)fwd, NWAVES * 64, LDS_BYTES); (void)hipGetLastError();
        if (per_cu < 1) fprintf(stderr, "kernel_launch: occupancy query says %d\n", per_cu);
        grid = cus;
    }
    if (grid < 0) return;
    (void)hipMemsetAsync((char*)d_ws + WS_CTL, 0, CTL_ZERO_BYTES, stream);
    Args a{};
    const float** fp = (const float**)&a.x;
    for (int i = 0; i < 21; ++i) fp[i] = (const float*)d_in[i];
    a.out = (float*)d_out; a.ws = (unsigned char*)d_ws;
    if (N_LAUNCHES == 1) { a.ph_lo = 0; a.ph_hi = PER_PHASE; hipLaunchKernelGGL(fwd, dim3(grid), dim3(NWAVES * 64), LDS_BYTES, stream, a); }
    else for (int p = 0; p < PER_PHASE; ++p) { a.ph_lo = p; a.ph_hi = p + 1;
        for (int rep = 0; rep < ((p == REP_PHASE) ? 1 + REP_EXTRA : 1); ++rep) { a.ph_hi = (p + 1) | ((rep > 0 ? REP_SUB : 0) << 8); hipLaunchKernelGGL(fwd, dim3(grid), dim3(NWAVES * 64), LDS_BYTES, stream, a); } }
}
```

```cpp
#include <hip/hip_runtime.h>
#include <cstdio>
#include <cstdint>

#define GAS __attribute__((address_space(1)))
#define LAS __attribute__((address_space(3)))
typedef unsigned short bf16_t;
typedef short bf16x8 __attribute__((ext_vector_type(8)));
typedef short s16x4 __attribute__((ext_vector_type(4)));
typedef float f32x2 __attribute__((ext_vector_type(2)));
typedef float f32x4 __attribute__((ext_vector_type(4)));
typedef float f32x16 __attribute__((ext_vector_type(16)));
typedef unsigned u32x2 __attribute__((ext_vector_type(2)));
typedef unsigned u32x4 __attribute__((ext_vector_type(4)));
typedef GAS unsigned gu32;
#define RLX_AGENT __ATOMIC_RELAXED, __HIP_MEMORY_SCOPE_AGENT
#define LDS_WAIT() asm volatile("s_waitcnt lgkmcnt(0)" ::: "memory")
#define VM_WAIT() asm volatile("s_waitcnt vmcnt(0)" ::: "memory")
#define SBAR() __builtin_amdgcn_sched_barrier(0)

#ifndef Y_FP8
#define Y_FP8 1
#endif
#ifndef MOE_FP8
#define MOE_FP8 1
#endif
constexpr int DM = 2048, NB = 4, SEQ = 4096, NTOK = NB * SEQ, NMEM = 256;
constexpr int NPROJ = 5120;
constexpr int C_QG = 0, C_KG = 512, C_VG = 1024, C_GG = 2048, C_QF = 3072, C_KF = 3584, C_VF = 4096, C_QM = 4608;
constexpr int NEXP = 32, TOPK = 4, DFF = 2048, NASSIGN = NTOK * TOPK, MAXTILES = NASSIGN / 256 + NEXP;
constexpr float EPS = 1e-5f;

typedef __bf16 bf16v2_t __attribute__((ext_vector_type(2)));
__device__ __forceinline__ unsigned cvt_pk_bf16(float lo, float hi) { const f32x2 v = {lo, hi}; return __builtin_bit_cast(unsigned, __builtin_convertvector(v, bf16v2_t)); }
__device__ __forceinline__ unsigned pk_fp8x4(float a, float b, float c, float d) { int w = 0; w = __builtin_amdgcn_cvt_pk_fp8_f32(a, b, w, false); w = __builtin_amdgcn_cvt_pk_fp8_f32(c, d, w, true); return (unsigned)w; }
__device__ __forceinline__ float bf2f(unsigned short b) { return __uint_as_float(((unsigned)b) << 16); }
__device__ __forceinline__ bf16x8 pack8(f32x4 a, f32x4 b) { u32x4 w = {cvt_pk_bf16(a[0], a[1]), cvt_pk_bf16(a[2], a[3]), cvt_pk_bf16(b[0], b[1]), cvt_pk_bf16(b[2], b[3])}; return __builtin_bit_cast(bf16x8, w); }
__device__ __forceinline__ unsigned cvt_pk_bf16_raw(float lo, float hi) { unsigned r; asm volatile("v_cvt_pk_bf16_f32 %0, %1, %2" : "=v"(r) : "v"(lo), "v"(hi)); return r; }
__device__ __forceinline__ bf16x8 pack8_raw(f32x4 a, f32x4 b) { u32x4 w = {cvt_pk_bf16_raw(a[0], a[1]), cvt_pk_bf16_raw(a[2], a[3]), cvt_pk_bf16_raw(b[0], b[1]), cvt_pk_bf16_raw(b[2], b[3])}; return __builtin_bit_cast(bf16x8, w); }
__device__ __forceinline__ float wave_sum(float v) {
#pragma unroll
    for (int o = 1; o < 64; o <<= 1) v += __shfl_xor(v, o);
    return v;
}
__device__ __forceinline__ float log_sigmoid(float z) { return fminf(z, 0.f) - log1pf(__expf(-fabsf(z))); }

namespace pg8 {
constexpr int META_OFF = 148480, META_BYTES = 4096;
constexpr int GSLOT_OFF = 131072 + 8192;
constexpr int BM = 256, BK = 64, HALF = 128, HTB = HALF * BK * 2, STAGE_BYTES = 8 * HTB, NXCD = 8, WGM = 8;
__host__ __device__ __forceinline__ int lds_byte(int r, int c) { const int st = (r >> 4) * 2 + (c >> 5), rr = r & 15, cc = c & 31, ob = rr * 64 + cc * 2; return st * 1024 + (ob ^ (((ob >> 9) & 1) << 5)); }
__host__ __device__ __forceinline__ void stage_rc(int b, int& R, int& C) { const int st = b / 1024, sb = b % 1024, swz = sb ^ (((sb >> 9) & 1) << 5); R = (st >> 1) * 16 + swz / 64; C = (st & 1) * 32 + (swz % 64) / 2; }
__host__ __device__ __forceinline__ int perm32(int rho) { const int n = rho >> 4, i = rho & 15; return 8 * (i >> 2) + 4 * n + (i & 3); }

struct Unit { const char* A; const char* B; const int* rowidx; const int* gidx; int pm, pn, e, rows, grows; };

struct StaticOrder {
    const char* A; const char* B; int K; int nM, nN, nwg, G, c;
    __device__ void init(const void* A_, const void* B_, int M, int N, int K_, int G_, int c_) { A = (const char*)A_; B = (const char*)B_; K = K_; nM = M / BM; nN = N / BM; nwg = nM * nN; G = G_; c = c_; }
    __device__ __forceinline__ bool next(int i, Unit& u) const {
        const long L = (long)i * G + c; if (L >= nwg) return false;
        int wgid = (int)L; { const int q = nwg / NXCD, r = nwg % NXCD, xcd = wgid % NXCD, off = wgid / NXCD; wgid = (xcd < r ? xcd * (q + 1) : r * (q + 1) + (xcd - r) * q) + off; }
        const int nig = WGM * nN, gid = wgid / nig, fm = gid * WGM, gsz = (nM - fm) < WGM ? (nM - fm) : WGM;
        u.pm = fm + ((wgid % nig) % gsz); u.pn = (wgid % nig) / gsz; u.e = 0; u.rows = BM; u.rowidx = nullptr; u.gidx = nullptr; u.grows = BM;
        u.A = A + (size_t)u.pm * BM * K * 2; u.B = B + (size_t)u.pn * BM * K * 2; return true;
    }
};

typedef int v4i_t __attribute__((ext_vector_type(4)));
typedef int v8i_t __attribute__((ext_vector_type(8)));
template <class Epi, class Sched, bool GATHER, bool FP8 = false, int SCA = 127, int SCB = 127>
__device__ __forceinline__ void gemm_phase(LAS unsigned char* lds, const int K, const Sched& S, const Epi& E) {
    const int tid = threadIdx.x, wid = __builtin_amdgcn_readfirstlane(tid >> 6), lane = tid & 63, wr = wid >> 2, wc = wid & 3, fr = lane & 15, fq = lane >> 4;
    const int nt = K / BK;
    unsigned voffA[2], voffB[2]; int RA[2], CA[2];
#pragma unroll
    for (int i = 0; i < 2; ++i) { int R, C; stage_rc(tid * 16 + i * 8192, R, C); const int Rb = Epi::PERM ? ((R & ~31) + perm32(R & 31)) : R;
        RA[i] = R; CA[i] = C; voffA[i] = (unsigned)(R * K + C) * 2u; voffB[i] = (unsigned)(Rb * K + C) * 2u; }
    const size_t kstep = (size_t)(BK * 2);
    const size_t hstep = (size_t)HALF * K * 2;
    const unsigned ldsw = (unsigned)wid * 1024u;
    const int aoff = lds_byte(wr * 64 + fr, fq * 8), boff = lds_byte(wc * 32 + fr, fq * 8);
    unsigned gcur[2][2];
#define PG8_SA(b, h) (((b) * 2 + (h)) * HTB)
#define PG8_SB(b, h) ((4 + (b) * 2 + (h)) * HTB)
#define PG8_STAGE(bufoff, gbase, voff) do { _Pragma("unroll") for (int _i = 0; _i < 2; ++_i) \
        __builtin_amdgcn_global_load_lds((const unsigned*)((const char*)(gbase) + (voff)[_i]), (LAS unsigned*)(lds + (bufoff) + ldsw + _i * 8192), 16, 0, 0); } while (0)
#define PG8_STAGE_A(bufoff, base, kb, h, NX) do { if constexpr (GATHER) { PG8_STAGE(bufoff, (base) + (kb), gcur[h]); } \
        else PG8_STAGE(bufoff, (base) + (kb) + (h) * hstep, voffA); } while (0)
#define PG8_LDA(dst, b, h) do { _Pragma("unroll") for (int m = 0; m < 4; ++m) { dst[m].lo = *(const LAS v4i_t*)(lds + PG8_SA(b, h) + aoff + m * 2048); dst[m].hi = *(const LAS v4i_t*)(lds + PG8_SA(b, h) + aoff + m * 2048 + 1024); } } while (0)
#define PG8_LDB(dst, b, h) do { _Pragma("unroll") for (int n = 0; n < 2; ++n) { dst[n].lo = *(const LAS v4i_t*)(lds + PG8_SB(b, h) + boff + n * 2048); dst[n].hi = *(const LAS v4i_t*)(lds + PG8_SB(b, h) + boff + n * 2048 + 1024); } } while (0)
#define PG8_BF(x) __builtin_bit_cast(bf16x8, (v4i_t)(x))
#define PG8_MMA(ai, bj, At, Bt) do { __builtin_amdgcn_s_setprio(1); _Pragma("unroll") for (int m = 0; m < 4; ++m) _Pragma("unroll") for (int n = 0; n < 2; ++n) { \
        if constexpr (FP8) acc[ai][bj][m][n] = __builtin_amdgcn_mfma_scale_f32_16x16x128_f8f6f4(Bt[n], At[m], acc[ai][bj][m][n], 0, 0, 0, SCB * 0x01010101, 0, SCA * 0x01010101); \
        else { acc[ai][bj][m][n] = __builtin_amdgcn_mfma_f32_16x16x32_bf16(PG8_BF(Bt[n].lo), PG8_BF(At[m].lo), acc[ai][bj][m][n], 0, 0, 0); \
               acc[ai][bj][m][n] = __builtin_amdgcn_mfma_f32_16x16x32_bf16(PG8_BF(Bt[n].hi), PG8_BF(At[m].hi), acc[ai][bj][m][n], 0, 0, 0); } } \
        __builtin_amdgcn_s_setprio(0); } while (0)
#define PG8_WAIT_V(n) asm volatile("s_waitcnt vmcnt(" #n ")" ::: "memory")
#define PG8_WAIT_L(n) asm volatile("s_waitcnt lgkmcnt(" #n ")" ::: "memory")
#define PG8_BAR __builtin_amdgcn_s_barrier()
#define PG8_SCHED __builtin_amdgcn_sched_barrier(0)
#define PG8_GIDX(dst, u) do { _Pragma("unroll") for (int _h = 0; _h < 2; ++_h) _Pragma("unroll") for (int _i = 0; _i < 2; ++_i) { \
        const int _r = _h * HALF + RA[_i]; const int _t = (u).gidx[_r < (u).grows ? _r : 0] >> 2; dst[_h][_i] = (unsigned)(_t * K + CA[_i]) * 2u; } } while (0)
#define PG8_GPOST(u) do { _Pragma("unroll") for (int _h = 0; _h < 2; ++_h) _Pragma("unroll") for (int _i = 0; _i < 2; ++_i) { const int _r = _h * HALF + RA[_i]; \
        __builtin_amdgcn_global_load_lds((const unsigned*)((u).gidx + (_r < (u).grows ? _r : 0)), (LAS unsigned*)(lds + GSLOT_OFF + (_h * 2 + _i) * 2048 + wid * 256), 4, 0, 0); } } while (0)
#define PG8_GTAKE() do { _Pragma("unroll") for (int _h = 0; _h < 2; ++_h) _Pragma("unroll") for (int _i = 0; _i < 2; ++_i) { \
        const int _t = *(const LAS int*)(lds + GSLOT_OFF + (_h * 2 + _i) * 2048 + wid * 256 + lane * 4) >> 2; gcur[_h][_i] = (unsigned)(_t * K + CA[_i]) * 2u; } } while (0)
    Unit cur, nxt; int ui = 0;
    if (!S.next(0, cur)) return;
    f32x4 acc[2][2][4][2];
#pragma unroll
    for (int a = 0; a < 2; ++a)
#pragma unroll
        for (int b = 0; b < 2; ++b)
#pragma unroll
            for (int m = 0; m < 4; ++m)
#pragma unroll
                for (int n = 0; n < 2; ++n) acc[a][b][m][n] = (f32x4){0.f, 0.f, 0.f, 0.f};
    v8i_t At[4], B0[2], B1[2];
    const char* cA = cur.A; const char* cB = cur.B;
    if constexpr (GATHER) { PG8_GIDX(gcur, cur); }
    PG8_STAGE(PG8_SB(0, 0), cB, voffB); PG8_STAGE(PG8_SB(0, 1), cB + hstep, voffB); PG8_STAGE_A(PG8_SA(0, 0), cA, 0, 0, false); PG8_STAGE_A(PG8_SA(0, 1), cA, 0, 1, false);
    if (wr == 1) PG8_BAR;
    PG8_WAIT_V(2); PG8_BAR;
    PG8_STAGE(PG8_SB(1, 0), cB + kstep, voffB); PG8_STAGE_A(PG8_SA(1, 0), cA, kstep, 0, false); PG8_STAGE(PG8_SB(1, 1), cB + hstep + kstep, voffB);
    PG8_WAIT_V(6); PG8_BAR;
    for (;;) {
        const bool has_next = S.next(ui + 1, nxt);
        const char* nA = has_next ? nxt.A : cA; const char* nB = has_next ? nxt.B : cB;
        if constexpr (GATHER) { if (has_next) { PG8_GPOST(nxt); } else { PG8_GPOST(cur); } }
        if constexpr (Epi::META) E.post(cur, lds + META_OFF + (ui & 1) * META_BYTES, wid, lane);
        for (int t = 0; t < nt; t += 2) {
            const bool last = (t == nt - 2);
            const size_t k1 = (size_t)(t + 1) * kstep;
            const char* a2 = last ? nA : cA; const char* b2 = last ? nB : cB + (size_t)(t + 2) * kstep;
            const size_t ka2 = last ? 0 : (size_t)(t + 2) * kstep, ka3 = ka2 + kstep; const char* b3 = b2 + kstep;
            PG8_LDB(B0, 0, 0); PG8_LDB(B1, 0, 1); PG8_SCHED; PG8_LDA(At, 0, 0); PG8_STAGE_A(PG8_SA(1, 1), cA, k1, 1, false);
            if constexpr (GATHER) { if (last) { PG8_GTAKE(); } }
            PG8_WAIT_V(8); PG8_WAIT_L(0); PG8_BAR; PG8_MMA(0, 0, At, B0); PG8_MMA(0, 1, At, B1); PG8_BAR; PG8_SCHED;
            PG8_LDA(At, 0, 1); PG8_STAGE(PG8_SB(0, 0), b2, voffB); PG8_STAGE(PG8_SB(0, 1), b2 + hstep, voffB); PG8_STAGE_A(PG8_SA(0, 0), a2, ka2, 0, last);
            PG8_WAIT_V(8); PG8_WAIT_L(0); PG8_BAR; PG8_MMA(1, 0, At, B0); PG8_MMA(1, 1, At, B1); PG8_BAR; PG8_SCHED;
            PG8_LDB(B0, 1, 0); PG8_LDB(B1, 1, 1); PG8_SCHED; PG8_LDA(At, 1, 0); PG8_STAGE_A(PG8_SA(0, 1), a2, ka2, 1, last);
            PG8_WAIT_V(8); PG8_WAIT_L(0); PG8_BAR; PG8_MMA(0, 0, At, B0); PG8_MMA(0, 1, At, B1); PG8_BAR; PG8_SCHED;
            PG8_LDA(At, 1, 1); PG8_STAGE(PG8_SB(1, 0), b3, voffB); PG8_STAGE(PG8_SB(1, 1), b3 + hstep, voffB); PG8_STAGE_A(PG8_SA(1, 0), a2, ka3, 0, last);
            PG8_WAIT_V(8); PG8_WAIT_L(0); PG8_BAR; PG8_MMA(1, 0, At, B0); PG8_MMA(1, 1, At, B1); PG8_BAR; PG8_SCHED;
        }
        if (wr == 0) PG8_BAR;
        if constexpr (Epi::META) E(acc, cur, wr, wc, fr, fq, lds + META_OFF + (ui & 1) * META_BYTES); else E(acc, cur, wr, wc, fr, fq);
        if (!has_next) break;
#pragma unroll
        for (int a = 0; a < 2; ++a)
#pragma unroll
            for (int b = 0; b < 2; ++b)
#pragma unroll
                for (int m = 0; m < 4; ++m)
#pragma unroll
                    for (int n = 0; n < 2; ++n) acc[a][b][m][n] = (f32x4){0.f, 0.f, 0.f, 0.f};
        cur = nxt; cA = nA; cB = nB; ++ui;
        if (wr == 1) PG8_BAR;
    }
    PG8_WAIT_V(0);
    PG8_BAR;
#undef PG8_SA
#undef PG8_SB
#undef PG8_STAGE
#undef PG8_STAGE_A
#undef PG8_LDA
#undef PG8_LDB
#undef PG8_MMA
#undef PG8_BF
#undef PG8_WAIT_V
#undef PG8_WAIT_L
#undef PG8_BAR
#undef PG8_SCHED
#undef PG8_GIDX
#undef PG8_GPOST
#undef PG8_GTAKE
}
}

namespace fox {
constexpr int D = 128, NW = 8, QBLK = 32, KVBLK = 64, QB = NW * QBLK;
constexpr int SHM_V = KVBLK * D * 2, SHM_K = KVBLK * D * 2;
constexpr int LDS_WS = 2 * SHM_V + 2 * SHM_K, LDS_FB = LDS_WS + NW * 64 * 4, LDS_BYTES = LDS_FB + 4096 * 4 + 64;
constexpr float SCALE = 0.08838834764831845f;
constexpr float THR = 8.f;
constexpr int LDQ = NPROJ;
#define KSWZ(row, colB) ((row) * 256 + ((colB) ^ (((row) & 7) << 4)))
__device__ __forceinline__ int v_st(int k, int c) { const int kk = (k & ~0xC) | ((k & 4) << 1) | ((k & 8) >> 1); return ((kk >> 3) * 4 + (c >> 5)) * 512 + ((kk & 7) * 32 + (c & 31)) * 2; }
__device__ __forceinline__ int v_rd_base(int lane) { return ((lane & 3) << 3) | (((lane >> 2) & 3) << 6) | (((lane >> 4) & 1) << 5) | (((lane >> 5) & 1) << 8); }
constexpr int v_rd_off(int d0, int ks, int half) { return d0 * 512 + ks * 4096 + half * 2048; }
__device__ __forceinline__ int crow(int r, int hi) { return (r & 3) + 8 * (r >> 2) + 4 * hi; }
__device__ __forceinline__ unsigned cvtpk(float lo, float hi) { return cvt_pk_bf16(lo, hi); }
__device__ __forceinline__ bf16x8 load8(const bf16_t* p) { return *reinterpret_cast<const bf16x8*>(p); }
__device__ __forceinline__ void mask_tile(f32x16& p0, f32x16& p1, int dq) {
    const float NEG = -__builtin_inff();
#pragma unroll
    for (int r = 0; r < 16; ++r) {
        const int c = (r & 3) + 8 * (r >> 2);
        if (dq - c < 0) p0[r] = NEG;
        if (dq - c - 32 < 0) p1[r] = NEG;
    }
}
__device__ __forceinline__ void partialSM(f32x16& p0, f32x16& p1, float& m_reg, float& mn, float& alpha) {
    float pmax = p0[0]; for (int r = 1; r < 16; ++r) pmax = fmaxf(pmax, p0[r]); for (int r = 0; r < 16; ++r) pmax = fmaxf(pmax, p1[r]);
    { auto rr = __builtin_amdgcn_permlane32_swap(__float_as_uint(pmax), __float_as_uint(pmax), false, false);
      pmax = fmaxf(__uint_as_float(rr[0]), __uint_as_float(rr[1])); }
    constexpr float C2 = 1.4426950408889634f * SCALE;
    if (__builtin_expect(__all((pmax - m_reg) * SCALE <= THR), 1)) { mn = m_reg; alpha = 1.f; }
    else { mn = fmaxf(m_reg, pmax); alpha = __builtin_amdgcn_exp2f((m_reg - mn) * C2); m_reg = mn; }
    const float mnL = -mn * C2;
    for (int r = 0; r < 16; ++r) p0[r] = fmaf(p0[r], C2, mnL); for (int r = 0; r < 16; ++r) p1[r] = fmaf(p1[r], C2, mnL);
    for (int r = 0; r < 16; ++r) p0[r] = __builtin_amdgcn_exp2f(p0[r]);
}
__device__ __forceinline__ void finishSM(f32x16& p0, f32x16& p1, float alpha, float& l_reg, bf16x8& pa0, bf16x8& pa1, bf16x8& pa2, bf16x8& pa3) {
    for (int r = 0; r < 16; ++r) p1[r] = __builtin_amdgcn_exp2f(p1[r]);
    float ps = 0; for (int r = 0; r < 16; ++r) ps += p0[r]; for (int r = 0; r < 16; ++r) ps += p1[r];
    { auto rr = __builtin_amdgcn_permlane32_swap(__float_as_uint(ps), __float_as_uint(ps), false, false);
      ps = __uint_as_float(rr[0]) + __uint_as_float(rr[1]); }
    l_reg = l_reg * alpha + ps;
#define PK4(P, B_, OUT) do { unsigned a0 = cvtpk(P[B_+0], P[B_+1]), a1 = cvtpk(P[B_+2], P[B_+3]);                          \
        unsigned b0 = cvtpk(P[B_+4], P[B_+5]), b1 = cvtpk(P[B_+6], P[B_+7]);                                             \
        auto r0 = __builtin_amdgcn_permlane32_swap(a0, b0, false, false); auto r1 = __builtin_amdgcn_permlane32_swap(a1, b1, false, false); \
        u32x4 w = {r0[0], r1[0], r0[1], r1[1]}; OUT = *reinterpret_cast<bf16x8*>(&w); } while (0)
    PK4(p0, 0, pa0); PK4(p0, 8, pa1); PK4(p1, 0, pa2); PK4(p1, 8, pa3);
#undef PK4
}
template <int KB>
__device__ __forceinline__ void qkt(f32x16& p0, f32x16& p1, const char* K_lds, const float* fb, int r32, int hi, const bf16x8* qr) {
#pragma unroll
    for (int g = 0; g < 4; ++g) { const f32x4 a = *(const f32x4*)(fb + 8 * g), b = *(const f32x4*)(fb + 32 + 8 * g);
        p0[4 * g] = a[0]; p0[4 * g + 1] = a[1]; p0[4 * g + 2] = a[2]; p0[4 * g + 3] = a[3];
        p1[4 * g] = b[0]; p1[4 * g + 1] = b[1]; p1[4 * g + 2] = b[2]; p1[4 * g + 3] = b[3]; }
    const char* kb[4];
#pragma unroll
    for (int dd = 0; dd < 4; ++dd) kb[dd] = K_lds + KB * SHM_K + KSWZ(r32, (dd * 16 + hi * 8) * 2);
#pragma unroll
    for (int d0 = 0; d0 < 8; ++d0) { const char* a = kb[d0 & 3] + (d0 >> 2) * 128;
        bf16x8 b0 = *reinterpret_cast<const bf16x8*>(a);
        bf16x8 b1 = *reinterpret_cast<const bf16x8*>(a + 32 * 256);
        p0 = __builtin_amdgcn_mfma_f32_32x32x16_bf16(b0, qr[d0], p0, 0, 0, 0);
        p1 = __builtin_amdgcn_mfma_f32_32x32x16_bf16(b1, qr[d0], p1, 0, 0, 0); }
}
template <int VB>
__device__ __forceinline__ void pv_tile(f32x16* o, int vb0, bf16x8 pa0, bf16x8 pa1, bf16x8 pa2, bf16x8 pa3) {
#define TRRD(dst, off) asm volatile("ds_read_b64_tr_b16 %0, %1 offset:%2" : "=&v"(dst) : "v"(vb0), "i"(off) : "memory")
#define PV_D0(d0) do { s16x4 l0, l1, l2, l3, h0, h1, h2, h3; constexpr int b_ = VB * SHM_V + v_rd_off(d0, 0, 0); \
        TRRD(l0, b_); TRRD(h0, b_ + 2048); TRRD(l1, b_ + 4096); TRRD(h1, b_ + 6144); TRRD(l2, b_ + 8192); TRRD(h2, b_ + 10240); TRRD(l3, b_ + 12288); TRRD(h3, b_ + 14336); \
        asm volatile("s_waitcnt lgkmcnt(0)" ::: "memory"); SBAR();   \
        o[d0] = __builtin_amdgcn_mfma_f32_32x32x16_bf16(pa0, (bf16x8){l0[0], l0[1], l0[2], l0[3], h0[0], h0[1], h0[2], h0[3]}, o[d0], 0, 0, 0);   \
        o[d0] = __builtin_amdgcn_mfma_f32_32x32x16_bf16(pa1, (bf16x8){l1[0], l1[1], l1[2], l1[3], h1[0], h1[1], h1[2], h1[3]}, o[d0], 0, 0, 0);   \
        o[d0] = __builtin_amdgcn_mfma_f32_32x32x16_bf16(pa2, (bf16x8){l2[0], l2[1], l2[2], l2[3], h2[0], h2[1], h2[2], h2[3]}, o[d0], 0, 0, 0);   \
        o[d0] = __builtin_amdgcn_mfma_f32_32x32x16_bf16(pa3, (bf16x8){l3[0], l3[1], l3[2], l3[3], h3[0], h3[1], h3[2], h3[3]}, o[d0], 0, 0, 0); } while (0)
    PV_D0(0); PV_D0(1); PV_D0(2); PV_D0(3);
#undef PV_D0
#undef TRRD
}
struct BlockRef { const bf16_t* Q; const bf16_t* K; const bf16_t* V; int P0, j_lo, j_hi; };
struct Seam { bf16x8 qr[8]; bf16x8 st_v0, st_v1, st_k0, st_k1; };
#define ROW(p, k0, rr) ((p) + (size_t)((k0) + (rr)) * LDQ + sc)
#define VMWN(n) asm volatile("s_waitcnt vmcnt(%0)" :: "i"(n) : "memory")
#define SLOAD_H(Kp, Vp, k0) do { S.st_v0 = load8(ROW(Vp, k0, sr)); S.st_v1 = load8(ROW(Vp, k0, 32 + sr)); S.st_k0 = load8(ROW(Kp, k0, sr)); S.st_k1 = load8(ROW(Kp, k0, 32 + sr)); } while (0)
#define SWRITE_HK(bf) do { *(bf16x8*)(K_lds + (bf) * SHM_K + kws) = S.st_k0; *(bf16x8*)(K_lds + (bf) * SHM_K + kws + 32 * 256) = S.st_k1; } while (0)
#define SWRITE_HV(bf) do { *(bf16x8*)(V_lds + (bf) * SHM_V + vst0) = S.st_v0; *(bf16x8*)(V_lds + (bf) * SHM_V + vst1) = S.st_v1; } while (0)
#define SWRITE_H(bf) do { SWRITE_HV(bf); SWRITE_HK(bf); } while (0)
__device__ __forceinline__ void prime(const BlockRef& cur, char* lds, Seam& S) {
    const int tid = threadIdx.x, wid = __builtin_amdgcn_readfirstlane(tid >> 6), lane = tid & 63, r32 = lane & 31, hi = lane >> 5;
    const int sr = tid >> 4, sc = (tid & 15) * 8, kws = KSWZ(sr, sc * 2); char* K_lds = lds + 2 * SHM_V;
    const int kb0 = cur.j_lo * KVBLK;
    for (int d0 = 0; d0 < 8; ++d0) S.qr[d0] = load8(cur.Q + (size_t)(wid * QBLK + r32) * LDQ + d0 * 16 + hi * 8);
    SLOAD_H(cur.K, cur.V, kb0); VM_WAIT(); SWRITE_HK(0);
    __syncthreads();
}
template <class Epi>
__device__ __forceinline__ void block(const BlockRef& cur, const BlockRef& nxt, char* lds, Seam& S, const Epi& E) {
    const int tid = threadIdx.x, wid = __builtin_amdgcn_readfirstlane(tid >> 6), lane = tid & 63, r32 = lane & 31, hi = lane >> 5;
    const int j_lo = cur.j_lo, j_hi = cur.j_hi;
    const int NT = j_hi - j_lo;
    const int kbn = nxt.j_lo * KVBLK;
    const int qlo = cur.P0 + wid * QBLK, qm = qlo + r32 - 4 * hi;
    char* V_lds = lds; char* K_lds = lds + 2 * SHM_V;
    float* ws = (float*)(lds + LDS_WS) + wid * 64; float* li_l = ws, * al_l = ws + 32;
    const float* FB = (const float*)(lds + LDS_FB) + 4 * hi;
    float m_reg = -1e30f, l_reg = 0; f32x16 o[4] = {};
    const int sr = tid >> 4, sc = (tid & 15) * 8, vst0 = v_st(sr, sc), vst1 = v_st(32 + sr, sc), kws = KSWZ(sr, sc * 2);
    const int vb0 = (int)(uintptr_t)V_lds + v_rd_base(lane);
    const bf16_t* Kh = cur.K; const bf16_t* Vh = cur.V;
#define RESC(a) do { if (__any((a) < 1.f)) { if (hi == 0) al_l[r32] = (a); asm volatile("s_waitcnt lgkmcnt(0)" ::: "memory");              \
                     for (int d_ = 0; d_ < 4; ++d_) for (int r = 0; r < 16; ++r) o[d_][r] *= al_l[crow(r, hi)]; } } while (0)
#define KBASE(t) ((j_lo + (t)) * KVBLK)
#define MASKT(P0_, P1_, t) do { const int kb_ = KBASE(t); if (kb_ + KVBLK - 1 > qlo) mask_tile(P0_, P1_, qm - kb_); } while (0)
    constexpr int NQL = 8;
#define SEAM_K0() do { VMWN(NQL); SWRITE_HK(0); SBAR(); } while (0)
    f32x16 pA0, pA1, pB0, pB1; float mnA, mnB, alA, alB; bf16x8 pa0, pa1, pa2, pa3;
    SWRITE_HV(0); SBAR();
    if (NT > 1) { SLOAD_H(Kh, Vh, KBASE(1)); }
    SBAR(); qkt<0>(pA0, pA1, K_lds, FB + KBASE(0), r32, hi, S.qr);
    MASKT(pA0, pA1, 0); partialSM(pA0, pA1, m_reg, mnA, alA);
    if (NT > 1) { VM_WAIT(); SWRITE_H(1); }
    __syncthreads();
#define HALF_STEP(PX0, PX1, mnX, alX, PY0, PY1, alY, t, KB, VB, SB) do {                                                      \
        SBAR(); qkt<KB>(PX0, PX1, K_lds, FB + KBASE(t), r32, hi, S.qr);                                                      \
        finishSM(PY0, PY1, alY, l_reg, pa0, pa1, pa2, pa3); SBAR();                                                           \
        if ((t) + 1 < NT) { SLOAD_H(Kh, Vh, KBASE((t) + 1)); SBAR(); }                                                       \
        pv_tile<VB>(o, vb0, pa0, pa1, pa2, pa3); MASKT(PX0, PX1, (t)); partialSM(PX0, PX1, m_reg, mnX, alX);                  \
        __syncthreads();                                                                                                      \
        if ((t) + 1 < NT) { VM_WAIT(); SWRITE_H(SB); }                                                                        \
        RESC(alX); __syncthreads(); } while (0)
    for (int t = 1; t + 1 < NT; t += 2) {
        HALF_STEP(pB0, pB1, mnB, alB, pA0, pA1, alA, t, 1, 0, 0);
        HALF_STEP(pA0, pA1, mnA, alA, pB0, pB1, alB, t + 1, 0, 1, 1);
    }
    const bool even = (NT & 1) == 0;
    if (even) { SBAR(); qkt<1>(pB0, pB1, K_lds, FB + KBASE(NT - 1), r32, hi, S.qr); SBAR(); }
    SLOAD_H(nxt.K, nxt.V, kbn); SBAR();
#pragma unroll
    for (int d0 = 0; d0 < 8; ++d0) S.qr[d0] = load8(nxt.Q + (size_t)(wid * QBLK + r32) * LDQ + d0 * 16 + hi * 8);
    SBAR();
    finishSM(pA0, pA1, alA, l_reg, pa0, pa1, pa2, pa3); SBAR();
    pv_tile<0>(o, vb0, pa0, pa1, pa2, pa3);
    if (even) { MASKT(pB0, pB1, NT - 1); partialSM(pB0, pB1, m_reg, mnB, alB); __syncthreads(); RESC(alB);
        finishSM(pB0, pB1, alB, l_reg, pa0, pa1, pa2, pa3); SBAR(); pv_tile<1>(o, vb0, pa0, pa1, pa2, pa3); }
    SBAR(); SEAM_K0();
    if (hi == 0) li_l[r32] = l_reg; asm volatile("s_waitcnt lgkmcnt(0)" ::: "memory");
    E(o, li_l, m_reg, cur.P0 + wid * QBLK, r32, hi);
    __syncthreads();
#undef RESC
#undef KBASE
#undef MASKT
#undef SEAM_K0
#undef HALF_STEP
}
#undef ROW
#undef VMWN
#undef SLOAD_H
#undef SWRITE_HK
#undef SWRITE_HV
#undef SWRITE_H
struct EpiNormBf16 {
    bf16_t* out; int ldo; const float* gain;
    __device__ __forceinline__ void operator()(const f32x16* o, const float* li_l, float  , int row0, int r32, int hi) const {
        const float g0 = gain[r32], g1 = gain[32 + r32], g2 = gain[64 + r32], g3 = gain[96 + r32];
#pragma unroll
        for (int r = 0; r < 16; ++r) { const int orow = crow(r, hi); const float rl = __builtin_amdgcn_rcpf(li_l[orow]);
            const float v0 = o[0][r] * rl, v1 = o[1][r] * rl, v2 = o[2][r] * rl, v3 = o[3][r] * rl;
            float ss = (v0 * v0 + v1 * v1) + (v2 * v2 + v3 * v3);
            ss += __shfl_xor(ss, 1); ss += __shfl_xor(ss, 2); ss += __shfl_xor(ss, 4); ss += __shfl_xor(ss, 8); ss += __shfl_xor(ss, 16);
            const float rs = 1.0f / sqrtf(ss * (1.0f / 128.0f) + EPS);
            u32x2 w; w.x = cvtpk(v0 * rs * g0, v1 * rs * g1); w.y = cvtpk(v2 * rs * g2, v3 * rs * g3);
            *(u32x2*)(out + (size_t)(row0 + orow) * ldo + r32 * 4) = w; }
    }
};
struct EpiPartial {
    float* O; float* ML;
    __device__ __forceinline__ void operator()(const f32x16* o, const float* li_l, float m, int row0, int r32, int hi) const {
#pragma unroll
        for (int r = 0; r < 16; ++r) { const int orow = crow(r, hi); u32x2 w; w.x = cvtpk(o[0][r], o[1][r]); w.y = cvtpk(o[2][r], o[3][r]); *(u32x2*)((bf16_t*)O + (size_t)(row0 + orow) * 512 + r32 * 4) = w; }
        if (hi == 0) *(f32x2*)(ML + (size_t)(row0 + r32) * 8) = (f32x2){m, li_l[r32]};
    }
};
}

constexpr size_t MiB = 1u << 20;
constexpr size_t WS_CTL = 0, CTL_ZERO_BYTES = 65536;
constexpr size_t WS_WSM = 1 * MiB;
constexpr size_t WS_RSTD = 2 * MiB;
constexpr size_t WS_SMALL = 3 * MiB;
constexpr size_t WS_GATE = 5 * MiB;
constexpr size_t WS_ROWLIST = 6 * MiB;
constexpr size_t WS_WMKV = 8 * MiB, WS_WOUT = 12 * MiB, WS_WIN = 20 * MiB;
constexpr size_t WS_MEMB = 40 * MiB;
constexpr size_t WS_KVM = 44 * MiB;
constexpr size_t WS_GLAD = 46 * MiB;
constexpr size_t WS_XB = 48 * MiB;
constexpr size_t WS_PROJ = 112 * MiB;
constexpr size_t WS_MIX = 272 * MiB;
constexpr size_t WS_X1 = 336 * MiB;
constexpr size_t WS_X1B = 464 * MiB;
constexpr size_t WS_GLAKV = 528 * MiB;
constexpr size_t WS_GLAO = 656 * MiB;
constexpr size_t WS_WUP = 720 * MiB;
constexpr size_t WS_WDOWN = 1232 * MiB;
constexpr size_t WS_ACT = 1488 * MiB;
constexpr size_t WS_Y = 1776 * MiB;
constexpr size_t WS_IDENT = 5 * MiB + 512 * 1024;
constexpr size_t WS_LA = 2032 * MiB;
constexpr size_t WS_FOXO = 2064 * MiB;
constexpr size_t WS_FOXML = 2192 * MiB;
constexpr size_t WS_ROWGATE = 2194 * MiB, WS_ROWRSTD = 2196 * MiB;
constexpr size_t WS_END = 2198 * MiB;
constexpr int CW_BAR = 4096;
constexpr int CW_CNT = 8192;

constexpr int RING_BYTES = 131072;
constexpr int TAB_OFF = RING_BYTES;
constexpr int MISC_OFF = 147456;
constexpr int LDS_BYTES = 147456 + 1024 + 8192;

#define XB_TMO      128
#define XB_XCNT(j)  (256  + 64 * (j))
#define XB_XSUB(j)  (1280 + 64 * (j))
#define XB_XGEN(j)  (2304 + 64 * (j))
#define XB_TOP      3328
#define XB_TOPGEN   3392
#define XCD_BAR_WORDS 3456
#define XB_SPIN_CAP (1u << 18)
__device__ __forceinline__ unsigned xb_ld(unsigned* p)              { return __hip_atomic_load(p, __ATOMIC_RELAXED, __HIP_MEMORY_SCOPE_AGENT); }
__device__ __forceinline__ unsigned xb_add(unsigned* p, unsigned v) { return __hip_atomic_fetch_add(p, v, __ATOMIC_RELAXED, __HIP_MEMORY_SCOPE_AGENT); }
__device__ __forceinline__ unsigned xb_xcc_id() { return (unsigned)__builtin_amdgcn_s_getreg((3 << 11) | 20) & 0xFu; }
#define XB_SPIN(cond, bar) do { unsigned _sp = 0; while (cond) { __builtin_amdgcn_s_sleep(1); \
    if ((++_sp & 255u) == 0u) { if (xb_ld(&(bar)[XB_TMO])) break; if (_sp > XB_SPIN_CAP) { atomicAdd(&(bar)[XB_TMO], 1u); break; } } } } while (0)
struct XcdBarrier { unsigned* bar; unsigned x; volatile LAS unsigned* st; };
__device__ __forceinline__ XcdBarrier xcd_barrier_post(unsigned* bar, volatile LAS unsigned* st) {
    XcdBarrier b; b.bar = bar; b.x = xb_xcc_id(); b.st = st;
    if (threadIdx.x == 0) (void)xb_add(&bar[XB_XCNT(b.x)], 1u);
    return b;
}
__device__ __forceinline__ void xcd_barrier_complete(unsigned* bar, unsigned x, unsigned& nloc, unsigned& nx) {
    const unsigned G = gridDim.x * gridDim.y * gridDim.z;
    unsigned sum, cnt, mine, sp = 0u;
    for (;;) {
        sum = 0u; cnt = 0u; mine = 0u;
#pragma unroll
        for (unsigned j = 0; j < 16; ++j) { const unsigned c = xb_ld(&bar[XB_XCNT(j)]); sum += c; cnt += (c > 0u) ? 1u : 0u; mine = (j == x) ? c : mine; }
        if (sum == G) break;
        __builtin_amdgcn_s_sleep(1);
        if ((++sp & 255u) == 0u) { if (xb_ld(&bar[XB_TMO])) break; if (sp > XB_SPIN_CAP) { atomicAdd(&bar[XB_TMO], 1u); break; } }
    }
    nloc = mine > 0u ? mine : 1u; nx = cnt > 0u ? cnt : 1u;
}
__device__ __forceinline__ void xcd_barrier(const XcdBarrier& b) {
    asm volatile("s_waitcnt vmcnt(0)" ::: "memory");
    __syncthreads();
    if (threadIdx.x == 0) {
        unsigned* bar = b.bar;
        __builtin_amdgcn_s_waitcnt(0);
        unsigned nloc = b.st[0], nx = b.st[1];
        if (nloc == 0u) { xcd_barrier_complete(bar, b.x, nloc, nx); b.st[0] = nloc; b.st[1] = nx; }
        const unsigned old = xb_add(&bar[XB_XSUB(b.x)], 1u);
        const unsigned gen = old / nloc;
        if (old + 1u == (gen + 1u) * nloc) {
            __builtin_amdgcn_fence(__ATOMIC_RELEASE, "agent");
            asm volatile("s_waitcnt vmcnt(0)" ::: "memory");
            const unsigned og = xb_add(&bar[XB_TOP], 1u);
            const unsigned tg = og / nx;
            if (og + 1u == (tg + 1u) * nx) xb_add(&bar[XB_TOPGEN], 1u);
            else XB_SPIN(xb_ld(&bar[XB_TOPGEN]) == tg, bar);
            __builtin_amdgcn_fence(__ATOMIC_ACQUIRE, "agent");
            xb_add(&bar[XB_XGEN(b.x)], 1u);
            asm volatile("s_waitcnt vmcnt(0)" ::: "memory");
        } else {
            XB_SPIN(xb_ld(&bar[XB_XGEN(b.x)]) == gen, bar);
            __builtin_amdgcn_fence(__ATOMIC_ACQUIRE, "agent");
            asm volatile("s_waitcnt vmcnt(0)" ::: "memory");
        }
    }
    __syncthreads();
}

__device__ __forceinline__ unsigned f2bf(float f) { unsigned u = __builtin_bit_cast(unsigned, f); return (u + 0x7fffu + ((u >> 16) & 1u)) >> 16; }
__device__ __forceinline__ unsigned pk2(float lo, float hi) { return f2bf(lo) | (f2bf(hi) << 16); }
__device__ __forceinline__ int head_perm(int x) { return (x & 3) * 32 + (x >> 2); }
template <bool KPERM>
__device__ __forceinline__ void transpose_item(const float* W, size_t ldw, int k0, int scol0, bf16_t* WT, int K, const float* g, float cs, LAS float* scr, int lane) {
#pragma unroll 16
    for (int i = 0; i < 32; ++i) { const int kk = 2 * i + (lane >> 5); int sk = k0 + kk; if (KPERM) sk = (sk & ~127) + head_perm(sk & 127);
        float v = W[(size_t)sk * ldw + scol0 + (lane & 31)]; if (g) v *= g[sk]; scr[kk * 33 + (lane & 31)] = v * cs; }
    LDS_WAIT(); asm volatile("" ::: "memory");
    const int c = lane & 7;
#pragma unroll
    for (int j = 0; j < 4; ++j) { const int n = (lane >> 3) + 8 * j; const LAS float* s = scr + (8 * c) * 33 + n;
        u32x4 o; o.x = pk2(s[0 * 33], s[1 * 33]); o.y = pk2(s[2 * 33], s[3 * 33]); o.z = pk2(s[4 * 33], s[5 * 33]); o.w = pk2(s[6 * 33], s[7 * 33]);
        *(GAS u32x4*)(WT + (size_t)n * K + k0 + 8 * c) = o; }
    LDS_WAIT(); asm volatile("" ::: "memory");
}
template <bool KPERM>
__device__ __forceinline__ void tr_item(const float* W, size_t ldw, int k0, int scol0, bf16_t* WT, int K, const float* g, float cs, LAS unsigned char* scr, int lane) {
    const int kr = lane >> 5, c4 = lane & 31;
    f32x4 a[16], b[16]; float ga[16], gb[16];
#pragma unroll
    for (int i = 0; i < 16; ++i) { int sa = k0 + 4 * i + 2 * kr, sb = sa + 1; if (KPERM) { sa = (sa & ~127) + head_perm(sa & 127); sb = (sb & ~127) + head_perm(sb & 127); }
        a[i] = *(const f32x4*)(W + (size_t)sa * ldw + scol0 + c4 * 4); b[i] = *(const f32x4*)(W + (size_t)sb * ldw + scol0 + c4 * 4);
        ga[i] = g ? g[sa] * cs : cs; gb[i] = g ? g[sb] * cs : cs; }
#pragma unroll
    for (int i = 0; i < 16; ++i) {
#pragma unroll
        for (int j = 0; j < 4; ++j) *(LAS unsigned*)(scr + (4 * c4 + j) * 144 + (2 * i + kr) * 4) = cvt_pk_bf16(a[i][j] * ga[i], b[i][j] * gb[i]); }
    LDS_WAIT(); asm volatile("" ::: "memory");
    const int q = lane & 7;
#pragma unroll
    for (int t = 0; t < 16; ++t) { const int n = 8 * t + (lane >> 3); const u32x4 v = *(const LAS u32x4*)(scr + n * 144 + q * 16);
        *(GAS u32x4*)(WT + (size_t)n * K + k0 + 8 * q) = v; }
    LDS_WAIT(); asm volatile("" ::: "memory");
}
__device__ __forceinline__ void tr_item_fp8(const float* W, size_t ldw, int k0, int scol0, unsigned char* WT, int K, const float* g, float cs, LAS unsigned char* scr, int lane) {
    const int kr = lane >> 4, c4 = lane & 15;
    const float* wl = W + (size_t)(4 * kr) * ldw + scol0 + c4 * 4;
    f32x4 a[8][4]; f32x4 gs[8];
#pragma unroll
    for (int i = 0; i < 8; ++i) {
#pragma unroll
        for (int t = 0; t < 4; ++t) a[i][t] = __builtin_nontemporal_load((const f32x4*)(wl + (size_t)(k0 + 16 * i + t) * ldw));
        gs[i] = g ? *(const f32x4*)(g + k0 + 16 * i + 4 * kr) * cs : (f32x4){cs, cs, cs, cs}; }
#pragma unroll
    for (int i = 0; i < 8; ++i)
#pragma unroll
        for (int j = 0; j < 4; ++j) *(LAS unsigned*)(scr + (4 * c4 + j) * 144 + (4 * i + kr) * 4) = pk_fp8x4(a[i][0][j] * gs[i][0], a[i][1][j] * gs[i][1], a[i][2][j] * gs[i][2], a[i][3][j] * gs[i][3]);
    LDS_WAIT(); asm volatile("" ::: "memory");
    const int q = lane & 7;
#pragma unroll
    for (int t = 0; t < 8; ++t) { const int n = 8 * t + (lane >> 3); const u32x4 v = *(const LAS u32x4*)(scr + n * 144 + q * 16);
        __builtin_nontemporal_store(v, (u32x4*)(WT + (size_t)n * K + k0 + 16 * q)); }
    LDS_WAIT(); asm volatile("" ::: "memory");
}
__device__ __forceinline__ void thin_item(int which, const float* W, const float* g, int k0, bf16_t* hi, bf16_t* lo, LAS float* scr, int lane) {
#pragma unroll 8
    for (int i = 0; i < 32; ++i) { const int kk = 2 * i + (lane >> 5), n = lane & 31, sk = k0 + kk; float v = 0.f;
        if (which == 0) { if (n < 16) v = W[(size_t)sk * 5140 + 3072 + n]; else if (n < 20) v = W[(size_t)sk * 5140 + 4624 + (n - 16)]; }
        else v = W[(size_t)sk * 32 + n];
        scr[kk * 33 + n] = v * g[sk]; }
    LDS_WAIT(); asm volatile("" ::: "memory");
    const int c = lane & 7;
#pragma unroll
    for (int j = 0; j < 4; ++j) { const int n = (lane >> 3) + 8 * j; const LAS float* s = scr + (8 * c) * 33 + n; float v[8], l[8];
#pragma unroll
        for (int t = 0; t < 8; ++t) { v[t] = s[t * 33]; l[t] = v[t] - __uint_as_float(f2bf(v[t]) << 16); }
        u32x4 o; o.x = pk2(v[0], v[1]); o.y = pk2(v[2], v[3]); o.z = pk2(v[4], v[5]); o.w = pk2(v[6], v[7]);
        *(GAS u32x4*)(hi + (size_t)n * 2048 + k0 + 8 * c) = o;
        o.x = pk2(l[0], l[1]); o.y = pk2(l[2], l[3]); o.z = pk2(l[4], l[5]); o.w = pk2(l[6], l[7]);
        *(GAS u32x4*)(lo + (size_t)n * 2048 + k0 + 8 * c) = o; }
    LDS_WAIT(); asm volatile("" ::: "memory");
}
__device__ __forceinline__ f32x4 bf_up4(bf16x8 h, int half) {
    f32x4 r;
#pragma unroll
    for (int j = 0; j < 4; ++j) r[j] = __uint_as_float(((unsigned)(unsigned short)h[4 * half + j]) << 16);
    return r;
}
template <int NT, bool Q8 = false>
__device__ __forceinline__ void rowpass16(const float* X, int row0, bf16_t* XB, const bf16_t* WT_hi, const bf16_t* WT_lo, f32x4 (&acc)[2], float& rstd_r, int lane) {
    const int r = lane & 15, q = lane >> 4;
    const float* xp = X + (size_t)(row0 + r) * DM + q * 16;
    bf16_t* xo = XB + (size_t)(row0 + r) * DM + q * 16;
    float ss = 0.f; acc[0] = (f32x4){0.f, 0.f, 0.f, 0.f}; acc[1] = acc[0];
#pragma unroll 2
    for (int kb = 0; kb < 32; ++kb) {
        const f32x4 v0 = *(const f32x4*)(xp + kb * 64), v1 = *(const f32x4*)(xp + kb * 64 + 4), v2 = *(const f32x4*)(xp + kb * 64 + 8), v3 = *(const f32x4*)(xp + kb * 64 + 12);
        ss += (v0[0] * v0[0] + v0[1] * v0[1]) + (v0[2] * v0[2] + v0[3] * v0[3]) + (v1[0] * v1[0] + v1[1] * v1[1]) + (v1[2] * v1[2] + v1[3] * v1[3]);
        ss += (v2[0] * v2[0] + v2[1] * v2[1]) + (v2[2] * v2[2] + v2[3] * v2[3]) + (v3[0] * v3[0] + v3[1] * v3[1]) + (v3[2] * v3[2] + v3[3] * v3[3]);
        const bf16x8 h0 = pack8(v0, v1), h1 = pack8(v2, v3);
        if constexpr (Q8) { u32x4 w8 = {pk_fp8x4(v0[0], v0[1], v0[2], v0[3]), pk_fp8x4(v1[0], v1[1], v1[2], v1[3]), pk_fp8x4(v2[0], v2[1], v2[2], v2[3]), pk_fp8x4(v3[0], v3[1], v3[2], v3[3])};
            *(u32x4*)((unsigned char*)XB + (size_t)(row0 + r) * DM + q * 16 + kb * 64) = w8; }
        else { *(bf16x8*)(xo + kb * 64) = h0; *(bf16x8*)(xo + kb * 64 + 8) = h1; }
        if constexpr (NT > 0) {
            const bf16x8 l0 = pack8(v0 - bf_up4(h0, 0), v1 - bf_up4(h0, 1)), l1 = pack8(v2 - bf_up4(h1, 0), v3 - bf_up4(h1, 1));
#pragma unroll
            for (int nt = 0; nt < NT; ++nt) {
                const bf16_t* wh = WT_hi + (size_t)(nt * 16 + r) * DM + kb * 64 + q * 16; const bf16_t* wl = WT_lo + (size_t)(nt * 16 + r) * DM + kb * 64 + q * 16;
                const bf16x8 bh0 = *(const bf16x8*)wh, bh1 = *(const bf16x8*)(wh + 8), bl0 = *(const bf16x8*)wl, bl1 = *(const bf16x8*)(wl + 8);
                acc[nt] = __builtin_amdgcn_mfma_f32_16x16x32_bf16(h0, bh0, acc[nt], 0, 0, 0); acc[nt] = __builtin_amdgcn_mfma_f32_16x16x32_bf16(l0, bh0, acc[nt], 0, 0, 0);
                acc[nt] = __builtin_amdgcn_mfma_f32_16x16x32_bf16(h0, bl0, acc[nt], 0, 0, 0);
                acc[nt] = __builtin_amdgcn_mfma_f32_16x16x32_bf16(h1, bh1, acc[nt], 0, 0, 0); acc[nt] = __builtin_amdgcn_mfma_f32_16x16x32_bf16(l1, bh1, acc[nt], 0, 0, 0);
                acc[nt] = __builtin_amdgcn_mfma_f32_16x16x32_bf16(h1, bl1, acc[nt], 0, 0, 0);
            }
        }
    }
    ss += __shfl_xor(ss, 16); ss += __shfl_xor(ss, 32);
    rstd_r = 1.0f / sqrtf(ss * (1.0f / DM) + EPS);
}

template <bool Q8>
__device__ __forceinline__ void rowpass_wg(const float* X, int row0, bf16_t* XB, const bf16_t* WT_hi, const bf16_t* WT_lo, f32x4 (&acc)[2], float& rstd_r, LAS unsigned char* wlds) {
    const int tid = threadIdx.x, lane = tid & 63, wave = __builtin_amdgcn_readfirstlane(tid >> 6), r = lane & 15, q = lane >> 4;
    const int rw = row0 + 16 * wave;
    const float* xp = X + (size_t)(rw + r) * DM + q * 16;
    bf16_t* xo = XB + (size_t)(rw + r) * DM + q * 16;
    float ss = 0.f; acc[0] = (f32x4){0.f, 0.f, 0.f, 0.f}; acc[1] = acc[0];
    f32x4 xa[4][4], xbuf[4][4]; u32x4 wst[4];
#define RW_LOADX(dst, c) do { _Pragma("unroll") for (int k4 = 0; k4 < 4; ++k4) _Pragma("unroll") for (int j = 0; j < 4; ++j) dst[k4][j] = *(const f32x4*)(xp + ((c) * 4 + k4) * 64 + 4 * j); } while (0)
#define RW_LOADW(c) do { _Pragma("unroll") for (int i = 0; i < 4; ++i) { const int p = tid + 512 * i, pp = p & 1023; const bf16_t* src = ((p >> 10) ? WT_lo : WT_hi) + (size_t)(pp >> 5) * DM + (c) * 256 + (pp & 31) * 8; \
        wst[i] = *(const u32x4*)src; } } while (0)
#define RW_STOREW() do { _Pragma("unroll") for (int i = 0; i < 4; ++i) { const int p = tid + 512 * i, pp = p & 1023; *(LAS u32x4*)(wlds + (p >> 10) * 16896 + (pp >> 5) * 528 + (pp & 31) * 16) = wst[i]; } } while (0)
#define RW_USE(src, c) do { _Pragma("unroll") for (int k4 = 0; k4 < 4; ++k4) { asm volatile("" ::: "memory"); const int kb = (c) * 4 + k4; const f32x4 v0 = src[k4][0], v1 = src[k4][1], v2 = src[k4][2], v3 = src[k4][3]; \
        ss += (v0[0] * v0[0] + v0[1] * v0[1]) + (v0[2] * v0[2] + v0[3] * v0[3]) + (v1[0] * v1[0] + v1[1] * v1[1]) + (v1[2] * v1[2] + v1[3] * v1[3]); \
        ss += (v2[0] * v2[0] + v2[1] * v2[1]) + (v2[2] * v2[2] + v2[3] * v2[3]) + (v3[0] * v3[0] + v3[1] * v3[1]) + (v3[2] * v3[2] + v3[3] * v3[3]); \
        const bf16x8 h0 = pack8_raw(v0, v1), h1 = pack8_raw(v2, v3); \
        if constexpr (Q8) { u32x4 w8 = {pk_fp8x4(v0[0], v0[1], v0[2], v0[3]), pk_fp8x4(v1[0], v1[1], v1[2], v1[3]), pk_fp8x4(v2[0], v2[1], v2[2], v2[3]), pk_fp8x4(v3[0], v3[1], v3[2], v3[3])}; \
            *(u32x4*)((unsigned char*)XB + (size_t)(rw + r) * DM + q * 16 + kb * 64) = w8; } \
        else { *(bf16x8*)(xo + kb * 64) = h0; *(bf16x8*)(xo + kb * 64 + 8) = h1; } \
        const bf16x8 l0 = pack8_raw(v0 - bf_up4(h0, 0), v1 - bf_up4(h0, 1)), l1 = pack8_raw(v2 - bf_up4(h1, 0), v3 - bf_up4(h1, 1)); \
        _Pragma("unroll") for (int nt = 0; nt < 2; ++nt) { const LAS unsigned char* wp = wlds + (nt * 16 + r) * 528 + (k4 * 64 + q * 16) * 2; \
            const bf16x8 bh0 = *(const LAS bf16x8*)wp, bh1 = *(const LAS bf16x8*)(wp + 16), bl0 = *(const LAS bf16x8*)(wp + 16896), bl1 = *(const LAS bf16x8*)(wp + 16896 + 16); \
            acc[nt] = __builtin_amdgcn_mfma_f32_16x16x32_bf16(h0, bh0, acc[nt], 0, 0, 0); acc[nt] = __builtin_amdgcn_mfma_f32_16x16x32_bf16(l0, bh0, acc[nt], 0, 0, 0); \
            acc[nt] = __builtin_amdgcn_mfma_f32_16x16x32_bf16(h0, bl0, acc[nt], 0, 0, 0); \
            acc[nt] = __builtin_amdgcn_mfma_f32_16x16x32_bf16(h1, bh1, acc[nt], 0, 0, 0); acc[nt] = __builtin_amdgcn_mfma_f32_16x16x32_bf16(l1, bh1, acc[nt], 0, 0, 0); \
            acc[nt] = __builtin_amdgcn_mfma_f32_16x16x32_bf16(h1, bl1, acc[nt], 0, 0, 0); } } } while (0)
    RW_LOADX(xa, 0);
#pragma unroll 1
    for (int c = 0; c < 8; c += 2) {
        RW_LOADW(c); RW_LOADX(xbuf, c + 1);
        __syncthreads(); RW_STOREW(); LDS_WAIT(); __syncthreads();
        RW_USE(xa, c);
        RW_LOADW(c + 1); if (c + 2 < 8) RW_LOADX(xa, c + 2);
        __syncthreads(); RW_STOREW(); LDS_WAIT(); __syncthreads();
        RW_USE(xbuf, c + 1);
    }
#undef RW_LOADX
#undef RW_LOADW
#undef RW_STOREW
#undef RW_USE
    ss += __shfl_xor(ss, 16); ss += __shfl_xor(ss, 32);
    rstd_r = 1.0f / sqrtf(ss * (1.0f / DM) + EPS);
    __syncthreads();
}

namespace pg8 {
struct EpiRowScaleBf16 {
    static constexpr bool PERM = true, META = false;
    bf16_t* O; int ldc; const float* rowscale;
    __device__ __forceinline__ void operator()(const f32x4 (&acc)[2][2][4][2], const Unit& u, int wr, int wc, int fr, int fq) const {
        const int row0 = u.pm * BM + wr * 64 + fr, col0 = u.pn * BM + wc * 32 + 8 * fq;
        float sc[2][4];
#pragma unroll
        for (int ai = 0; ai < 2; ++ai)
#pragma unroll
            for (int m = 0; m < 4; ++m) sc[ai][m] = rowscale[row0 + ai * HALF + m * 16];
        asm volatile("" : "+v"(sc[0][0]), "+v"(sc[0][1]), "+v"(sc[0][2]), "+v"(sc[0][3]), "+v"(sc[1][0]), "+v"(sc[1][1]), "+v"(sc[1][2]), "+v"(sc[1][3]));
#pragma unroll
        for (int ai = 0; ai < 2; ++ai)
#pragma unroll
            for (int m = 0; m < 4; ++m) { const int row = row0 + ai * HALF + m * 16; const float s = sc[ai][m]; bf16_t* rowp = O + (size_t)row * ldc + col0;
#pragma unroll
                for (int bj = 0; bj < 2; ++bj) { const f32x4 v0 = acc[ai][bj][m][0] * s, v1 = acc[ai][bj][m][1] * s;
                    u32x4 w; w.x = cvt_pk_bf16(v0[0], v0[1]); w.y = cvt_pk_bf16(v0[2], v0[3]); w.z = cvt_pk_bf16(v1[0], v1[1]); w.w = cvt_pk_bf16(v1[2], v1[3]);
                    *(u32x4*)(rowp + bj * HALF) = w; } }
    }
};
struct EpiResF32 {
    static constexpr bool PERM = false, META = false;
    const float* base; float* C; int ldc;
    __device__ __forceinline__ void operator()(const f32x4 (&acc)[2][2][4][2], const Unit& u, int wr, int wc, int fr, int fq) const {
        const int row0 = u.pm * BM + wr * 64 + fr, col0 = u.pn * BM + wc * 32 + 4 * fq;
#pragma unroll
        for (int ai = 0; ai < 2; ++ai) { f32x4 bs[4][2][2];
#pragma unroll
            for (int m = 0; m < 4; ++m)
#pragma unroll
                for (int bj = 0; bj < 2; ++bj)
#pragma unroll
                    for (int n = 0; n < 2; ++n) bs[m][bj][n] = *(const f32x4*)(base + (size_t)(row0 + ai * HALF + m * 16) * ldc + col0 + bj * HALF + n * 16);
#pragma unroll
            for (int m = 0; m < 4; ++m) asm volatile("" : "+v"(bs[m][0][0]), "+v"(bs[m][0][1]), "+v"(bs[m][1][0]), "+v"(bs[m][1][1]));
#pragma unroll
            for (int m = 0; m < 4; ++m)
#pragma unroll
                for (int bj = 0; bj < 2; ++bj)
#pragma unroll
                    for (int n = 0; n < 2; ++n) *(f32x4*)(C + (size_t)(row0 + ai * HALF + m * 16) * ldc + col0 + bj * HALF + n * 16) = bs[m][bj][n] + acc[ai][bj][m][n]; }
    }
};
struct EpiMoeUp {
    static constexpr bool PERM = true, META = false;
    bf16_t* ACT; const float* rstd; const float* bias;
    __device__ __forceinline__ void operator()(const f32x4 (&acc)[2][2][4][2], const Unit& u, int wr, int wc, int fr, int fq) const {
        asm volatile("" : "+v"(fr), "+v"(fq));
        const int j0 = u.pn * HALF + wc * 32 + 8 * fq; const float* bg = bias + (size_t)u.e * 4096 + j0; const float* bu = bg + 2048;
        int tk[2][4];
#pragma unroll
        for (int ai = 0; ai < 2; ++ai)
#pragma unroll
            for (int m = 0; m < 4; ++m) { const int r = ai * HALF + wr * 64 + m * 16 + fr; tk[ai][m] = u.rowidx[r < u.rows ? r : 0]; }
        f32x4 bg0 = *(const f32x4*)bg, bg1 = *(const f32x4*)(bg + 4), bu0 = *(const f32x4*)bu, bu1 = *(const f32x4*)(bu + 4);
        asm volatile("" : "+v"(tk[0][0]), "+v"(tk[0][1]), "+v"(tk[0][2]), "+v"(tk[0][3]), "+v"(tk[1][0]), "+v"(tk[1][1]), "+v"(tk[1][2]), "+v"(tk[1][3]), "+v"(bg0), "+v"(bg1), "+v"(bu0), "+v"(bu1));
        float sc[2][4];
#pragma unroll
        for (int ai = 0; ai < 2; ++ai)
#pragma unroll
            for (int m = 0; m < 4; ++m) sc[ai][m] = rstd[tk[ai][m] >> 2];
        asm volatile("" : "+v"(sc[0][0]), "+v"(sc[0][1]), "+v"(sc[0][2]), "+v"(sc[0][3]), "+v"(sc[1][0]), "+v"(sc[1][1]), "+v"(sc[1][2]), "+v"(sc[1][3]));
#pragma unroll
        for (int ai = 0; ai < 2; ++ai)
#pragma unroll
            for (int m = 0; m < 4; ++m) { const int r = ai * HALF + wr * 64 + m * 16 + fr; const float s = sc[ai][m];
                f32x4 o[2];
#pragma unroll
                for (int n = 0; n < 2; ++n) { const f32x4 g = acc[ai][0][m][n] * s + (n ? bg1 : bg0), up = acc[ai][1][m][n] * s + (n ? bu1 : bu0);
#pragma unroll
                    for (int i = 0; i < 4; ++i) { const float gg = fminf(g[i], 7.0f), uu = fminf(fmaxf(up[i], -7.0f), 7.0f);
                        const float sg = __builtin_amdgcn_rcpf(1.0f + __builtin_amdgcn_exp2f(-1.702f * 1.4426950408889634f * gg)); o[n][i] = gg * sg * (uu + 1.0f); } }
                u32x4 w; w.x = cvt_pk_bf16(o[0][0], o[0][1]); w.y = cvt_pk_bf16(o[0][2], o[0][3]); w.z = cvt_pk_bf16(o[1][0], o[1][1]); w.w = cvt_pk_bf16(o[1][2], o[1][3]);
                *(u32x4*)(ACT + ((size_t)u.pm * BM + r) * DFF + j0) = w; }
    }
};
struct EpiMoeDown {
    static constexpr bool PERM = true, META = true;
    bf16_t* Y; const float* gate; const float* bias;
    __device__ __forceinline__ void post(const Unit& u, LAS unsigned char* mb, int wid, int lane) const {
        const int r = (wid & 3) * 64 + lane, rc = r < u.rows ? r : 0;
        if (wid < 4) { __builtin_amdgcn_global_load_lds((const unsigned*)(u.rowidx + rc), (LAS unsigned*)(mb + wid * 256), 4, 0, 0);
                       __builtin_amdgcn_global_load_lds((const unsigned*)((const char*)(u.rowidx + rc) + (WS_ROWGATE - WS_ROWLIST)), (LAS unsigned*)(mb + 1024 + wid * 256), 4, 0, 0); }
        else __builtin_amdgcn_global_load_lds((const unsigned*)(bias + (size_t)u.e * DM + u.pn * BM + (wid - 4) * 64 + lane), (LAS unsigned*)(mb + 2048 + (wid - 4) * 256), 4, 0, 0);
    }
    __device__ __forceinline__ void operator()(const f32x4 (&acc)[2][2][4][2], const Unit& u, int wr, int wc, int fr, int fq, const LAS unsigned char* mb) const {
        asm volatile("" : "+v"(fr), "+v"(fq));
        const int col0 = u.pn * BM + wc * 32 + 8 * fq;
        f32x4 bv[2][2];
#pragma unroll
        for (int bj = 0; bj < 2; ++bj)
#pragma unroll
            for (int n = 0; n < 2; ++n) bv[bj][n] = *(const LAS f32x4*)(mb + 2048 + (bj * HALF + wc * 32 + 8 * fq + 4 * n) * 4);
#pragma unroll
        for (int ai = 0; ai < 2; ++ai)
#pragma unroll
            for (int m = 0; m < 4; ++m) { const int r = ai * HALF + wr * 64 + m * 16 + fr;
                const int a = (r < u.rows) ? *(const LAS int*)(mb + r * 4) : NASSIGN;
                const float g = *(const LAS float*)(mb + 1024 + r * 4);
#if Y_FP8
                unsigned char* rowp = (unsigned char*)Y + (size_t)a * DM + col0; const float g16 = g * 16.0f;
#pragma unroll
                for (int bj = 0; bj < 2; ++bj) { const f32x4 v0 = (acc[ai][bj][m][0] + bv[bj][0]) * g16, v1 = (acc[ai][bj][m][1] + bv[bj][1]) * g16;
                    u32x2 w; w.x = pk_fp8x4(v0[0], v0[1], v0[2], v0[3]); w.y = pk_fp8x4(v1[0], v1[1], v1[2], v1[3]);
                    *(u32x2*)(rowp + bj * HALF) = w; } }
#else
                bf16_t* rowp = Y + (size_t)a * DM + col0;
#pragma unroll
                for (int bj = 0; bj < 2; ++bj) { const f32x4 v0 = (acc[ai][bj][m][0] + bv[bj][0]) * g, v1 = (acc[ai][bj][m][1] + bv[bj][1]) * g;
                    u32x4 w; w.x = cvt_pk_bf16(v0[0], v0[1]); w.y = cvt_pk_bf16(v0[2], v0[3]); w.z = cvt_pk_bf16(v1[0], v1[1]); w.w = cvt_pk_bf16(v1[2], v1[3]);
                    *(u32x4*)(rowp + bj * HALF) = w; } }
#endif
    }
};
struct EpiMoeUpQ {
    static constexpr bool PERM = true, META = true;
    unsigned char* ACT; const float* rstd; const float* bias;
    __device__ __forceinline__ void post(const Unit& u, LAS unsigned char* mb, int wid, int lane) const {
        const int r = (wid & 3) * 64 + lane, rc = r < u.rows ? r : 0;
        if (wid < 4) __builtin_amdgcn_global_load_lds((const unsigned*)((const char*)(u.rowidx + rc) + (WS_ROWRSTD - WS_ROWLIST)), (LAS unsigned*)(mb + wid * 256), 4, 0, 0);
        else __builtin_amdgcn_global_load_lds((const unsigned*)(bias + (size_t)u.e * 4096 + ((wid - 4) >> 1) * 2048 + u.pn * HALF + ((wid - 4) & 1) * 64 + lane), (LAS unsigned*)(mb + 1024 + (wid - 4) * 256), 4, 0, 0);
    }
    __device__ __forceinline__ void operator()(const f32x4 (&acc)[2][2][4][2], const Unit& u, int wr, int wc, int fr, int fq, const LAS unsigned char* mb) const {
        asm volatile("" : "+v"(fr), "+v"(fq));
        const int j0 = u.pn * HALF + wc * 32 + 8 * fq, jl = wc * 32 + 8 * fq;
        const f32x4 bg0 = *(const LAS f32x4*)(mb + 1024 + jl * 4), bg1 = *(const LAS f32x4*)(mb + 1024 + jl * 4 + 16), bu0 = *(const LAS f32x4*)(mb + 1536 + jl * 4), bu1 = *(const LAS f32x4*)(mb + 1536 + jl * 4 + 16);
#pragma unroll
        for (int ai = 0; ai < 2; ++ai)
#pragma unroll
            for (int m = 0; m < 4; ++m) { const int r = ai * HALF + wr * 64 + m * 16 + fr; const float s = *(const LAS float*)(mb + r * 4);
                f32x4 o[2];
#pragma unroll
                for (int n = 0; n < 2; ++n) { const f32x4 g4 = acc[ai][0][m][n] * s + (n ? bg1 : bg0), u4 = acc[ai][1][m][n] * s + (n ? bu1 : bu0);
#pragma unroll
                    for (int hh = 0; hh < 2; ++hh) { f32x2 g = {g4[2 * hh], g4[2 * hh + 1]}, up = {u4[2 * hh], u4[2 * hh + 1]};
                        g = __builtin_elementwise_min(g, (f32x2){7.0f, 7.0f}); up = __builtin_elementwise_min(__builtin_elementwise_max(up, (f32x2){-7.0f, -7.0f}), (f32x2){7.0f, 7.0f});
                        const f32x2 ea = g * (-1.702f * 1.4426950408889634f); f32x2 e; e.x = __builtin_amdgcn_exp2f(ea.x); e.y = __builtin_amdgcn_exp2f(ea.y);
                        const f32x2 d = e + 1.0f; f32x2 sg; sg.x = __builtin_amdgcn_rcpf(d.x); sg.y = __builtin_amdgcn_rcpf(d.y);
                        const f32x2 t = g * 4.0f, r2 = (t * up + t) * sg; o[n][2 * hh] = r2.x; o[n][2 * hh + 1] = r2.y; } }
                u32x2 w; w.x = pk_fp8x4(o[0][0], o[0][1], o[0][2], o[0][3]); w.y = pk_fp8x4(o[1][0], o[1][1], o[1][2], o[1][3]);
                *(u32x2*)(ACT + ((size_t)u.pm * BM + r) * DFF + j0) = w; }
    }
};
struct MoeOrder {
    const char* A; const char* B; const int* rowlist; const int* ident; const LAS int* tab; int NT, K; size_t bexp; int G, c;
    __device__ __forceinline__ bool next(int i, Unit& u) const {
        if (i >= 32) return false;
        const LAS int* en = tab + 1024 + 8 * i;
        const int valid = __builtin_amdgcn_readfirstlane(en[0]); if (!valid) return false;
        const int e = __builtin_amdgcn_readfirstlane(en[1]), ntile = __builtin_amdgcn_readfirstlane(en[2]), pm = __builtin_amdgcn_readfirstlane(en[3]), rows = __builtin_amdgcn_readfirstlane(en[4]),
                  mrow = __builtin_amdgcn_readfirstlane(en[5]);
        u.e = e; u.pn = ntile; u.pm = pm; u.rows = rows;
        u.rowidx = rowlist + (size_t)e * NTOK + (size_t)mrow * BM;
        u.B = B + (size_t)e * bexp + (size_t)ntile * BM * K * 2;
        u.A = A;
        if (ident) { u.gidx = ident + (size_t)u.pm * BM; u.grows = BM; } else { u.gidx = u.rowidx; u.grows = u.rows; }
        return true;
    }
};
}
__device__ __forceinline__ void moe_build_table(LAS int* tab, const unsigned* cnt, int NT) {
    if (threadIdx.x == 0) { int ng = 0, start = 0, slot = 0;
        for (int e = 0; e < NEXP; ++e) { const int c = (int)cnt[e]; const int tiles = (c + 255) >> 8;
            for (int mt0 = 0; mt0 < tiles; mt0 += 8) { const int gsz = (tiles - mt0) < 8 ? (tiles - mt0) : 8; LAS int* en = tab + 8 + 8 * ng;
                en[0] = start; en[1] = e; en[2] = mt0; en[3] = gsz; en[4] = slot + mt0; en[5] = c - mt0 * 256; ++ng; start += gsz * NT; }
            slot += tiles; }
        tab[0] = ng; tab[1] = start; }
    __syncthreads();
    if (threadIdx.x < 32) { const int i = threadIdx.x, G = gridDim.x, c = blockIdx.x; const int total = tab[1], ng = tab[0]; LAS int* en = tab + 1024 + 8 * i;
        const long L = (long)i * G + c;
        if (L >= total) { en[0] = 0; }
        else { int p = (int)L; { const int q = total / pg8::NXCD, r = total % pg8::NXCD, xcd = p % pg8::NXCD, off = p / pg8::NXCD; p = (xcd < r ? xcd * (q + 1) : r * (q + 1) + (xcd - r) * q) + off; }
            int g = 0; while (g + 1 < ng && tab[8 + 8 * (g + 1)] <= p) ++g;
            const LAS int* ge = tab + 8 + 8 * g; const int qn = p - ge[0], gsz = ge[3], ntile = qn / gsz, mi = qn - ntile * gsz, rl = ge[5] - mi * 256;
            en[0] = 1; en[1] = ge[1]; en[2] = ntile; en[3] = ge[4] + mi; en[4] = rl < 256 ? rl : 256; en[5] = ge[2] + mi; } }
    __syncthreads();
}
__device__ __forceinline__ void gla_chunk_kv(int unit, const bf16_t* proj, const float* la, float* KV, float* Dc, char* lds) {
    const int tid = threadIdx.x, wid = __builtin_amdgcn_readfirstlane(tid >> 6), lane = tid & 63, r32 = lane & 31, hi = lane >> 5;
    const int b = unit >> 8, h = (unit >> 6) & 3, c = unit & 63; const size_t tok0 = (size_t)b * SEQ + (size_t)c * 64;
    char* V_lds = lds;
    const int dk = 32 * (wid & 3) + r32, hd = h * 128 + dk;
    float lav[64];
#pragma unroll
    for (int s = 0; s < 64; ++s) lav[s] = la[(tok0 + s) * 512 + hd];
    float kv[4][8];
#pragma unroll
    for (int ks = 0; ks < 4; ++ks)
#pragma unroll
        for (int j = 0; j < 8; ++j) kv[ks][j] = bf2f(proj[(tok0 + 16 * ks + 8 * hi + j) * NPROJ + C_KG + hd]);
    { const int sr = tid >> 4, sc = (tid & 15) * 8;
#pragma unroll
      for (int hf = 0; hf < 2; ++hf) { const bf16_t* vp = proj + (tok0 + sr) * NPROJ + C_VG + h * 256 + hf * 128 + sc;
          const bf16x8 a = *(const bf16x8*)vp, bb = *(const bf16x8*)(vp + (size_t)32 * NPROJ);
          *(bf16x8*)(V_lds + hf * fox::SHM_V + fox::v_st(sr, sc)) = a; *(bf16x8*)(V_lds + hf * fox::SHM_V + fox::v_st(32 + sr, sc)) = bb; } }
    float rsum = 0.f; float fr[4][8];
#pragma unroll
    for (int ks = 3; ks >= 0; --ks)
#pragma unroll
        for (int h2 = 1; h2 >= 0; --h2)
#pragma unroll
            for (int j = 7; j >= 0; --j) { const int s = 16 * ks + 8 * h2 + j;
                const float dec = __builtin_amdgcn_exp2f(rsum * 1.4426950408889634f);
                if (h2 == hi) fr[ks][j] = kv[ks][j] * dec;
                rsum += lav[s]; }
    bf16x8 pa[4];
#pragma unroll
    for (int ks = 0; ks < 4; ++ks) pa[ks] = pack8((f32x4){fr[ks][0], fr[ks][1], fr[ks][2], fr[ks][3]}, (f32x4){fr[ks][4], fr[ks][5], fr[ks][6], fr[ks][7]});
    __syncthreads();
    f32x16 o[4] = {};
    const int vb0 = (int)(uintptr_t)V_lds + fox::v_rd_base(lane);
    if ((wid >> 2) == 0) fox::pv_tile<0>(o, vb0, pa[0], pa[1], pa[2], pa[3]); else fox::pv_tile<1>(o, vb0, pa[0], pa[1], pa[2], pa[3]);
    bf16_t* kvo = (bf16_t*)KV + (size_t)unit * (128 * 256) + (size_t)((wid >> 2) * 128 + r32) * 128 + 32 * (wid & 3) + 4 * hi;
#pragma unroll
    for (int d0 = 0; d0 < 4; ++d0)
#pragma unroll
        for (int g = 0; g < 4; ++g) { u32x2 w; w.x = cvt_pk_bf16(o[d0][4 * g], o[d0][4 * g + 1]); w.y = cvt_pk_bf16(o[d0][4 * g + 2], o[d0][4 * g + 3]); *(u32x2*)(kvo + (size_t)d0 * 32 * 128 + 8 * g) = w; }
    if (hi == 0 && (wid >> 2) == 0) Dc[(size_t)unit * 128 + dk] = __builtin_amdgcn_exp2f(rsum * 1.4426950408889634f);
    __syncthreads();
}
struct GlaSet { bf16x8 kv[4]; bf16x8 qf[4]; };
__device__ __forceinline__ void gla_ld(GlaSet& R, int c, int b, int h, int sl, int mt, const bf16_t* proj, const bf16_t* KV, int r, int q) {
    const bf16_t* kvp = KV + (size_t)((b * 4 + h) * 64 + c) * (128 * 256) + (size_t)(sl * 16 + r) * 128 + 8 * q;
    const bf16_t* qp = proj + ((size_t)b * SEQ + (size_t)c * 64 + 16 * mt + r) * NPROJ + C_QG + h * 128 + 8 * q;
#pragma unroll
    for (int ks = 0; ks < 4; ++ks) { R.qf[ks] = *(const bf16x8*)(qp + 32 * ks); R.kv[ks] = *(const bf16x8*)(kvp + 32 * ks); }
}
typedef _Float16 f16x4 __attribute__((ext_vector_type(4)));
typedef _Float16 f16x8 __attribute__((ext_vector_type(8)));
__device__ __forceinline__ void gla_step(const GlaSet& R, f32x4 (&S)[4][2], const LAS _Float16* dl, int c, int b, int h, int sl, int mt, float* GO, int r, int q) {
    f32x4 o = {0.f, 0.f, 0.f, 0.f};
#pragma unroll
    for (int ks = 0; ks < 4; ++ks) { const f16x8 dh = *(const LAS f16x8*)(dl + c * 128 + 32 * ks + 8 * q);
        const f32x4 d0 = {(float)dh[0], (float)dh[1], (float)dh[2], (float)dh[3]}, d1 = {(float)dh[4], (float)dh[5], (float)dh[6], (float)dh[7]};
        S[ks][0] = d0 * S[ks][0] + bf_up4(R.kv[ks], 0); S[ks][1] = d1 * S[ks][1] + bf_up4(R.kv[ks], 1);
        o = __builtin_amdgcn_mfma_f32_16x16x32_bf16(pack8(S[ks][0], S[ks][1]), R.qf[ks], o, 0, 0, 0); }
    u32x2 w; w.x = cvt_pk_bf16(o[0], o[1]); w.y = cvt_pk_bf16(o[2], o[3]);
    *(u32x2*)((bf16_t*)GO + ((size_t)b * SEQ + (size_t)c * 64 + 16 * mt + r) * 1024 + h * 256 + sl * 16 + 4 * q) = w;
}
__device__ __forceinline__ void gla_scan(int unit, const bf16_t* proj, const float* KVf, float* GO, const LAS _Float16* dl, int lane) {
    const bf16_t* KV = (const bf16_t*)KVf;
    const int mt = unit & 3, u2 = unit >> 2, b = u2 >> 6, h = (u2 >> 4) & 3, sl = u2 & 15, r = lane & 15, q = lane >> 4;
    f32x4 S[4][2];
#pragma unroll
    for (int ks = 0; ks < 4; ++ks) { S[ks][0] = (f32x4){0.f, 0.f, 0.f, 0.f}; S[ks][1] = S[ks][0]; }
    GlaSet R0, R1, R2, R3;
    gla_ld(R0, 0, b, h, sl, mt, proj, KV, r, q); gla_ld(R1, 1, b, h, sl, mt, proj, KV, r, q); gla_ld(R2, 2, b, h, sl, mt, proj, KV, r, q);
#pragma unroll 1
    for (int c = 0; c < 64; c += 4) {
        gla_ld(R3, c + 3, b, h, sl, mt, proj, KV, r, q);
        gla_step(R0, S, dl, c, b, h, sl, mt, GO, r, q);
        if (c + 4 < 64) gla_ld(R0, c + 4, b, h, sl, mt, proj, KV, r, q);
        gla_step(R1, S, dl, c + 1, b, h, sl, mt, GO, r, q);
        if (c + 4 < 64) gla_ld(R1, c + 5, b, h, sl, mt, proj, KV, r, q);
        gla_step(R2, S, dl, c + 2, b, h, sl, mt, GO, r, q);
        if (c + 4 < 64) gla_ld(R2, c + 6, b, h, sl, mt, proj, KV, r, q);
        gla_step(R3, S, dl, c + 3, b, h, sl, mt, GO, r, q);
    }
    LDS_WAIT(); asm volatile("" ::: "memory");
}
__device__ __forceinline__ f32x4 bf_lo4(u32x4 w) { return (f32x4){__uint_as_float(w[0] << 16), __uint_as_float(w[0] & 0xffff0000u), __uint_as_float(w[1] << 16), __uint_as_float(w[1] & 0xffff0000u)}; }
__device__ __forceinline__ f32x4 bf_hi4(u32x4 w) { return (f32x4){__uint_as_float(w[2] << 16), __uint_as_float(w[2] & 0xffff0000u), __uint_as_float(w[3] << 16), __uint_as_float(w[3] & 0xffff0000u)}; }
__device__ __forceinline__ void gla_finish16(int th0, const float* GO, const bf16_t* proj, const float* gain, bf16_t* mix, int lane) {
    const int l32 = lane & 31, sub = lane >> 5;
    u32x4 go[8], gt[8];
#pragma unroll
    for (int i = 0; i < 8; ++i) { const int th = th0 + 2 * i + sub, tok = th >> 2, h = th & 3;
        go[i] = *(const u32x4*)((const bf16_t*)GO + (size_t)tok * 1024 + h * 256 + l32 * 8); gt[i] = *(const u32x4*)(proj + (size_t)tok * NPROJ + C_GG + h * 256 + l32 * 8); }
#pragma unroll
    for (int i = 0; i < 8; ++i) { const int th = th0 + 2 * i + sub, tok = th >> 2, h = th & 3;
        const f32x4 v0 = bf_lo4(go[i]), v1 = bf_hi4(go[i]), q0 = bf_lo4(gt[i]), q1 = bf_hi4(gt[i]);
        float ss = ((v0[0] * v0[0] + v0[1] * v0[1]) + (v0[2] * v0[2] + v0[3] * v0[3])) + ((v1[0] * v1[0] + v1[1] * v1[1]) + (v1[2] * v1[2] + v1[3] * v1[3]));
        ss += __shfl_xor(ss, 1); ss += __shfl_xor(ss, 2); ss += __shfl_xor(ss, 4); ss += __shfl_xor(ss, 8); ss += __shfl_xor(ss, 16);
        const float rs = 1.0f / sqrtf(ss * (1.0f / 256.0f) + EPS);
        const f32x4 g0 = *(const f32x4*)(gain + h * 256 + l32 * 8), g1 = *(const f32x4*)(gain + h * 256 + l32 * 8 + 4);
        auto silu = [](float x) { return x * __builtin_amdgcn_rcpf(1.0f + __expf(-x)); };
        u32x4 w; w[0] = cvt_pk_bf16(v0[0] * rs * g0[0] * silu(q0[0]), v0[1] * rs * g0[1] * silu(q0[1])); w[1] = cvt_pk_bf16(v0[2] * rs * g0[2] * silu(q0[2]), v0[3] * rs * g0[3] * silu(q0[3]));
        w[2] = cvt_pk_bf16(v1[0] * rs * g1[0] * silu(q1[0]), v1[1] * rs * g1[1] * silu(q1[1])); w[3] = cvt_pk_bf16(v1[2] * rs * g1[2] * silu(q1[2]), v1[3] * rs * g1[3] * silu(q1[3]));
        *(u32x4*)(mix + (size_t)tok * DM + h * 256 + l32 * 8) = w; }
}

__device__ __forceinline__ void fox_combine16(int th0, const float* PO, const float* ML, const float* gain, bf16_t* mix, int lane) {
    const int l16 = lane & 15, sub = lane >> 4, h = sub & 3; constexpr float C2 = 1.4426950408889634f * 0.08838834764831845f;
    u32x4 o0[4], o1[4]; f32x2 ml0[4], ml1[4];
#pragma unroll
    for (int i = 0; i < 4; ++i) { const size_t th = (size_t)(th0 + 4 * i + sub);
        o0[i] = *(const u32x4*)((const bf16_t*)PO + th * 128 + l16 * 8); o1[i] = *(const u32x4*)((const bf16_t*)PO + (size_t)NTOK * 512 + th * 128 + l16 * 8);
        ml0[i] = *(const f32x2*)(ML + th * 2); ml1[i] = *(const f32x2*)(ML + (size_t)NTOK * 8 + th * 2); }
    float g[8];
#pragma unroll
    for (int t = 0; t < 8; ++t) g[t] = gain[h * 128 + (t & 3) * 32 + l16 * 2 + (t >> 2)];
#pragma unroll
    for (int i = 0; i < 4; ++i) { const int th = th0 + 4 * i + sub, tok = th >> 2;
        const float m = fmaxf(ml0[i][0], ml1[i][0]), a0 = __builtin_amdgcn_exp2f((ml0[i][0] - m) * C2), a1 = __builtin_amdgcn_exp2f((ml1[i][0] - m) * C2);
        const float inv = 1.0f / (ml0[i][1] * a0 + ml1[i][1] * a1);
        const f32x4 v0 = (bf_lo4(o0[i]) * a0 + bf_lo4(o1[i]) * a1) * inv, v1 = (bf_hi4(o0[i]) * a0 + bf_hi4(o1[i]) * a1) * inv;
        float ss = ((v0[0] * v0[0] + v0[1] * v0[1]) + (v0[2] * v0[2] + v0[3] * v0[3])) + ((v1[0] * v1[0] + v1[1] * v1[1]) + (v1[2] * v1[2] + v1[3] * v1[3]));
        ss += __shfl_xor(ss, 1); ss += __shfl_xor(ss, 2); ss += __shfl_xor(ss, 4); ss += __shfl_xor(ss, 8);
        const float rs = 1.0f / sqrtf(ss * (1.0f / 128.0f) + EPS);
        u32x4 w; w[0] = cvt_pk_bf16(v0[0] * rs * g[0], v0[1] * rs * g[1]); w[1] = cvt_pk_bf16(v0[2] * rs * g[2], v0[3] * rs * g[3]);
        w[2] = cvt_pk_bf16(v1[0] * rs * g[4], v1[1] * rs * g[5]); w[3] = cvt_pk_bf16(v1[2] * rs * g[6], v1[3] * rs * g[7]);
        *(u32x4*)(mix + (size_t)tok * DM + 1024 + h * 128 + l16 * 8) = w; }
}

__device__ __forceinline__ void memkv_tile(int t, const bf16_t* memb, const bf16_t* WT, const float* rstd, bf16_t* KM, bf16_t* VT, int lane) {
    const int rt = t >> 5, ct = t & 31, r = lane & 15, q = lane >> 4;
    const bf16_t* ap = memb + (size_t)(rt * 32 + r) * DM + q * 16; const bf16_t* bp = WT + (size_t)(ct * 32 + r) * DM + q * 16;
    f32x4 acc[2][2] = {};
#pragma unroll 4
    for (int kb = 0; kb < 32; ++kb) {
        bf16x8 a[2][2], bb[2][2];
#pragma unroll
        for (int i = 0; i < 2; ++i)
#pragma unroll
            for (int s = 0; s < 2; ++s) { a[i][s] = *(const bf16x8*)(ap + (size_t)i * 16 * DM + kb * 64 + s * 8); bb[i][s] = *(const bf16x8*)(bp + (size_t)i * 16 * DM + kb * 64 + s * 8); }
#pragma unroll
        for (int i = 0; i < 2; ++i)
#pragma unroll
            for (int j = 0; j < 2; ++j)
#pragma unroll
                for (int s = 0; s < 2; ++s) acc[i][j] = __builtin_amdgcn_mfma_f32_16x16x32_bf16(a[i][s], bb[j][s], acc[i][j], 0, 0, 0);
    }
#pragma unroll
    for (int i = 0; i < 2; ++i) { const int row = rt * 32 + 16 * i + 4 * q;
        const f32x4 rs = *(const f32x4*)(rstd + row);
#pragma unroll
        for (int j = 0; j < 2; ++j) { const int col = ct * 32 + 16 * j + r; const f32x4 v = acc[i][j] * rs;
            if (col < 512) {
#pragma unroll
                for (int tt = 0; tt < 4; ++tt) KM[(size_t)(row + tt) * 512 + col] = (bf16_t)(cvt_pk_bf16(v[tt], 0.f) & 0xffffu); }
            else { const int hd = col - 512, bb2 = row >> 8, key = row & 255; u32x2 w; w.x = cvt_pk_bf16(v[0], v[1]); w.y = cvt_pk_bf16(v[2], v[3]);
                *(u32x2*)(VT + ((size_t)(bb2 * 4 + (hd >> 7)) * 128 + (hd & 127)) * 256 + key) = w; } } }
}
__device__ __forceinline__ void memattn_unit(int bh, int qt, const bf16_t* proj, const LAS unsigned char* kl, const LAS unsigned char* vl, const float* gain, bf16_t* mix, int lane) {
    const int b = bh >> 2, h = bh & 3, r32 = lane & 31, hi = lane >> 5;
    const size_t tok0 = (size_t)b * SEQ + (size_t)qt * 32;
    bf16x8 qr[8];
#pragma unroll
    for (int d0 = 0; d0 < 8; ++d0) qr[d0] = *(const bf16x8*)(proj + (tok0 + r32) * NPROJ + C_QM + h * 128 + d0 * 16 + hi * 8);
    const int sw = r32 & 15;
    const LAS unsigned char* ka[8];
#pragma unroll
    for (int d0 = 0; d0 < 8; ++d0) ka[d0] = kl + r32 * 256 + (((2 * d0 + hi) ^ sw) << 4);
    float mx = -3.0e38f;
#pragma unroll 1
    for (int j = 0; j < 8; ++j) { f32x16 p = {}; const int ko = j * 32 * 256;
#pragma unroll
        for (int d0 = 0; d0 < 8; ++d0) p = __builtin_amdgcn_mfma_f32_32x32x16_bf16(*(const LAS bf16x8*)(ka[d0] + ko), qr[d0], p, 0, 0, 0);
#pragma unroll
        for (int r = 0; r < 16; ++r) mx = fmaxf(mx, p[r]); }
    { auto rr = __builtin_amdgcn_permlane32_swap(__float_as_uint(mx), __float_as_uint(mx), false, false); mx = fmaxf(__uint_as_float(rr[0]), __uint_as_float(rr[1])); }
    constexpr float C2 = 1.4426950408889634f * 0.08838834764831845f; const float mL = -mx * C2;
    float ps = 0.f;
    f32x16 o[4] = {};
    const LAS unsigned char* va[4];
#pragma unroll
    for (int ks = 0; ks < 4; ++ks) va[ks] = vl + r32 * 512 + (((2 * ks + hi) ^ (sw & 7)) << 4);
#define PK4(P, B_, OUT) do { unsigned a0 = cvt_pk_bf16(P[B_+0], P[B_+1]), a1 = cvt_pk_bf16(P[B_+2], P[B_+3]), b0 = cvt_pk_bf16(P[B_+4], P[B_+5]), b1 = cvt_pk_bf16(P[B_+6], P[B_+7]); \
        auto r0 = __builtin_amdgcn_permlane32_swap(a0, b0, false, false); auto r1 = __builtin_amdgcn_permlane32_swap(a1, b1, false, false); \
        u32x4 w = {r0[0], r1[0], r0[1], r1[1]}; OUT = __builtin_bit_cast(bf16x8, w); } while (0)
#pragma unroll 1
    for (int jj = 0; jj < 4; ++jj) { f32x16 p0 = {}, p1 = {}; const int ko = jj * 64 * 256;
#pragma unroll
        for (int d0 = 0; d0 < 8; ++d0) { p0 = __builtin_amdgcn_mfma_f32_32x32x16_bf16(*(const LAS bf16x8*)(ka[d0] + ko), qr[d0], p0, 0, 0, 0);
                                         p1 = __builtin_amdgcn_mfma_f32_32x32x16_bf16(*(const LAS bf16x8*)(ka[d0] + ko + 32 * 256), qr[d0], p1, 0, 0, 0); }
#pragma unroll
        for (int r = 0; r < 16; ++r) { p0[r] = __builtin_amdgcn_exp2f(fmaf(p0[r], C2, mL)); p1[r] = __builtin_amdgcn_exp2f(fmaf(p1[r], C2, mL)); ps += p0[r] + p1[r]; }
        bf16x8 pa[4];
        PK4(p0, 0, pa[0]); PK4(p0, 8, pa[1]); PK4(p1, 0, pa[2]); PK4(p1, 8, pa[3]);
        const int vo = (jj >> 1) * 256 + ((((jj & 1) << 3) ^ (sw & 8)) << 4);
#pragma unroll
        for (int ks = 0; ks < 4; ++ks)
#pragma unroll
            for (int d0 = 0; d0 < 4; ++d0) o[d0] = __builtin_amdgcn_mfma_f32_32x32x16_bf16(pa[ks], *(const LAS bf16x8*)(va[ks] + vo + d0 * 32 * 512), o[d0], 0, 0, 0); }
#undef PK4
    { auto rr = __builtin_amdgcn_permlane32_swap(__float_as_uint(ps), __float_as_uint(ps), false, false); ps = __uint_as_float(rr[0]) + __uint_as_float(rr[1]); }
    const float rl = __builtin_amdgcn_rcpf(ps);
    const float g0 = gain[h * 128 + r32], g1 = gain[h * 128 + 32 + r32], g2 = gain[h * 128 + 64 + r32], g3 = gain[h * 128 + 96 + r32];
    bf16_t* out = mix + tok0 * DM + 1536 + h * 128;
#pragma unroll
    for (int r = 0; r < 16; ++r) { const int orow = fox::crow(r, hi); const float rlr = __shfl(rl, orow);
        const float v0 = o[0][r] * rlr, v1 = o[1][r] * rlr, v2 = o[2][r] * rlr, v3 = o[3][r] * rlr;
        float ss = (v0 * v0 + v1 * v1) + (v2 * v2 + v3 * v3);
        ss += __shfl_xor(ss, 1); ss += __shfl_xor(ss, 2); ss += __shfl_xor(ss, 4); ss += __shfl_xor(ss, 8); ss += __shfl_xor(ss, 16);
        const float rs = 1.0f / sqrtf(ss * (1.0f / 128.0f) + EPS);
        u32x2 w; w.x = cvt_pk_bf16(v0 * rs * g0, v1 * rs * g1); w.y = cvt_pk_bf16(v2 * rs * g2, v3 * rs * g3);
        *(u32x2*)(out + (size_t)orow * DM + r32 * 4) = w; }
}

constexpr int NWAVES = 8;
constexpr int CONV_ALL = 49152, CONV_P1 = 6144, CONV_P7 = 6144, CONV_P2 = CONV_ALL - CONV_P1 - CONV_P7;
#ifndef MK_N_LAUNCHES
#define MK_N_LAUNCHES 1
#endif
#ifndef REP_PHASE
#define REP_PHASE -1
#endif
#ifndef REP_EXTRA
#define REP_EXTRA 1
#endif
#define REP_SUB 0
constexpr int PER_PHASE = 11;
constexpr int N_LAUNCHES = MK_N_LAUNCHES;
struct Args {
    const float *x, *mem, *g_attn, *g_mem, *w_in, *w_a2, *b_a, *g_gla, *b_fox, *g_fox, *w_mkv, *g_memo, *w_out, *g_ffn, *w_router, *b_router, *w_up, *b_up, *w_down, *b_down, *g_final;
    float* out; unsigned char* ws; int ph_lo, ph_hi;
};
typedef const __attribute__((address_space(4))) Args* KArgs;
__device__ __forceinline__ KArgs kargs() { KArgs p = (KArgs)__builtin_amdgcn_kernarg_segment_ptr(); asm volatile("" : "+s"(p)); return p; }
__global__ void __launch_bounds__(NWAVES * 64, 2) fwd(Args a_unused) {
    extern __shared__ __attribute__((aligned(16))) unsigned char lds_raw[];
    LAS unsigned char* lds = (LAS unsigned char*)lds_raw;
    const int tid = threadIdx.x, lane = tid & 63, wave = __builtin_amdgcn_readfirstlane(tid >> 6);
    const int G = gridDim.x, bx = blockIdx.x;
    const int vcu = (G % 8 == 0) ? (bx % 8) * (G / 8) + bx / 8 : bx;
    const int gw = vcu * NWAVES + wave, NGW = G * NWAVES;
    unsigned char* ws = kargs()->ws;
    unsigned* ctl = (unsigned*)(ws + WS_CTL);
    volatile LAS unsigned* MISC = (volatile LAS unsigned*)(lds + MISC_OFF);
    for (int u = tid; u < (LDS_BYTES - MISC_OFF) / 4; u += NWAVES * 64) ((LAS unsigned*)(lds + MISC_OFF))[u] = 0u;
    __syncthreads();
    XcdBarrier bar; bar.bar = ctl + CW_BAR; bar.x = 0; bar.st = nullptr;
    if (N_LAUNCHES == 1) bar = xcd_barrier_post(ctl + CW_BAR, MISC + 8);
#define GRID_BAR() do { if (N_LAUNCHES == 1) xcd_barrier(bar); } while (0)
    const int lo = kargs()->ph_lo, hi_ph = kargs()->ph_hi & 0xff, sub = kargs()->ph_hi >> 8;
#define PART(i) (sub == 0 || ((sub >> (i)) & 1))
#ifndef PH_MASK
#define PH_MASK 0xFFFF
#endif
#define IN(k) (((PH_MASK >> (k)) & 1) && lo <= (k) && (k) < hi_ph)
#define BOTH(k) (IN(k) && IN((k) + 1))
    bf16_t* WsmT = (bf16_t*)(ws + WS_WSM); bf16_t* WrT = (bf16_t*)(ws + WS_WSM + 256 * 1024);
    float* rstd1 = (float*)(ws + WS_RSTD); float* rstdm = rstd1 + 16384; float* rstd2 = rstd1 + 32768;
    float* small = (float*)(ws + WS_SMALL); float* gate_a = (float*)(ws + WS_GATE); int* rowlist = (int*)(ws + WS_ROWLIST);
    bf16_t* WmkvT = (bf16_t*)(ws + WS_WMKV); bf16_t* WoutT = (bf16_t*)(ws + WS_WOUT); bf16_t* WinT = (bf16_t*)(ws + WS_WIN);
    bf16_t* memb = (bf16_t*)(ws + WS_MEMB); bf16_t* KM = (bf16_t*)(ws + WS_KVM); bf16_t* VT = (bf16_t*)(ws + WS_KVM + MiB);
    float* glaD = (float*)(ws + WS_GLAD); bf16_t* xb = (bf16_t*)(ws + WS_XB); bf16_t* proj = (bf16_t*)(ws + WS_PROJ); bf16_t* mix = (bf16_t*)(ws + WS_MIX);
    float* x1 = (float*)(ws + WS_X1); bf16_t* x1b = (bf16_t*)(ws + WS_X1B); float* glaKV = (float*)(ws + WS_GLAKV); float* glaO = (float*)(ws + WS_GLAO);
    bf16_t* WupT = (bf16_t*)(ws + WS_WUP); bf16_t* WdownT = (bf16_t*)(ws + WS_WDOWN); bf16_t* act = (bf16_t*)(ws + WS_ACT); bf16_t* ybuf = (bf16_t*)(ws + WS_Y);
    unsigned* cnt = ctl + CW_CNT; float* la = (float*)(ws + WS_LA); int* ident = (int*)(ws + WS_IDENT); float* rowgate = (float*)(ws + WS_ROWGATE); float* rowrstd = (float*)(ws + WS_ROWRSTD);

#if MOE_FP8
#define MOE_CONV_ITEM(r_) do { const int r = (int)(r_); KArgs kq = kargs(); LAS unsigned char* scr = lds + wave * 18432; \
        if (r < 32768) { const int e = r >> 10, q = r & 1023, kb = q >> 6, nb = q & 63, nt = nb >> 2, bj = (nb >> 1) & 1, j64 = nb & 1; \
            tr_item_fp8(kq->w_up + (size_t)e * DM * 4096, 4096, kb * 128, bj * 2048 + nt * 128 + j64 * 64, (unsigned char*)WupT + ((size_t)e * 4096 + nb * 64) * DM, DM, kq->g_ffn, 32.0f, scr, lane); } \
        else { const int r2 = r - 32768, e = r2 >> 9, q = r2 & 511, kb = q >> 5, nb = q & 31; \
            tr_item_fp8(kq->w_down + (size_t)e * DFF * DM, DM, kb * 128, nb * 64, (unsigned char*)WdownT + ((size_t)e * DM + nb * 64) * DFF, DFF, nullptr, 32.0f, scr, lane); } } while (0)
#else
#define MOE_CONV_ITEM(r_) do { const int r = (int)(r_); KArgs kq = kargs(); LAS unsigned char* scr = lds + wave * 18432; \
        if (r < 32768) { const int e = r >> 10, q = r & 1023, kb = q >> 5, nb = q & 31, nt = nb >> 1, bj = nb & 1; \
            tr_item<false>(kq->w_up + (size_t)e * DM * 4096, 4096, kb * 64, bj * 2048 + nt * 128, WupT + ((size_t)e * 4096 + nb * 128) * DM, DM, kq->g_ffn, 1.0f, scr, lane); } \
        else { const int r2 = r - 32768, e = r2 >> 9, q = r2 & 511, kb = q >> 4, nb = q & 15; \
            tr_item<false>(kq->w_down + (size_t)e * DFF * DM, DM, kb * 64, nb * 128, WdownT + ((size_t)e * DM + nb * 128) * DFF, DFF, nullptr, 1.0f, scr, lane); } } while (0)
#endif
    if (IN(0)) {
        KArgs ka = kargs();
        LAS unsigned char* scr = lds + wave * 18432; LAS float* scrf = (LAS float*)scr;
        constexpr int I_IN = 32 * 40, I_OUT = 32 * 16, I_MKV = 32 * 8, I_TH = 32;
        constexpr int NITEMS = I_IN + I_OUT + I_MKV + 2 * I_TH;
        for (int it = gw; it < NITEMS; it += NGW) {
            int r = it;
            if (r < I_IN) { const int kb = r / 40, nb = r % 40, n0 = nb * 128; const int sc0 = n0 < 3072 ? n0 : (n0 < 4608 ? n0 + 16 : n0 + 20);
                tr_item<false>(ka->w_in, 5140, kb * 64, sc0, WinT + (size_t)n0 * DM, DM, ka->g_attn, n0 < 512 ? 0.08838834764831845f : 1.0f, scr, lane); continue; } r -= I_IN;
            if (r < I_OUT) { const int kb = r >> 4, nb = r & 15;
                if (kb < 16) tr_item<false>(ka->w_out, DM, kb * 64, nb * 128, WoutT + (size_t)nb * 128 * DM, DM, nullptr, 1.0f, scr, lane);
                else tr_item<true>(ka->w_out, DM, kb * 64, nb * 128, WoutT + (size_t)nb * 128 * DM, DM, nullptr, 1.0f, scr, lane);
                continue; } r -= I_OUT;
            if (r < I_MKV) { const int kb = r >> 3, nb = r & 7;
                tr_item<false>(ka->w_mkv, 1024, kb * 64, nb * 128, WmkvT + (size_t)nb * 128 * DM, DM, ka->g_mem, 1.0f, scr, lane); continue; } r -= I_MKV;
            if (r < I_TH) { thin_item(0, ka->w_in, ka->g_attn, r * 64, WsmT, WsmT + 32 * 2048, scrf, lane); continue; } r -= I_TH;
            thin_item(1, ka->w_router, ka->g_ffn, r * 64, WrT, WrT + 32 * 2048, scrf, lane);
        }
        for (int i = gw * 64 + lane; i < MAXTILES * 256; i += NGW * 64) ident[i] = i << 2;
        for (int row = gw; row < NB * NMEM; row += NGW) {
            const float* xr = ka->mem + (size_t)row * DM + lane * 4; f32x4 v[8]; float ss = 0.f;
#pragma unroll
            for (int j = 0; j < 8; ++j) v[j] = *(const f32x4*)(xr + j * 256);
#pragma unroll
            for (int j = 0; j < 8; ++j) { ss += (v[j][0] * v[j][0] + v[j][1] * v[j][1]) + (v[j][2] * v[j][2] + v[j][3] * v[j][3]);
                u32x2 w; w.x = cvt_pk_bf16(v[j][0], v[j][1]); w.y = cvt_pk_bf16(v[j][2], v[j][3]); *(u32x2*)(memb + (size_t)row * DM + j * 256 + lane * 4) = w; }
            ss = wave_sum(ss); if (lane == 0) rstdm[row] = 1.0f / sqrtf(ss * (1.0f / DM) + EPS); }
        if (BOTH(0)) GRID_BAR();
    }
    if (IN(1)) {
        KArgs ka = kargs();
        LAS float* alw = (LAS float*)(lds + wave * 1024);
        LAS unsigned char* wl = lds + 8192;
        for (int gq8 = vcu; gq8 < NTOK / 128; gq8 += G) { const int gq = gq8 * 8 + wave; f32x4 acc2[2]; float rs;
            rowpass_wg<false>(ka->x, gq8 * 128, xb, WsmT, WsmT + 32 * 2048, acc2, rs, wl);
            int lane = tid & 63; asm volatile("" : "+v"(lane));
            if (lane < 16) rstd1[gq * 16 + lane] = rs;
            const int r = lane & 15, q = lane >> 4;
#pragma unroll
            for (int i = 0; i < 4; ++i) { const float rr = __shfl(rs, 4 * q + i);
                alw[(4 * q + i) * 16 + r] = acc2[0][i] * rr; small[(size_t)(gq * 16 + 4 * q + i) * 32 + 16 + r] = acc2[1][i] * rr; }
            LDS_WAIT(); asm volatile("" ::: "memory");
#pragma unroll 1
            for (int hb = 0; hb < 8; ++hb) { const int hd = hb * 64 + lane; float w[16];
#pragma unroll
                for (int k2 = 0; k2 < 16; ++k2) w[k2] = ka->w_a2[k2 * 512 + hd];
                const float ba = ka->b_a[hd];
#pragma unroll 4
                for (int rw = 0; rw < 16; ++rw) { const f32x4 a0 = *(const LAS f32x4*)(alw + rw * 16), a1 = *(const LAS f32x4*)(alw + rw * 16 + 4), a2 = *(const LAS f32x4*)(alw + rw * 16 + 8), a3 = *(const LAS f32x4*)(alw + rw * 16 + 12);
                    float z = ba;
                    z += a0[0] * w[0] + a0[1] * w[1] + a0[2] * w[2] + a0[3] * w[3]; z += a1[0] * w[4] + a1[1] * w[5] + a1[2] * w[6] + a1[3] * w[7];
                    z += a2[0] * w[8] + a2[1] * w[9] + a2[2] * w[10] + a2[3] * w[11]; z += a3[0] * w[12] + a3[1] * w[13] + a3[2] * w[14] + a3[3] * w[15];
                    const float ls = fminf(z, 0.f) - __logf(1.0f + __expf(-fabsf(z)));
                    la[(size_t)(gq * 16 + rw) * 512 + hd] = ls * (1.0f / 16.0f); } }
            LDS_WAIT(); asm volatile("" ::: "memory"); }
        for (int t = gw - NTOK / 16; t < 1024; t += NGW) if (t >= 0) memkv_tile(t, memb, WmkvT, rstdm, KM, VT, lane);
        if (NGW == 2048 && gw >= 1024) { for (int it = CONV_P2 + (gw - 1024); it < CONV_P2 + CONV_P1; it += 1024) MOE_CONV_ITEM(it); }
        else if (NGW != 2048) { for (int it = CONV_P2 + gw; it < CONV_P2 + CONV_P1; it += NGW) MOE_CONV_ITEM(it); }
        if (BOTH(1)) GRID_BAR();
    }
    if (IN(2)) {
        KArgs ka = kargs();
        pg8::StaticOrder S; S.init(xb, WinT, NTOK, NPROJ, DM, G, bx);
        pg8::EpiRowScaleBf16 E{proj, NPROJ, rstd1};
        const bool conv_first = (bx & 7) < 4;
        if (conv_first) { for (int it = gw; it < CONV_P2; it += NGW) MOE_CONV_ITEM(it); __syncthreads(); }
        pg8::gemm_phase<pg8::EpiRowScaleBf16, pg8::StaticOrder, false>(lds, DM, S, E);
        if (!conv_first) { __syncthreads(); for (int it = gw; it < CONV_P2; it += NGW) MOE_CONV_ITEM(it); }
        if (BOTH(2)) GRID_BAR();
    }
    if (IN(3)) {
        KArgs ka = kargs();
        if (G == 256) {
            const int j = bx >> 3, bh = 2 * (bx & 7) + (j >> 4), x = j & 7, sh = (j >> 3) & 1, b = bh >> 2, h = bh & 3;
            char* l = (char*)lds_raw; float* Fb = (float*)(l + fox::LDS_FB); float* wsum = (float*)(l + fox::LDS_WS);
            bf16_t* PO = (bf16_t*)(ws + WS_FOXO) + (size_t)sh * NTOK * 512; float* PML = (float*)(ws + WS_FOXML) + (size_t)sh * NTOK * 8;
            {
                const float bf = ka->b_fox[h]; float v[8]; float run = 0.f;
#pragma unroll
                for (int i = 0; i < 8; ++i) { const int k = tid * 8 + i; const float lf = log_sigmoid(small[((size_t)b * SEQ + k) * 32 + 16 + h] + bf); run += lf; v[i] = run; }
                float inc = run;
#pragma unroll
                for (int o = 1; o < 64; o <<= 1) { const float t2 = __shfl_up(inc, o); if (lane >= o) inc += t2; }
                if (lane == 63) wsum[wave] = inc;
                __syncthreads();
                float woff = 0.f; for (int w2 = 0; w2 < wave; ++w2) woff += wsum[w2];
                const float base = woff + inc - run;
#pragma unroll
                for (int i = 0; i < 8; ++i) Fb[tid * 8 + i] = -(base + v[i]) * (1.0f / fox::SCALE);
                __syncthreads(); }
#pragma unroll 1
            for (int pass = 0; pass < 2; ++pass) { const int qb = pass ? 15 - x : x, n = 4 * (qb + 1);
                fox::BlockRef cur; cur.Q = proj + (size_t)(b * SEQ + qb * 256) * NPROJ + C_QF + h * 128; cur.K = proj + (size_t)b * SEQ * NPROJ + C_KF + h * 128; cur.V = proj + (size_t)b * SEQ * NPROJ + C_VF + h * 128;
                cur.P0 = qb * 256; cur.j_lo = sh ? n / 2 : 0; cur.j_hi = sh ? n : n / 2;
                fox::Seam Sm; fox::prime(cur, l, Sm);
                fox::EpiPartial E{(float*)(PO + ((size_t)b * SEQ * 4 + h) * 128), PML + ((size_t)b * SEQ * 4 + h) * 2};
                fox::block<fox::EpiPartial>(cur, cur, l, Sm, E); }
        }
        for (int u = bx; u < 1024; u += G) gla_chunk_kv(u, proj, la, glaKV, glaD, (char*)lds_raw);
        if (BOTH(3)) GRID_BAR();
    }
    if (IN(4)) {
        KArgs ka = kargs();
#pragma unroll 1
        for (int g = vcu; g < 256; g += G) {
            const int bh = g >> 4; int tl = tid, ll = lane; asm volatile("" : "+v"(tl), "+v"(ll));
            { const float* dsrc = glaD + (size_t)bh * 8192; const bf16_t* ksrc = KM + (size_t)((bh >> 2) * 256) * 512 + (bh & 3) * 128; const bf16_t* vsrc = VT + (size_t)bh * 128 * 256;
              f32x4 t[4]; bf16x8 kk[8], vv[8];
#pragma unroll
              for (int i = 0; i < 4; ++i) t[i] = *(const f32x4*)(dsrc + (i * 512 + tl) * 4);
#pragma unroll
              for (int i = 0; i < 8; ++i) { const int idx = i * 512 + tl; kk[i] = *(const bf16x8*)(ksrc + (size_t)(idx >> 4) * 512 + (idx & 15) * 8); }
#pragma unroll
              for (int i = 0; i < 8; ++i) vv[i] = *(const bf16x8*)(vsrc + (size_t)(i * 512 + tl) * 8);
#pragma unroll
              for (int i = 0; i < 4; ++i) { const f16x4 hv = {(_Float16)t[i][0], (_Float16)t[i][1], (_Float16)t[i][2], (_Float16)t[i][3]}; *(LAS f16x4*)(lds + (i * 512 + tl) * 8) = hv; }
#pragma unroll
              for (int i = 0; i < 8; ++i) { const int idx = i * 512 + tl, row = idx >> 4, ch = idx & 15; *(LAS bf16x8*)(lds + 16384 + row * 256 + ((ch ^ (row & 15)) << 4)) = kk[i]; }
#pragma unroll
              for (int i = 0; i < 8; ++i) { const int idx = i * 512 + tl, row = idx >> 5, ch = idx & 31; *(LAS bf16x8*)(lds + 81920 + row * 512 + ((ch ^ (row & 15)) << 4)) = vv[i]; }
              __syncthreads(); }
            if (wave < 4) { if (PART(0)) gla_scan(g * 4 + wave, proj, glaKV, glaO, (const LAS _Float16*)lds, ll); }
            else if (PART(1)) { for (int i = 0; i < 2; ++i) memattn_unit(bh, (g & 15) * 8 + i * 4 + (wave - 4), proj, lds + 16384, lds + 81920, ka->g_memo, mix, ll); }
            __syncthreads();
        }
        if (BOTH(4)) GRID_BAR();
    }
    if (IN(5)) {
        KArgs ka = kargs();
        int l5 = (int)__builtin_amdgcn_mbcnt_hi(~0u, __builtin_amdgcn_mbcnt_lo(~0u, 0u)); asm volatile("" : "+v"(l5));
        for (int th = gw * 16; th < NTOK * 4; th += NGW * 16) gla_finish16(th, glaO, proj, ka->g_gla, mix, l5);
        for (int th = gw * 16; th < NTOK * 4; th += NGW * 16) fox_combine16(th, (const float*)(ws + WS_FOXO), (const float*)(ws + WS_FOXML), ka->g_fox, mix, l5);
        if (BOTH(5)) GRID_BAR();
    }
    if (IN(6)) {
        KArgs ka = kargs();
        pg8::StaticOrder S; S.init(mix, WoutT, NTOK, DM, DM, G, bx);
        pg8::EpiResF32 E{ka->x, x1, DM};
        pg8::gemm_phase<pg8::EpiResF32, pg8::StaticOrder, false>(lds, DM, S, E);
        if (BOTH(6)) GRID_BAR();
    }
    if (IN(7)) {
        KArgs ka = kargs();
        LAS float* lg = (LAS float*)(lds + wave * 2048);
        LAS unsigned char* wl = lds + 16384;
        for (int gq8 = vcu; gq8 < NTOK / 128; gq8 += G) { const int gq = gq8 * 8 + wave; f32x4 acc2[2]; float rs;
            rowpass_wg<MOE_FP8 != 0>(x1, gq8 * 128, x1b, WrT, WrT + 32 * 2048, acc2, rs, wl);
            int lane = tid & 63; asm volatile("" : "+v"(lane));
            if (lane < 16) rstd2[gq * 16 + lane] = rs;
            const int r = lane & 15, q = lane >> 4;
#pragma unroll
            for (int i = 0; i < 4; ++i) { const float rr = __shfl(rs, 4 * q + i);
                lg[(4 * q + i) * 32 + r] = acc2[0][i] * rr + ka->b_router[r]; lg[(4 * q + i) * 32 + 16 + r] = acc2[1][i] * rr + ka->b_router[16 + r]; }
            LDS_WAIT(); asm volatile("" ::: "memory");
            LAS unsigned* hist = (LAS unsigned*)(lds + 61440);
            if (lane < 32 && wave == 0) hist[lane] = 0u;
            __syncthreads();
            int idx[4] = {0, 0, 0, 0}; float gt[4] = {0.f, 0.f, 0.f, 0.f}; unsigned rnk[4] = {0u, 0u, 0u, 0u};
            if (lane < 16) { float v[32];
#pragma unroll
                for (int e = 0; e < 32; ++e) v[e] = lg[lane * 32 + e];
                float val[4];
#pragma unroll
                for (int k = 0; k < 4; ++k) { float best = -3.0e38f; int bi = 0;
#pragma unroll
                    for (int e = 0; e < 32; ++e) { const bool better = v[e] > best; best = better ? v[e] : best; bi = better ? e : bi; }
                    idx[k] = bi; val[k] = best;
#pragma unroll
                    for (int e = 0; e < 32; ++e) v[e] = (e == bi) ? -3.0e38f : v[e]; }
                const float e0 = 1.0f, e1 = __expf(val[1] - val[0]), e2 = __expf(val[2] - val[0]), e3 = __expf(val[3] - val[0]); const float inv = 1.0f / (e0 + e1 + e2 + e3);
                gt[0] = e0 * inv; gt[1] = e1 * inv; gt[2] = e2 * inv; gt[3] = e3 * inv;
#pragma unroll
                for (int k = 0; k < 4; ++k) rnk[k] = __hip_atomic_fetch_add(hist + idx[k], 1u, __ATOMIC_RELAXED, __HIP_MEMORY_SCOPE_WORKGROUP); }
            __syncthreads();
            { int t32 = lane + 64 * wave; asm volatile("" : "+v"(t32));
              if (t32 < 32) { const unsigned n = hist[t32]; hist[32 + t32] = n ? atomicAdd(&cnt[t32], n) : 0u; } }
            __syncthreads();
            if (lane < 16) { const int tok = gq * 16 + lane; const float rsrow = rs;
#pragma unroll
                for (int k = 0; k < 4; ++k) { const int asg = tok * 4 + k; const size_t rp = (size_t)idx[k] * NTOK + hist[32 + idx[k]] + rnk[k]; rowlist[rp] = asg; rowgate[rp] = gt[k]; rowrstd[rp] = rsrow; } }
            LDS_WAIT(); asm volatile("" ::: "memory");
        }
        if (NGW == 2048 && gw >= 1024) { for (int it = CONV_P2 + CONV_P1 + (gw - 1024); it < CONV_ALL; it += 1024) MOE_CONV_ITEM(it); }
        else if (NGW != 2048) { for (int it = CONV_P2 + CONV_P1 + gw; it < CONV_ALL; it += NGW) MOE_CONV_ITEM(it); }
        if (BOTH(7)) GRID_BAR();
    }
    if (IN(8)) {
        KArgs ka = kargs();
        LAS int* tab = (LAS int*)(lds + TAB_OFF);
        moe_build_table(tab, cnt, 16);
#if MOE_FP8
        pg8::MoeOrder S{(const char*)x1b, (const char*)WupT, rowlist, nullptr, tab, 16, DM / 2, (size_t)4096 * DM, G, bx};
        pg8::EpiMoeUpQ E{(unsigned char*)act, rstd2, ka->b_up};
        pg8::gemm_phase<pg8::EpiMoeUpQ, pg8::MoeOrder, true, true, 127, 122>(lds, DM / 2, S, E);
#else
        pg8::MoeOrder S{(const char*)x1b, (const char*)WupT, rowlist, nullptr, tab, 16, DM, (size_t)4096 * DM * 2, G, bx};
        pg8::EpiMoeUp E{act, rstd2, ka->b_up};
        pg8::gemm_phase<pg8::EpiMoeUp, pg8::MoeOrder, true>(lds, DM, S, E);
#endif
        if (BOTH(8)) GRID_BAR();
    }
    if (IN(9)) {
        KArgs ka = kargs();
        LAS int* tab = (LAS int*)(lds + TAB_OFF);
        __syncthreads();
        moe_build_table(tab, cnt, 8);
#if MOE_FP8
        pg8::MoeOrder S{(const char*)act, (const char*)WdownT, rowlist, ident, tab, 8, DFF / 2, (size_t)DM * DFF, G, bx};
        pg8::EpiMoeDown E{ybuf, gate_a, ka->b_down};
        pg8::gemm_phase<pg8::EpiMoeDown, pg8::MoeOrder, true, true, 125, 122>(lds, DFF / 2, S, E);
#else
        pg8::MoeOrder S{(const char*)act, (const char*)WdownT, rowlist, ident, tab, 8, DFF, (size_t)DM * DFF * 2, G, bx};
        pg8::EpiMoeDown E{ybuf, gate_a, ka->b_down};
        pg8::gemm_phase<pg8::EpiMoeDown, pg8::MoeOrder, true>(lds, DFF, S, E);
#endif
        if (BOTH(9)) GRID_BAR();
    }
    if (IN(10)) {
        KArgs ka = kargs();
        const int lane = (int)__builtin_amdgcn_mbcnt_hi(~0u, __builtin_amdgcn_mbcnt_lo(~0u, 0u));
        for (int tok = gw; tok < NTOK; tok += NGW) {
            f32x4 v[8]; float ss = 0.f;
#if Y_FP8
            unsigned yw[4][8];
#pragma unroll
            for (int j = 0; j < 8; ++j) { v[j] = __builtin_nontemporal_load((const f32x4*)(x1 + (size_t)tok * DM + j * 256 + lane * 4));
#pragma unroll
                for (int k = 0; k < 4; ++k) yw[k][j] = __builtin_nontemporal_load((const unsigned*)((const unsigned char*)ybuf + ((size_t)tok * 4 + k) * DM + j * 256 + lane * 4)); }
#pragma unroll
            for (int j = 0; j < 8; ++j) {
#pragma unroll
                for (int k = 0; k < 4; ++k) { const f32x2 lo = __builtin_amdgcn_cvt_pk_f32_fp8((int)yw[k][j], false), hi2 = __builtin_amdgcn_cvt_pk_f32_fp8((int)yw[k][j], true);
                    v[j][0] += lo[0] * 0.0625f; v[j][1] += lo[1] * 0.0625f; v[j][2] += hi2[0] * 0.0625f; v[j][3] += hi2[1] * 0.0625f; }
#else
            u32x2 yw[4][8];
#pragma unroll
            for (int j = 0; j < 8; ++j) { v[j] = __builtin_nontemporal_load((const f32x4*)(x1 + (size_t)tok * DM + j * 256 + lane * 4));
#pragma unroll
                for (int k = 0; k < 4; ++k) yw[k][j] = __builtin_nontemporal_load((const u32x2*)(ybuf + ((size_t)tok * 4 + k) * DM + j * 256 + lane * 4)); }
#pragma unroll
            for (int j = 0; j < 8; ++j) {
#pragma unroll
                for (int k = 0; k < 4; ++k) { const u32x2 w = yw[k][j];
                    v[j][0] += __uint_as_float(w.x << 16); v[j][1] += __uint_as_float(w.x & 0xffff0000u); v[j][2] += __uint_as_float(w.y << 16); v[j][3] += __uint_as_float(w.y & 0xffff0000u); }
#endif
                ss += (v[j][0] * v[j][0] + v[j][1] * v[j][1]) + (v[j][2] * v[j][2] + v[j][3] * v[j][3]); }
            const float rs = 1.0f / sqrtf(wave_sum(ss) * (1.0f / DM) + EPS);
#pragma unroll
            for (int j = 0; j < 8; ++j) { const f32x4 g = *(const f32x4*)(ka->g_final + j * 256 + lane * 4); __builtin_nontemporal_store(v[j] * rs * g, (f32x4*)(ka->out + (size_t)tok * DM + j * 256 + lane * 4)); }
        }
    }
#undef IN
#undef BOTH
#undef GRID_BAR
}

extern "C" void kernel_launch(void* const* d_in, const int* in_sizes, int n_in, void* d_out, int out_size, void* d_ws, size_t ws_size, hipStream_t stream) {
    static int grid = 0;
    if (grid == 0) {
        if (n_in != 21 || in_sizes[0] != NTOK * DM || out_size != NTOK * DM || ws_size < WS_END) { fprintf(stderr, "kernel_launch: unexpected shapes (n_in %d, in0 %d, out %d, ws %zu)\n", n_in, n_in > 0 ? in_sizes[0] : -1, out_size, ws_size); grid = -1; return; }
        int dev = 0, cus = 0;
        if (hipGetDevice(&dev) != hipSuccess || hipDeviceGetAttribute(&cus, hipDeviceAttributeMultiprocessorCount, dev) != hipSuccess) { grid = -1; return; }
        if (hipFuncSetAttribute((const void*)fwd, hipFuncAttributeMaxDynamicSharedMemorySize, LDS_BYTES) != hipSuccess) { fprintf(stderr, "kernel_launch: hipFuncSetAttribute failed\n"); grid = -1; return; }
        int per_cu = 0; (void)hipOccupancyMaxActiveBlocksPerMultiprocessor(&per_cu, (const void*)fwd, NWAVES * 64, LDS_BYTES); (void)hipGetLastError();
        if (per_cu < 1) fprintf(stderr, "kernel_launch: occupancy query says %d\n", per_cu);
        grid = cus;
    }
    if (grid < 0) return;
    (void)hipMemsetAsync((char*)d_ws + WS_CTL, 0, CTL_ZERO_BYTES, stream);
    Args a{};
    const float** fp = (const float**)&a.x;
    for (int i = 0; i < 21; ++i) fp[i] = (const float*)d_in[i];
    a.out = (float*)d_out; a.ws = (unsigned char*)d_ws;
    if (N_LAUNCHES == 1) { a.ph_lo = 0; a.ph_hi = PER_PHASE; hipLaunchKernelGGL(fwd, dim3(grid), dim3(NWAVES * 64), LDS_BYTES, stream, a); }
    else for (int p = 0; p < PER_PHASE; ++p) { a.ph_lo = p; a.ph_hi = p + 1;
        for (int rep = 0; rep < ((p == REP_PHASE) ? 1 + REP_EXTRA : 1); ++rep) { a.ph_hi = (p + 1) | ((rep > 0 ? REP_SUB : 0) << 8); hipLaunchKernelGGL(fwd, dim3(grid), dim3(NWAVES * 64), LDS_BYTES, stream, a); } }
}
```
